# Optimizing an MI355X kernel written in HIP

```python
import math
import jax
import jax.numpy as jnp
from jax import lax
import numpy as np

D_MODEL = 1024
BATCH = 4
SEQ = 4096
DEPTH = 2

PLE_DIM = 256
D_FF = 2816
LN_EPS = 1e-5
DEEPNORM_ALPHA = (2 * DEPTH) ** 0.25
DEEPNORM_BETA = (8 * DEPTH) ** -0.25
MACARON_W = 0.5

RW_HEADS = 8
RW_HEAD = 64
RW_WIDTH = RW_HEADS * RW_HEAD
RW_DECAY_LORA = 64
RW_AAA_LORA = 64
RW_GATE_LORA = 160
RW_GN_EPS = 1e-5 * RW_HEAD

GLA_HEADS = 4
GLA_DK = 64
GLA_DV = 128
GLA_GATE_LORA = 16
GLA_GATE_NORM = 16.0
GLA_CHUNK = 64

GDN_HEADS = 4
GDN_DK = 128
GDN_DV = 128
GDN_CONV = 4
GDN_CHUNK = 64

HEAD_NORM_EPS = 1e-6
L2_EPS = 1e-6
N_BRANCH = 3
BRANCH_WIDTH = 512

RW_SPLITS = (RW_WIDTH, RW_WIDTH, RW_WIDTH, RW_DECAY_LORA, RW_AAA_LORA, RW_GATE_LORA)
GLA_SPLITS = (GLA_HEADS * GLA_DK, GLA_HEADS * GLA_DK, GLA_HEADS * GLA_DV, GLA_GATE_LORA, GLA_HEADS * GLA_DV)
GDN_QKV = GDN_HEADS * (2 * GDN_DK + GDN_DV)
GDN_SPLITS = (GDN_QKV, GDN_HEADS, GDN_HEADS, GDN_HEADS * GDN_DV)
RW_IN = sum(RW_SPLITS)
GROUP_SPLITS = (RW_IN, sum(GLA_SPLITS), sum(GDN_SPLITS), N_BRANCH * D_MODEL)
D_IN = sum(GROUP_SPLITS)

kernel_name = "hybrid_rwkv7_gla_gdn_macaron_deepnorm"


def _split(h, sizes):
    idx, s = [], 0
    for w in sizes[:-1]:
        s += w
        idx.append(s)
    return jnp.split(h, idx, axis=-1)


def _heads(t, h, d):
    return t.reshape(t.shape[:-1] + (h, d))


def _layer_norm(x, g, b):
    xf = x.astype(jnp.float32)
    m = jnp.mean(xf, -1, keepdims=True)
    var = jnp.mean(jnp.square(xf - m), -1, keepdims=True)
    return ((xf - m) * lax.rsqrt(var + LN_EPS) * g + b).astype(x.dtype)


def _rms_norm(x, g):
    return x * lax.rsqrt(jnp.mean(jnp.square(x), -1, keepdims=True) + HEAD_NORM_EPS) * g


def _l2norm(x):
    return x * lax.rsqrt(jnp.sum(jnp.square(x), -1, keepdims=True) + L2_EPS)


def _swiglu(x, w1, w3, w2):
    return (jax.nn.silu(x @ w1) * (x @ w3)) @ w2


def rwkv7_time_mix(h_rw, mu, w0, w2, a0, a2, g2, k_k, k_a, r_k, gn_g, gn_b):
    B, T, _ = h_rw.shape
    prev = jnp.pad(h_rw, ((0, 0), (1, 0), (0, 0)))[:, :-1]
    h_rw = h_rw + (prev - h_rw) * mu
    r, k, v, w_lo, a_lo, g_lo = _split(h_rw, RW_SPLITS)
    w = -jax.nn.softplus(-(w0 + jnp.tanh(w_lo) @ w2)) - 0.5
    decay = jnp.exp(-jnp.exp(w))
    a = jax.nn.sigmoid(a0 + a_lo @ a2)
    g = jax.nn.sigmoid(g_lo) @ g2
    kk = _l2norm(_heads(k * k_k, RW_HEADS, RW_HEAD))
    k = k * (1.0 + (a - 1.0) * k_a)
    r, k, v, decay, a = (_heads(t, RW_HEADS, RW_HEAD) for t in (r, k, v, decay, a))

    def step(S, inp):
        r_t, k_t, v_t, d_t, a_t, b_t = inp
        sa = jnp.einsum('bhvk,bhk->bhv', S, a_t)
        S = S * d_t[:, :, None, :] + sa[..., None] * b_t[:, :, None, :] + v_t[..., None] * k_t[:, :, None, :]
        return S, jnp.einsum('bhvk,bhk->bhv', S, r_t)

    xs = tuple(jnp.moveaxis(t, 1, 0) for t in (r, k, v, decay, -kk, kk * a))
    S0 = jnp.zeros((B, RW_HEADS, RW_HEAD, RW_HEAD), jnp.float32)
    _, y = lax.scan(step, S0, xs)
    y = jnp.moveaxis(y, 0, 1)
    ym = jnp.mean(y, -1, keepdims=True)
    yv = jnp.mean(jnp.square(y - ym), -1, keepdims=True)
    y = ((y - ym) * lax.rsqrt(yv + RW_GN_EPS)).reshape(B, T, RW_WIDTH) * gn_g + gn_b
    bonus = jnp.sum(r * k * r_k, -1, keepdims=True) * v
    return (y + bonus.reshape(B, T, RW_WIDTH)) * g


def gla_mix(q, k, v, gk_lo, gate, gk_w2, gk_b, norm_g):
    B, T, _ = q.shape
    C, n, H = GLA_CHUNK, T // GLA_CHUNK, GLA_HEADS
    log_a = jax.nn.log_sigmoid(gk_lo @ gk_w2 + gk_b) / GLA_GATE_NORM

    def chunked(t, d):
        return t.reshape(B, n, C, H, d).transpose(1, 0, 3, 2, 4)

    q = chunked(q * GLA_DK ** -0.5, GLA_DK)
    k = chunked(k, GLA_DK)
    v = chunked(v, GLA_DV)
    b = jnp.cumsum(chunked(log_a, GLA_DK), axis=3)
    causal = jnp.tril(jnp.ones((C, C), dtype=bool))[:, :, None]

    def step(S, inp):
        q_c, k_c, v_c, b_c = inp
        rel = jnp.where(causal, b_c[:, :, :, None, :] - b_c[:, :, None, :, :], -jnp.inf)
        att = jnp.sum(q_c[:, :, :, None, :] * k_c[:, :, None, :, :] * jnp.exp(rel), axis=-1)
        o = att @ v_c + (q_c * jnp.exp(b_c)) @ S
        b_end = b_c[:, :, -1:, :]
        S = S * jnp.exp(b_end[:, :, 0, :, None]) + jnp.einsum('bhjd,bhjv->bhdv', k_c * jnp.exp(b_end - b_c), v_c)
        return S, o

    S0 = jnp.zeros((B, H, GLA_DK, GLA_DV), jnp.float32)
    _, o = lax.scan(step, S0, (q, k, v, b))
    o = o.transpose(1, 0, 3, 2, 4).reshape(B, T, H, GLA_DV)
    return _rms_norm(o, norm_g).reshape(B, T, H * GLA_DV) * jax.nn.silu(gate)


def gated_deltanet_mix(qkv, a_in, b_in, gate, conv_w, a_log, dt_bias, norm_g):
    B, T, _ = qkv.shape
    C, n, H = GDN_CHUNK, T // GDN_CHUNK, GDN_HEADS
    qkv = jax.nn.silu(lax.conv_general_dilated(
        qkv, conv_w[:, None, :].astype(qkv.dtype), (1,), [(GDN_CONV - 1, 0)],
        dimension_numbers=('NWC', 'WIO', 'NWC'), feature_group_count=qkv.shape[-1]))
    q, k, v = _split(qkv, (H * GDN_DK, H * GDN_DK, H * GDN_DV))
    q = _l2norm(_heads(q, H, GDN_DK)) * GDN_DK ** -0.5
    k = _l2norm(_heads(k, H, GDN_DK))
    v = _heads(v, H, GDN_DV)
    beta = jax.nn.sigmoid(b_in)
    g = -jnp.exp(a_log) * jax.nn.softplus(a_in + dt_bias)

    def chunked(t):
        t = jnp.moveaxis(t, 2, 1)
        return t.reshape((B, H, n, C) + t.shape[3:])

    q, k, v, beta, g = (chunked(t) for t in (q, k, v, beta, g))
    g = jnp.cumsum(g, axis=-1)
    causal = jnp.tril(jnp.ones((C, C), dtype=bool))
    strict = jnp.tril(jnp.ones((C, C), dtype=bool), -1)
    decay = jnp.exp(jnp.where(causal, g[..., :, None] - g[..., None, :], -jnp.inf))
    kb = k * beta[..., None]
    lower = jnp.where(strict, jnp.einsum('bhnid,bhnjd->bhnij', kb, k) * decay, 0.0)
    eye = jnp.eye(C, dtype=lower.dtype)
    t_inv = lax.linalg.triangular_solve(eye + lower, jnp.broadcast_to(eye, lower.shape),
                                        left_side=True, lower=True)
    u = t_inv @ (v * beta[..., None])
    w = t_inv @ (kb * jnp.exp(g)[..., None])
    att = jnp.einsum('bhnid,bhnjd->bhnij', q, k) * decay
    xs = tuple(jnp.moveaxis(t, 2, 0) for t in (q, k, u, w, g, att))

    def step(S, inp):
        q_c, k_c, u_c, w_c, g_c, att_c = inp
        v_new = u_c - w_c @ S
        o = (q_c * jnp.exp(g_c)[..., None]) @ S + att_c @ v_new
        g_end = g_c[..., -1:]
        S = S * jnp.exp(g_end)[..., None] + jnp.einsum('bhcd,bhcv->bhdv', k_c * jnp.exp(g_end - g_c)[..., None], v_new)
        return S, o

    S0 = jnp.zeros((B, H, GDN_DK, GDN_DV), jnp.float32)
    _, o = lax.scan(step, S0, xs)
    o = o.transpose(1, 0, 3, 2, 4).reshape(B, T, H, GDN_DV)
    return _rms_norm(o, norm_g).reshape(B, T, H * GDN_DV) * jax.nn.silu(gate)


def token_mixing(x, w_in, rw_mu, rw_w0, rw_w2, rw_a0, rw_a2, rw_g2, rw_k_k, rw_k_a, rw_r_k, rw_gn_g, rw_gn_b,
                 gla_gk_w2, gla_gk_b, gla_norm_g, gdn_conv_w, gdn_a_log, gdn_dt_bias, gdn_norm_g, w_branch, w_o):
    B, T, _ = x.shape
    h = (x @ w_in).astype(jnp.float32)
    h_rw, h_gla, h_gdn, h_gate = _split(h, GROUP_SPLITS)
    o_rw = rwkv7_time_mix(h_rw, rw_mu, rw_w0, rw_w2, rw_a0, rw_a2, rw_g2, rw_k_k, rw_k_a, rw_r_k, rw_gn_g, rw_gn_b)
    o_gla = gla_mix(*_split(h_gla, GLA_SPLITS), gla_gk_w2, gla_gk_b, gla_norm_g)
    o_gdn = gated_deltanet_mix(*_split(h_gdn, GDN_SPLITS), gdn_conv_w, gdn_a_log, gdn_dt_bias, gdn_norm_g)
    branches = jnp.stack([o_rw, o_gla, o_gdn], axis=2)
    proj = jnp.einsum('btnc,ncd->btnd', branches, w_branch)
    gates = jax.nn.sigmoid(h_gate).reshape(B, T, N_BRANCH, D_MODEL)
    merged = jnp.sum(gates * proj, axis=2)
    return merged.astype(x.dtype) @ w_o


def setup_inputs(seed: int = 0) -> dict:
    key = jax.random.key(seed)
    ks = iter(jax.random.split(key, 40))
    L, D = DEPTH, D_MODEL
    bt = DEEPNORM_BETA

    def nrm(shape, scale):
        return jax.random.normal(next(ks), shape, jnp.float32) * scale

    def uni(shape, lo, hi):
        return jax.random.uniform(next(ks), shape, jnp.float32, lo, hi)

    dt = jnp.exp(uni((L, GDN_HEADS), math.log(1e-3), math.log(1e-1)))
    return {
        "x": nrm((BATCH, SEQ, D), 1.0),
        "p": nrm((L, BATCH, SEQ, PLE_DIM), 1.0),
        "ln_g": 1.0 + nrm((L, 4, D), 0.02),
        "ln_b": nrm((L, 4, D), 0.02),
        "ffn_w1": nrm((L, 2, D, D_FF), D ** -0.5),
        "ffn_w3": nrm((L, 2, D, D_FF), D ** -0.5),
        "ffn_w2": nrm((L, 2, D_FF, D), bt * D_FF ** -0.5),
        "w_in": nrm((L, D, D_IN), D ** -0.5),
        "rw_mu": uni((L, RW_IN), 0.0, 1.0),
        "rw_w0": uni((L, RW_WIDTH), -6.0, -1.0),
        "rw_w2": nrm((L, RW_DECAY_LORA, RW_WIDTH), 0.5 * RW_DECAY_LORA ** -0.5),
        "rw_a0": nrm((L, RW_WIDTH), 0.1),
        "rw_a2": nrm((L, RW_AAA_LORA, RW_WIDTH), 0.5 * RW_AAA_LORA ** -0.5),
        "rw_g2": nrm((L, RW_GATE_LORA, RW_WIDTH), RW_GATE_LORA ** -0.5),
        "rw_k_k": 0.85 + nrm((L, RW_WIDTH), 0.05),
        "rw_k_a": 1.0 + nrm((L, RW_WIDTH), 0.05),
        "rw_r_k": nrm((L, RW_HEADS, RW_HEAD), 0.1),
        "rw_gn_g": 1.0 + nrm((L, RW_WIDTH), 0.02),
        "rw_gn_b": nrm((L, RW_WIDTH), 0.02),
        "gla_gk_w2": nrm((L, GLA_GATE_LORA, GLA_HEADS * GLA_DK), GLA_GATE_LORA ** -0.5),
        "gla_gk_b": uni((L, GLA_HEADS * GLA_DK), 0.0, 3.0),
        "gla_norm_g": 1.0 + nrm((L, GLA_DV), 0.02),
        "gdn_conv_w": nrm((L, GDN_CONV, GDN_QKV), GDN_CONV ** -0.5),
        "gdn_a_log": jnp.log(uni((L, GDN_HEADS), 1.0, 16.0)),
        "gdn_dt_bias": dt + jnp.log(-jnp.expm1(-dt)),
        "gdn_norm_g": 1.0 + nrm((L, GDN_DV), 0.02),
        "w_branch": nrm((L, N_BRANCH, BRANCH_WIDTH, D), bt * BRANCH_WIDTH ** -0.5),
        "w_o": nrm((L, D, D), bt * D ** -0.5),
        "ple_w_gate": nrm((L, D, D), D ** -0.5),
        "ple_w_proj": nrm((L, PLE_DIM, D), bt * PLE_DIM ** -0.5),
    }


def reference(x, p, ln_g, ln_b, ffn_w1, ffn_w3, ffn_w2, w_in, rw_mu, rw_w0, rw_w2, rw_a0, rw_a2, rw_g2,
              rw_k_k, rw_k_a, rw_r_k, rw_gn_g, rw_gn_b, gla_gk_w2, gla_gk_b, gla_norm_g, gdn_conv_w, gdn_a_log,
              gdn_dt_bias, gdn_norm_g, w_branch, w_o, ple_w_gate, ple_w_proj):
    a = DEEPNORM_ALPHA
    for i in range(DEPTH):
        x = _layer_norm(a * x + MACARON_W * _swiglu(x, ffn_w1[i, 0], ffn_w3[i, 0], ffn_w2[i, 0]), ln_g[i, 0], ln_b[i, 0])
        mix = token_mixing(x, w_in[i], rw_mu[i], rw_w0[i], rw_w2[i], rw_a0[i], rw_a2[i], rw_g2[i], rw_k_k[i],
                           rw_k_a[i], rw_r_k[i], rw_gn_g[i], rw_gn_b[i], gla_gk_w2[i], gla_gk_b[i], gla_norm_g[i],
                           gdn_conv_w[i], gdn_a_log[i], gdn_dt_bias[i], gdn_norm_g[i], w_branch[i], w_o[i])
        x = _layer_norm(a * x + mix, ln_g[i, 1], ln_b[i, 1])
        x = _layer_norm(a * x + MACARON_W * _swiglu(x, ffn_w1[i, 1], ffn_w3[i, 1], ffn_w2[i, 1]), ln_g[i, 2], ln_b[i, 2])
        ple = jax.nn.sigmoid(x @ ple_w_gate[i]) * (p[i] @ ple_w_proj[i])
        x = _layer_norm(a * x + ple, ln_g[i, 3], ln_b[i, 3])
    return x
```

```cpp
#define MK_SINGLE 1
#include <hip/hip_runtime.h>
#include <hip/hip_cooperative_groups.h>
#include <cstdio>
#include <cstdint>
namespace pg8 {
#define PG8_LAS __attribute__((address_space(3)))
typedef unsigned short bf16_t;
typedef short bf16x8 __attribute__((ext_vector_type(8)));
typedef float f32x4 __attribute__((ext_vector_type(4)));
typedef unsigned u32x4 __attribute__((ext_vector_type(4)));
constexpr int BM = 256, BK = 64, HALF = 128, HTB = HALF * BK * 2  , STAGE_BYTES = 8 * HTB, NXCD = 8, WGM = 8;

__host__ __device__ __forceinline__ int lds_byte(int r, int c) { const int st = (r >> 4) * 2 + (c >> 5), rr = r & 15, cc = c & 31, ob = rr * 64 + cc * 2; return st * 1024 + (ob ^ (((ob >> 9) & 1) << 5)); }
__host__ __device__ __forceinline__ void stage_rc(int b, int& R, int& C) { const int st = b / 1024, sb = b % 1024, swz = sb ^ (((sb >> 9) & 1) << 5); R = (st >> 1) * 16 + swz / 64; C = (st & 1) * 32 + (swz % 64) / 2; }
__host__ __device__ __forceinline__ int perm32(int rho) { const int n = rho >> 4, i = rho & 15; return 8 * (i >> 2) + 4 * n + (i & 3); }

struct Unit { int pm, pn; };
struct Gemm { const bf16_t* A; const bf16_t* Bt; int M, N, K; };

struct StaticOrder {
    int nM, nN, nwg, G, c;
    __host__ __device__ void init(int M, int N, int G_, int c_) { nM = M / BM; nN = N / BM; nwg = nM * nN; G = G_; c = c_; }
    __host__ __device__ bool next(int i, Unit& u) const {
        const long L = (long)i * G + c; if (L >= nwg) return false;
        int wgid = (int)L; { const int q = nwg / NXCD, r = nwg % NXCD, xcd = wgid % NXCD, off = wgid / NXCD; wgid = (xcd < r ? xcd * (q + 1) : r * (q + 1) + (xcd - r) * q) + off; }
        const int nig = WGM * nN, gid = wgid / nig, fm = gid * WGM, gsz = (nM - fm) < WGM ? (nM - fm) : WGM;
        u.pm = fm + ((wgid % nig) % gsz); u.pn = (wgid % nig) / gsz; return true;
    }
    __device__ __forceinline__ void a_ready(const Unit&) const {}
    __device__ __forceinline__ void done(const Unit&) const {}
};

__device__ __forceinline__ unsigned cvt_pk_bf16(float lo, float hi) { unsigned r; asm volatile("v_cvt_pk_bf16_f32 %0, %1, %2" : "=v"(r) : "v"(lo), "v"(hi)); return r; }
typedef unsigned u32x2 __attribute__((ext_vector_type(2)));
__device__ __forceinline__ float fsigmoid(float x) { return __builtin_amdgcn_rcpf(1.0f + __builtin_amdgcn_exp2f(-1.44269504f * x)); }
__device__ __forceinline__ unsigned bf16_sw(float f) { const unsigned u = __float_as_uint(f); return (u + 0x7fffu + ((u >> 16) & 1u)) >> 16; }
__device__ __forceinline__ unsigned pk_bf16_sw(float lo, float hi) { return bf16_sw(lo) | (bf16_sw(hi) << 16); }
__device__ __forceinline__ float bf2f(unsigned short u) { return __uint_as_float((unsigned)u << 16); }
__device__ __forceinline__ float bflo(unsigned w) { return __uint_as_float(w << 16); }
__device__ __forceinline__ float bfhi(unsigned w) { return __uint_as_float(w & 0xffff0000u); }

struct EpiSwiGLU {
    static constexpr bool PERM = true, AFTER_DRAIN = false;
    bf16_t* O; int ldc;
    __device__ __forceinline__ void operator()(const f32x4 (&acc)[2][2][4][2], const Unit& u, int wr, int wc, int fr, int fq) const {
        const int row0 = u.pm * BM + wr * 64 + fr, col0 = u.pn * HALF + wc * 32 + 8 * fq;
#pragma unroll
        for (int ai = 0; ai < 2; ++ai)
#pragma unroll
            for (int m = 0; m < 4; ++m) {
                bf16_t* rowp = O + (size_t)(row0 + ai * HALF + m * 16) * ldc + col0;
                const f32x4 g0 = acc[ai][0][m][0], g1 = acc[ai][0][m][1], u0 = acc[ai][1][m][0], u1 = acc[ai][1][m][1];
                float h[8];
#pragma unroll
                for (int e = 0; e < 4; ++e) { h[e] = g0[e] * fsigmoid(g0[e]) * u0[e]; h[4 + e] = g1[e] * fsigmoid(g1[e]) * u1[e]; }
                u32x4 w; w.x = cvt_pk_bf16(h[0], h[1]); w.y = cvt_pk_bf16(h[2], h[3]); w.z = cvt_pk_bf16(h[4], h[5]); w.w = cvt_pk_bf16(h[6], h[7]);
                *(u32x4*)rowp = w;
            }
    }
};
template <int ACT> struct EpiStore {
    static constexpr bool PERM = true, AFTER_DRAIN = false;
    bf16_t* O; int ldc;
    __device__ __forceinline__ void operator()(const f32x4 (&acc)[2][2][4][2], const Unit& u, int wr, int wc, int fr, int fq) const {
        const int row0 = u.pm * BM + wr * 64 + fr, col0 = u.pn * BM + wc * 32 + 8 * fq;
#pragma unroll
        for (int ai = 0; ai < 2; ++ai)
#pragma unroll
            for (int m = 0; m < 4; ++m) {
                bf16_t* rowp = O + (size_t)(row0 + ai * HALF + m * 16) * ldc + col0;
#pragma unroll
                for (int bj = 0; bj < 2; ++bj) {
                    f32x4 v0 = acc[ai][bj][m][0], v1 = acc[ai][bj][m][1];
                    if (ACT == 2) {
#pragma unroll
                        for (int e = 0; e < 4; ++e) { v0[e] = fsigmoid(v0[e]); v1[e] = fsigmoid(v1[e]); }
                    }
                    u32x4 w;
                    if (ACT == 2) { w.x = pk_bf16_sw(v0[0], v0[1]); w.y = pk_bf16_sw(v0[2], v0[3]); w.z = pk_bf16_sw(v1[0], v1[1]); w.w = pk_bf16_sw(v1[2], v1[3]); }
                    else { w.x = cvt_pk_bf16(v0[0], v0[1]); w.y = cvt_pk_bf16(v0[2], v0[3]); w.z = cvt_pk_bf16(v1[0], v1[1]); w.w = cvt_pk_bf16(v1[2], v1[3]); }
                    *(u32x4*)(rowp + bj * HALF) = w;
                }
            }
    }
};
struct EpiResid {
    static constexpr bool PERM = false, AFTER_DRAIN = false;
    float* X; float alpha, s;
    __device__ __forceinline__ void operator()(const f32x4 (&acc)[2][2][4][2], const Unit& u, int wr, int wc, int fr, int fq) const {
        const int col0 = u.pn * BM + wc * 32 + 4 * fq;
#pragma unroll
        for (int ai = 0; ai < 2; ++ai)
#pragma unroll
            for (int m = 0; m < 4; ++m) {
                const int r = u.pm * BM + ai * HALF + wr * 64 + m * 16 + fr; float* p = X + (size_t)r * 1024 + col0;
#pragma unroll
                for (int bj = 0; bj < 2; ++bj)
#pragma unroll
                    for (int n = 0; n < 2; ++n) { f32x4 v = *(const f32x4*)(p + bj * HALF + n * 16); v = v * alpha + acc[ai][bj][m][n] * s; *(f32x4*)(p + bj * HALF + n * 16) = v; }
                asm volatile("" ::: "memory");
            }
    }
};
struct EpiBranch {
    static constexpr bool PERM = false, AFTER_DRAIN = false;
    const bf16_t* G; float* ACC; bf16_t* MG;
    __device__ __forceinline__ void operator()(const f32x4 (&acc)[2][2][4][2], const Unit& u, int wr, int wc, int fr, int fq) const {
        const int b = u.pm >> 6, pm = u.pm & 63, pn = u.pn & 3;
        const int col0 = pn * BM + wc * 32 + 4 * fq;
#pragma unroll
        for (int ai = 0; ai < 2; ++ai)
#pragma unroll
            for (int m = 0; m < 4; ++m) {
                const int r = pm * BM + ai * HALF + wr * 64 + m * 16 + fr;
                float* pa = ACC + (size_t)r * 1024 + col0; const bf16_t* pg = G + (size_t)r * 3072 + b * 1024 + col0; bf16_t* po = MG + (size_t)r * 1024 + col0;
#pragma unroll
                for (int bj = 0; bj < 2; ++bj)
#pragma unroll
                    for (int n = 0; n < 2; ++n) {
                        const int o = bj * HALF + n * 16;
                        const u32x2 gw = *(const u32x2*)(pg + o);
                        f32x4 v = acc[ai][bj][m][n];
                        v[0] *= bflo(gw.x); v[1] *= bfhi(gw.x); v[2] *= bflo(gw.y); v[3] *= bfhi(gw.y);
#ifdef ZERO_BRANCH
                        if (b == ZERO_BRANCH) v = (f32x4){0.f, 0.f, 0.f, 0.f};
#endif
                        if (b > 0) v += *(const f32x4*)(pa + o);
                        if (b < 2) *(f32x4*)(pa + o) = v;
                        else { u32x2 w; w.x = cvt_pk_bf16(v[0], v[1]); w.y = cvt_pk_bf16(v[2], v[3]); *(u32x2*)(po + o) = w; }
                    }
                asm volatile("" ::: "memory");
            }
    }
};
struct EpiPle {
    static constexpr bool PERM = false, AFTER_DRAIN = false;
    float* X; const bf16_t* P; float alpha;
    __device__ __forceinline__ void operator()(const f32x4 (&acc)[2][2][4][2], const Unit& u, int wr, int wc, int fr, int fq) const {
        const int col0 = u.pn * BM + wc * 32 + 4 * fq;
#pragma unroll
        for (int ai = 0; ai < 2; ++ai)
#pragma unroll
            for (int m = 0; m < 4; ++m) {
                const int r = u.pm * BM + ai * HALF + wr * 64 + m * 16 + fr; float* p = X + (size_t)r * 1024 + col0; const bf16_t* pp = P + (size_t)r * 1024 + col0;
#pragma unroll
                for (int bj = 0; bj < 2; ++bj)
#pragma unroll
                    for (int n = 0; n < 2; ++n) {
                        const int o = bj * HALF + n * 16;
                        f32x4 v = *(const f32x4*)(p + o); const u32x2 pw = *(const u32x2*)(pp + o); const f32x4 a = acc[ai][bj][m][n];
                        v[0] = v[0] * alpha + fsigmoid(a[0]) * bflo(pw.x); v[1] = v[1] * alpha + fsigmoid(a[1]) * bfhi(pw.x);
                        v[2] = v[2] * alpha + fsigmoid(a[2]) * bflo(pw.y); v[3] = v[3] * alpha + fsigmoid(a[3]) * bfhi(pw.y);
                        *(f32x4*)(p + o) = v;
                    }
                asm volatile("" ::: "memory");
            }
    }
};
struct BranchOrder {
    StaticOrder so;
    __host__ __device__ void init(int G_, int c_) { so.init(16384, 1024, G_, c_); }
    __host__ __device__ bool next(int i, Unit& u) const { if (i >= 3) return false; Unit t; if (!so.next(0, t)) return false; u.pm = i * 64 + t.pm; u.pn = i * 4 + t.pn; return true; }
    __device__ __forceinline__ void a_ready(const Unit&) const {}
    __device__ __forceinline__ void done(const Unit&) const {}
};

template <class Epi, class Sched, bool ALIGN_EPI = false, bool SP2 = false>
__device__ __forceinline__ void gemm_phase(PG8_LAS unsigned char* lds, const Gemm g, const Sched& S, const Epi& E, const int tid) {
    const int  wid = __builtin_amdgcn_readfirstlane(tid >> 6), lane = tid & 63, wr = wid >> 2, wc = wid & 3, fr = lane & 15, fq = lane >> 4;
    const int K = g.K, nt = K / BK;
    unsigned voffA[2], voffB[2];
#pragma unroll
    for (int i = 0; i < 2; ++i) { int R, C; stage_rc(tid * 16 + i * 8192, R, C); const int Rb = Epi::PERM ? ((R & ~31) + perm32(R & 31)) : R;
        voffA[i] = (unsigned)(R * K + C) * 2u; voffB[i] = (unsigned)(Rb * K + C) * 2u; }
    const size_t kstep = (size_t)(BK * 2);
    const size_t hstep = (size_t)HALF * K * 2;
    const size_t tstep = 2 * hstep;
    const unsigned ldsw = (unsigned)wid * 1024u;
    const int aoff = lds_byte(wr * 64 + fr, fq * 8), boff = lds_byte(wc * 32 + fr, fq * 8);
#define PG8_SA(b, h) (((b) * 2 + (h)) * HTB)
#define PG8_SB(b, h) ((4 + (b) * 2 + (h)) * HTB)
#define PG8_STAGE(bufoff, gbase, voff) do { _Pragma("unroll") for (int _i = 0; _i < 2; ++_i) \
        __builtin_amdgcn_global_load_lds((const unsigned*)((const char*)(gbase) + (voff)[_i]), (PG8_LAS unsigned*)(lds + (bufoff) + ldsw + _i * 8192), 16, 0, 0); } while (0)
#define PG8_LDA(dst, b, h) do { _Pragma("unroll") for (int m = 0; m < 4; ++m) _Pragma("unroll") for (int k = 0; k < 2; ++k) dst[m][k] = *(const PG8_LAS bf16x8*)(lds + PG8_SA(b, h) + aoff + m * 2048 + k * 1024); } while (0)
#define PG8_LDB(dst, b, h) do { _Pragma("unroll") for (int n = 0; n < 2; ++n) _Pragma("unroll") for (int k = 0; k < 2; ++k) dst[n][k] = *(const PG8_LAS bf16x8*)(lds + PG8_SB(b, h) + boff + n * 2048 + k * 1024); } while (0)
#define PG8_MMA(ai, bj, At, Bt) do { __builtin_amdgcn_s_setprio(1); _Pragma("unroll") for (int m = 0; m < 4; ++m) _Pragma("unroll") for (int n = 0; n < 2; ++n) _Pragma("unroll") for (int k = 0; k < 2; ++k) \
        acc[ai][bj][m][n] = __builtin_amdgcn_mfma_f32_16x16x32_bf16(Bt[n][k], At[m][k], acc[ai][bj][m][n], 0, 0, 0); __builtin_amdgcn_s_setprio(0); } while (0)
#define PG8_WAIT_V(n) asm volatile("s_waitcnt vmcnt(" #n ")" ::: "memory")
#define PG8_WAIT_L(n) asm volatile("s_waitcnt lgkmcnt(" #n ")" ::: "memory")
#define PG8_BAR __builtin_amdgcn_s_barrier()
#define PG8_SCHED __builtin_amdgcn_sched_barrier(0)
    Unit cur, nxt; int ui = 0;
    if (!S.next(0, cur)) return;
    f32x4 acc[2][2][4][2];
#pragma unroll
    for (int a = 0; a < 2; ++a)
#pragma unroll
        for (int b = 0; b < 2; ++b)
#pragma unroll
            for (int m = 0; m < 4; ++m)
#pragma unroll
                for (int n = 0; n < 2; ++n) acc[a][b][m][n] = (f32x4){0.f, 0.f, 0.f, 0.f};
    bf16x8 At[4][2], B0[2][2], B1[2][2];
    const char* cA = (const char*)g.A + (size_t)cur.pm * tstep; const char* cB = (const char*)g.Bt + (size_t)cur.pn * tstep;
    S.a_ready(cur);
    if constexpr (SP2) {
        PG8_STAGE(PG8_SB(0, 0), cB, voffB); PG8_STAGE(PG8_SB(0, 1), cB + hstep, voffB); PG8_STAGE(PG8_SA(0, 0), cA, voffA); PG8_STAGE(PG8_SA(0, 1), cA + hstep, voffA);
        if (wr == 1) PG8_BAR;
        PG8_WAIT_V(2); PG8_BAR;
        PG8_STAGE(PG8_SB(1, 0), cB + kstep, voffB); PG8_STAGE(PG8_SA(1, 0), cA + kstep, voffA); PG8_STAGE(PG8_SB(1, 1), cB + hstep + kstep, voffB);
        PG8_WAIT_V(6); PG8_BAR;
    } else {
        PG8_STAGE(PG8_SB(0, 0), cB, voffB); PG8_STAGE(PG8_SA(0, 0), cA, voffA); PG8_STAGE(PG8_SB(0, 1), cB + hstep, voffB); PG8_STAGE(PG8_SA(0, 1), cA + hstep, voffA);
        if (wr == 1) PG8_BAR;
        PG8_WAIT_V(4); PG8_BAR;
        PG8_STAGE(PG8_SB(1, 0), cB + kstep, voffB); PG8_STAGE(PG8_SA(1, 0), cA + kstep, voffA); PG8_STAGE(PG8_SB(1, 1), cB + hstep + kstep, voffB);
        PG8_WAIT_V(6); PG8_BAR;
    }
    for (;;) {
        const bool has_next = S.next(ui + 1, nxt);
        const char* nA = has_next ? (const char*)g.A + (size_t)nxt.pm * tstep : cA; const char* nB = has_next ? (const char*)g.Bt + (size_t)nxt.pn * tstep : cB;
        for (int t = 0; t < nt; t += 2) {
            const bool last = (t == nt - 2);
            const char* a1 = cA + (size_t)(t + 1) * kstep;
            const char* a2 = last ? nA : cA + (size_t)(t + 2) * kstep; const char* b2 = last ? nB : cB + (size_t)(t + 2) * kstep;
            const char* a3 = a2 + kstep; const char* b3 = b2 + kstep;
            if (last && has_next) S.a_ready(nxt);
            if constexpr (SP2) {
            PG8_LDB(B0, 0, 0); PG8_LDB(B1, 0, 1); PG8_SCHED; PG8_LDA(At, 0, 0); PG8_STAGE(PG8_SA(1, 1), a1 + hstep, voffA);
            PG8_WAIT_V(8); PG8_WAIT_L(0); PG8_BAR; PG8_MMA(0, 0, At, B0); PG8_MMA(0, 1, At, B1); PG8_BAR; PG8_SCHED;
            PG8_LDA(At, 0, 1); PG8_STAGE(PG8_SB(0, 0), b2, voffB); PG8_STAGE(PG8_SB(0, 1), b2 + hstep, voffB); PG8_STAGE(PG8_SA(0, 0), a2, voffA);
            PG8_WAIT_V(8); PG8_WAIT_L(0); PG8_BAR; PG8_MMA(1, 0, At, B0); PG8_MMA(1, 1, At, B1); PG8_BAR; PG8_SCHED;
            PG8_LDB(B0, 1, 0); PG8_LDB(B1, 1, 1); PG8_SCHED; PG8_LDA(At, 1, 0); PG8_STAGE(PG8_SA(0, 1), a2 + hstep, voffA);
            PG8_WAIT_V(8); PG8_WAIT_L(0); PG8_BAR; PG8_MMA(0, 0, At, B0); PG8_MMA(0, 1, At, B1); PG8_BAR; PG8_SCHED;
            PG8_LDA(At, 1, 1); PG8_STAGE(PG8_SB(1, 0), b3, voffB); PG8_STAGE(PG8_SB(1, 1), b3 + hstep, voffB); PG8_STAGE(PG8_SA(1, 0), a3, voffA);
            PG8_WAIT_V(8); PG8_WAIT_L(0); PG8_BAR; PG8_MMA(1, 0, At, B0); PG8_MMA(1, 1, At, B1); PG8_BAR; PG8_SCHED;
            } else {
            PG8_LDB(B0, 0, 0); PG8_SCHED; PG8_LDA(At, 0, 0); PG8_STAGE(PG8_SA(1, 1), a1 + hstep, voffA);
            PG8_WAIT_L(8); PG8_BAR; PG8_WAIT_L(0); PG8_MMA(0, 0, At, B0); PG8_BAR; PG8_SCHED;
            PG8_LDB(B1, 0, 1); PG8_STAGE(PG8_SB(0, 0), b2, voffB);
            PG8_BAR; PG8_WAIT_L(0); PG8_MMA(0, 1, At, B1); PG8_BAR;
            PG8_LDA(At, 0, 1); PG8_STAGE(PG8_SA(0, 0), a2, voffA);
            PG8_BAR; PG8_WAIT_L(0); PG8_MMA(1, 0, At, B0); PG8_BAR; PG8_SCHED;
            PG8_STAGE(PG8_SB(0, 1), b2 + hstep, voffB);
            PG8_WAIT_V(6); PG8_BAR; PG8_MMA(1, 1, At, B1); PG8_BAR;
            PG8_LDB(B0, 1, 0); PG8_SCHED; PG8_LDA(At, 1, 0); PG8_STAGE(PG8_SA(0, 1), a2 + hstep, voffA);
            PG8_WAIT_L(8); PG8_BAR; PG8_WAIT_L(0); PG8_MMA(0, 0, At, B0); PG8_BAR; PG8_SCHED;
            PG8_LDB(B1, 1, 1); PG8_STAGE(PG8_SB(1, 0), b3, voffB);
            PG8_BAR; PG8_WAIT_L(0); PG8_MMA(0, 1, At, B1); PG8_BAR;
            PG8_LDA(At, 1, 1); PG8_STAGE(PG8_SA(1, 0), a3, voffA);
            PG8_BAR; PG8_WAIT_L(0); PG8_MMA(1, 0, At, B0); PG8_BAR; PG8_SCHED;
            PG8_STAGE(PG8_SB(1, 1), b3 + hstep, voffB);
            PG8_WAIT_V(6); PG8_BAR; PG8_MMA(1, 1, At, B1); PG8_BAR;
            }
        }
        if constexpr (ALIGN_EPI) { if (wr == 0) PG8_BAR; }
        if constexpr (!Epi::AFTER_DRAIN) { E(acc, cur, wr, wc, fr, fq); S.done(cur); }
        if (!has_next) break;
#pragma unroll
        for (int a = 0; a < 2; ++a)
#pragma unroll
            for (int b = 0; b < 2; ++b)
#pragma unroll
                for (int m = 0; m < 4; ++m)
#pragma unroll
                    for (int n = 0; n < 2; ++n) acc[a][b][m][n] = (f32x4){0.f, 0.f, 0.f, 0.f};
        cur = nxt; cA = nA; cB = nB; ++ui;
        if constexpr (ALIGN_EPI) { if (wr == 1) PG8_BAR; }
    }
    PG8_WAIT_V(0);
    if constexpr (!ALIGN_EPI) { if (wr == 0) PG8_BAR; }
    PG8_BAR;
    if constexpr (Epi::AFTER_DRAIN) { E.fused(acc, cur, wr, wc, fr, fq, lds, wid, lane); S.done(cur); }
#undef PG8_SA
#undef PG8_SB
#undef PG8_STAGE
#undef PG8_LDA
#undef PG8_LDB
#undef PG8_MMA
#undef PG8_WAIT_V
#undef PG8_WAIT_L
#undef PG8_BAR
#undef PG8_SCHED
}
}
namespace cg = cooperative_groups;
constexpr int NWAVES = 8, NTHREADS = 512;
constexpr int BATCH = 4, SEQ = 4096, D = 1024, FF = 2816, M = BATCH * SEQ, DEPTH = 2, PLE = 256;
constexpr int DIN = 8504, NMIX = 5432, LDH = 5632, NGATE = 3072;
constexpr int C_RW = 0, C_GLA = 1824, C_GDN = 3376;
constexpr float LN_EPS = 1e-5f, ALPHA = 1.41421356237f;
constexpr size_t MiB = 1u << 20;
constexpr size_t WS_CTL = 0;
constexpr size_t SZ_W13 = (size_t)5632 * 1024 * 2, SZ_W2 = (size_t)1024 * 2816 * 2, SZ_WIN = (size_t)LDH * 1024 * 2, SZ_WG = (size_t)NGATE * 1024 * 2,
                 SZ_WBR = (size_t)3 * 1024 * 512 * 2, SZ_WO = (size_t)1024 * 1024 * 2, SZ_WPP = (size_t)1024 * 256 * 2;
constexpr size_t WS_W = 1 * MiB;
constexpr size_t WO_W13_0 = 0, WO_W2_0 = WO_W13_0 + SZ_W13, WO_W13_1 = WO_W2_0 + SZ_W2, WO_W2_1 = WO_W13_1 + SZ_W13, WO_WIN = WO_W2_1 + SZ_W2, WO_WG = WO_WIN + SZ_WIN,
                 WO_WBR = WO_WG + SZ_WG, WO_WO = WO_WBR + SZ_WBR, WO_WPG = WO_WO + SZ_WO, WO_WPP = WO_WPG + SZ_WO, WO_END = WO_WPP + SZ_WPP;
static_assert(WO_END <= 58 * MiB, "weights region");
constexpr size_t WS_XB = 59 * MiB;
constexpr size_t WS_R = 91 * MiB;
constexpr size_t WS_R_ACC = WS_R + 96 * MiB, WS_R_PP = WS_R + 8 * MiB;
constexpr size_t WS_O = 267 * MiB;
constexpr size_t WS_END = 315 * MiB;
constexpr int LDS_BYTES = 147456;

#define GAS __attribute__((address_space(1)))
#define LAS __attribute__((address_space(3)))
typedef unsigned short bf16;
typedef unsigned v4u __attribute__((ext_vector_type(4)));
typedef float f32x4 __attribute__((ext_vector_type(4)));
#define LDS_WAIT() asm volatile("s_waitcnt lgkmcnt(0)" ::: "memory")
__device__ __forceinline__ unsigned f2bf(float f) { unsigned u = __builtin_bit_cast(unsigned, f); return (u + 0x7fffu + ((u >> 16) & 1u)) >> 16; }
__device__ __forceinline__ unsigned pk2(float lo, float hi) { return f2bf(lo) | (f2bf(hi) << 16); }
__device__ __forceinline__ float b2f(bf16 u) { return __uint_as_float((unsigned)u << 16); }
__device__ __forceinline__ float wave_sum(float v) {
#pragma unroll
    for (int o = 1; o < 64; o <<= 1) v += __shfl_xor(v, o);
    return v;
}
__device__ __forceinline__ float sigmoidf_(float x) { return 1.0f / (1.0f + __expf(-x)); }
__device__ __forceinline__ float softplusf_(float x) { return fmaxf(x, 0.f) + log1pf(__expf(-fabsf(x))); }

struct Args { const float* in[30]; float* out; unsigned char* ws; int ph_lo, ph_hi; };
typedef const __attribute__((address_space(4))) Args* KArgs;

__device__ __forceinline__ void cvt_item(const float* W, int ld, int c0, int ncols, int K, bf16* WT, int kind, LAS float* scr, int item, int nnb, int lane) {
    const int kb = item / nnb, nb = item % nnb, k0 = 64 * kb, n0 = 32 * nb;
    const int nn = n0 + (lane & 31); const bool ok = nn < ncols;
#pragma unroll 8
    for (int i = 0; i < 32; ++i) { const int kk = 2 * i + (lane >> 5); scr[kk * 33 + (lane & 31)] = ok ? W[(size_t)(k0 + kk) * ld + c0 + nn] : 0.f; }
    LDS_WAIT(); asm volatile("" ::: "memory");
    const int c = lane & 7;
    const int drow0 = (kind == 0) ? n0 : (256 * (n0 >> 7) + (n0 & 127) + (kind == 2 ? 128 : 0));
#pragma unroll
    for (int j = 0; j < 4; ++j) { const int n = (lane >> 3) + 8 * j; const LAS float* s = scr + (8 * c) * 33 + n;
        v4u o; o.x = pk2(s[0 * 33], s[1 * 33]); o.y = pk2(s[2 * 33], s[3 * 33]); o.z = pk2(s[4 * 33], s[5 * 33]); o.w = pk2(s[6 * 33], s[7 * 33]);
        *(GAS v4u*)(WT + (size_t)(drow0 + n) * K + k0 + 8 * c) = o; }
    LDS_WAIT(); asm volatile("" ::: "memory");
}
__device__ __forceinline__ void convert_weights(KArgs a, int L, LAS unsigned char* lds, int wave, int lane, int gw, int NGW) {
    LAS float* scr = (LAS float*)(lds + wave * 8704);
    unsigned char* wb = a->ws + WS_W;
    constexpr int I_W1 = 16 * 88, I_W2 = 44 * 32, I_WIN = 16 * 176, I_WG = 16 * 96, I_BR = 8 * 32, I_O = 16 * 32, I_PP = 4 * 32;
    constexpr int NIT = 4 * I_W1 + 2 * I_W2 + I_WIN + I_WG + 3 * I_BR + 2 * I_O + I_PP;
    for (int it = gw; it < NIT; it += NGW) {
        int r = it;
        if (r < 4 * I_W1) { const int q = r / I_W1, s = q >> 1, w3 = q & 1; r -= q * I_W1;
            cvt_item((w3 ? a->in[5] : a->in[4]) + (size_t)(L * 2 + s) * 1024 * 2816, 2816, 0, 2816, 1024, (bf16*)(wb + (s ? WO_W13_1 : WO_W13_0)), 1 + w3, scr, r, 88, lane); continue; }
        r -= 4 * I_W1;
        if (r < 2 * I_W2) { const int s = r / I_W2; r -= s * I_W2;
            cvt_item(a->in[6] + (size_t)(L * 2 + s) * 2816 * 1024, 1024, 0, 1024, 2816, (bf16*)(wb + (s ? WO_W2_1 : WO_W2_0)), 0, scr, r, 32, lane); continue; }
        r -= 2 * I_W2;
        if (r < I_WIN) { cvt_item(a->in[7] + (size_t)L * 1024 * DIN, DIN, 0, NMIX, 1024, (bf16*)(wb + WO_WIN), 0, scr, r, 176, lane); continue; }
        r -= I_WIN;
        if (r < I_WG) { cvt_item(a->in[7] + (size_t)L * 1024 * DIN, DIN, NMIX, NGATE, 1024, (bf16*)(wb + WO_WG), 0, scr, r, 96, lane); continue; }
        r -= I_WG;
        if (r < 3 * I_BR) { const int b = r / I_BR; r -= b * I_BR;
            cvt_item(a->in[26] + (size_t)(L * 3 + b) * 512 * 1024, 1024, 0, 1024, 512, (bf16*)(wb + WO_WBR) + (size_t)b * 1024 * 512, 0, scr, r, 32, lane); continue; }
        r -= 3 * I_BR;
        if (r < I_O) { cvt_item(a->in[27] + (size_t)L * 1024 * 1024, 1024, 0, 1024, 1024, (bf16*)(wb + WO_WO), 0, scr, r, 32, lane); continue; }
        r -= I_O;
        if (r < I_O) { cvt_item(a->in[28] + (size_t)L * 1024 * 1024, 1024, 0, 1024, 1024, (bf16*)(wb + WO_WPG), 0, scr, r, 32, lane); continue; }
        r -= I_O;
        cvt_item(a->in[29] + (size_t)L * 256 * 1024, 1024, 0, 1024, 256, (bf16*)(wb + WO_WPP), 0, scr, r, 32, lane);
    }
}
template <bool NORM>
__device__ __forceinline__ void row_pass(const float* src, float* dst, bf16* dstb, const float* g, const float* bta, int lane) {
    const GAS f32x4* xr = (const GAS f32x4*)src + lane;
    f32x4 v[4]; float s = 0.f;
#pragma unroll
    for (int j = 0; j < 4; ++j) { v[j] = xr[64 * j]; s += (v[j].x + v[j].y) + (v[j].z + v[j].w); }
    if (NORM) {
        const float mean = wave_sum(s) * (1.f / D); float s2 = 0.f;
#pragma unroll
        for (int j = 0; j < 4; ++j) { v[j] = v[j] - mean; s2 += (v[j].x * v[j].x + v[j].y * v[j].y) + (v[j].z * v[j].z + v[j].w * v[j].w); }
        const float rstd = 1.f / sqrtf(wave_sum(s2) * (1.f / D) + LN_EPS);
#pragma unroll
        for (int j = 0; j < 4; ++j) { const f32x4 gg = ((const GAS f32x4*)g)[lane + 64 * j], bb = ((const GAS f32x4*)bta)[lane + 64 * j]; v[j] = v[j] * rstd * gg + bb; }
    }
    GAS f32x4* o4 = (GAS f32x4*)dst + lane;
    GAS unsigned long long* o8 = (GAS unsigned long long*)dstb + lane;
#pragma unroll
    for (int j = 0; j < 4; ++j) { o4[64 * j] = v[j]; o8[64 * j] = (unsigned long long)pk2(v[j].x, v[j].y) | ((unsigned long long)pk2(v[j].z, v[j].w) << 32); }
}

constexpr int CH = 16;
__device__ __forceinline__ void mix_rwkv(KArgs a, int L, int b, int h, LAS float* sm, int tid) {
    const bf16* hm = (const bf16*)(a->ws + WS_R); bf16* out = (bf16*)(a->ws + WS_O);
    const int lane = tid & 63, wid = tid >> 6;
    LAS float* w2h = sm; LAS float* a2h = sm + 4096; LAS float* g2h = sm + 8192;
    LAS float* tw = sm + 18432; LAS float* al = tw + 1024; LAS float* gl = al + 1024;
    LAS float* sr = gl + 2560; LAS float* skr = sr + 1024; LAS float* sv = skr + 1024; LAS float* sd = sv + 1024; LAS float* sa = sd + 1024; LAS float* sb = sa + 1024;
    LAS float* sk2 = sb + 1024; LAS float* sg = sk2 + 1024; LAS float* sbon = sg + 1024; LAS float* sy = sbon + 1024;
    const float* mu = a->in[8] + L * 1824;
    for (int e = tid; e < 64 * 64; e += NTHREADS) { const int i = e >> 6, j = e & 63; w2h[e] = a->in[10][(size_t)(L * 64 + i) * 512 + h * 64 + j]; a2h[e] = a->in[12][(size_t)(L * 64 + i) * 512 + h * 64 + j]; }
    for (int e = tid; e < 160 * 64; e += NTHREADS) { const int i = e >> 6, j = e & 63; g2h[e] = a->in[13][(size_t)(L * 160 + i) * 512 + h * 64 + j]; }
    const int hj = L * 512 + h * 64 + lane;
    const float w0j = a->in[9][hj], a0j = a->in[11][hj], kkj = a->in[14][hj], kaj = a->in[15][hj], rkj = a->in[16][hj], gngj = a->in[17][hj], gnbj = a->in[18][hj];
    float S[8];
#pragma unroll
    for (int i = 0; i < 8; ++i) S[i] = 0.f;
    const int vrow = tid >> 3, kg = tid & 7;
    __syncthreads();
#pragma unroll 1
    for (int c = 0; c < SEQ / CH; ++c) {
        const int t0 = c * CH;
        for (int e = tid; e < CH * 480; e += NTHREADS) {
            const int tt = e / 480, cc = e % 480, t = t0 + tt;
            int col; if (cc < 64) col = h * 64 + cc; else if (cc < 128) col = 512 + h * 64 + (cc - 64); else if (cc < 192) col = 1024 + h * 64 + (cc - 128); else col = 1536 + (cc - 192);
            const size_t ro = (size_t)(b * SEQ + t) * LDH + C_RW + col;
            const float cur = b2f(hm[ro]), prev = t > 0 ? b2f(hm[ro - LDH]) : 0.f;
            const float xs = cur + (prev - cur) * mu[col];
            if (cc < 64) sr[tt * 64 + cc] = xs; else if (cc < 128) skr[tt * 64 + cc - 64] = xs; else if (cc < 192) sv[tt * 64 + cc - 128] = xs;
            else if (cc < 256) tw[tt * 64 + cc - 192] = tanhf(xs); else if (cc < 320) al[tt * 64 + cc - 256] = xs; else gl[tt * 160 + cc - 320] = sigmoidf_(xs);
        }
        __syncthreads();
#pragma unroll
        for (int i2 = 0; i2 < 2; ++i2) {
            const int tt = wid + 8 * i2;
            float w = w0j, av = a0j, g = 0.f;
#pragma unroll 4
            for (int i = 0; i < 64; ++i) { w += tw[tt * 64 + i] * w2h[i * 64 + lane]; av += al[tt * 64 + i] * a2h[i * 64 + lane]; }
#pragma unroll 4
            for (int i = 0; i < 160; ++i) g += gl[tt * 160 + i] * g2h[i * 64 + lane];
            const float wl = -softplusf_(-w) - 0.5f, dec = __expf(-__expf(wl)), asig = sigmoidf_(av);
            const float kraw = skr[tt * 64 + lane], kkr = kraw * kkj;
            const float kk = kkr * (1.0f / sqrtf(wave_sum(kkr * kkr) + 1e-6f));
            const float k2 = kraw * (1.f + (asig - 1.f) * kaj);
            const float rk = wave_sum(sr[tt * 64 + lane] * k2 * rkj);
            sd[tt * 64 + lane] = dec; sa[tt * 64 + lane] = -kk; sb[tt * 64 + lane] = kk * asig; sk2[tt * 64 + lane] = k2; sg[tt * 64 + lane] = g; sbon[tt * 64 + lane] = rk * sv[tt * 64 + lane];
        }
        __syncthreads();
#pragma unroll 1
        for (int tt = 0; tt < CH; ++tt) {
            const int o = tt * 64 + kg * 8;
            float x = 0.f;
#pragma unroll
            for (int i = 0; i < 8; ++i) x += S[i] * sa[o + i];
            x += __shfl_xor(x, 1); x += __shfl_xor(x, 2); x += __shfl_xor(x, 4);
            const float vv = sv[tt * 64 + vrow];
            float y = 0.f;
#pragma unroll
            for (int i = 0; i < 8; ++i) { S[i] = S[i] * sd[o + i] + x * sb[o + i] + vv * sk2[o + i]; y += S[i] * sr[o + i]; }
            y += __shfl_xor(y, 1); y += __shfl_xor(y, 2); y += __shfl_xor(y, 4);
            if (kg == 0) sy[tt * 64 + vrow] = y;
        }
        __syncthreads();
#pragma unroll
        for (int i2 = 0; i2 < 2; ++i2) {
            const int tt = wid + 8 * i2;
            const float y = sy[tt * 64 + lane], mean = wave_sum(y) * (1.f / 64.f), dv = y - mean, var = wave_sum(dv * dv) * (1.f / 64.f);
            const float yn = dv * (1.0f / sqrtf(var + 64e-5f)) * gngj + gnbj;
            const float o = (yn + sbon[tt * 64 + lane]) * sg[tt * 64 + lane];
            out[(size_t)(b * SEQ + t0 + tt) * 512 + h * 64 + lane] = (bf16)f2bf(o);
        }
        __syncthreads();
    }
}
__device__ __forceinline__ void mix_gla(KArgs a, int L, int b, int h, LAS float* sm, int tid) {
    const bf16* hm = (const bf16*)(a->ws + WS_R); bf16* out = (bf16*)(a->ws + WS_O) + (size_t)M * 512;
    const int lane = tid & 63, wid = tid >> 6;
    LAS float* gkw = sm; LAS float* sq = sm + 1024; LAS float* sk = sq + 1024; LAS float* sdec = sk + 1024; LAS float* sv = sdec + 1024; LAS float* sgt = sv + 2048; LAS float* so = sgt + 2048; LAS float* gkl = so + 2048;
    for (int e = tid; e < 16 * 64; e += NTHREADS) { const int i = e >> 6, j = e & 63; gkw[e] = a->in[19][(size_t)(L * 16 + i) * 256 + h * 64 + j]; }
    const float gkbj = a->in[20][L * 256 + h * 64 + lane];
    const float ng0 = a->in[21][L * 128 + lane], ng1 = a->in[21][L * 128 + 64 + lane];
    float S[16];
#pragma unroll
    for (int i = 0; i < 16; ++i) S[i] = 0.f;
    const int vc = tid >> 2, kg = tid & 3;
    __syncthreads();
#pragma unroll 1
    for (int c = 0; c < SEQ / CH; ++c) {
        const int t0 = c * CH;
        for (int e = tid; e < CH * 400; e += NTHREADS) {
            const int tt = e / 400, cc = e % 400;
            int col; if (cc < 64) col = h * 64 + cc; else if (cc < 128) col = 256 + h * 64 + (cc - 64); else if (cc < 256) col = 512 + h * 128 + (cc - 128); else if (cc < 272) col = 1024 + (cc - 256); else col = 1040 + h * 128 + (cc - 272);
            const float x = b2f(hm[(size_t)(b * SEQ + t0 + tt) * LDH + C_GLA + col]);
            if (cc < 64) sq[tt * 64 + cc] = x; else if (cc < 128) sk[tt * 64 + cc - 64] = x; else if (cc < 256) sv[tt * 128 + cc - 128] = x; else if (cc < 272) gkl[tt * 16 + cc - 256] = x; else sgt[tt * 128 + cc - 272] = x;
        }
        __syncthreads();
#pragma unroll
        for (int i2 = 0; i2 < 2; ++i2) {
            const int tt = wid + 8 * i2;
            float z = gkbj;
#pragma unroll
            for (int i = 0; i < 16; ++i) z += gkl[tt * 16 + i] * gkw[i * 64 + lane];
            sdec[tt * 64 + lane] = __expf(-softplusf_(-z) * (1.f / 16.f));
        }
        __syncthreads();
#pragma unroll 1
        for (int tt = 0; tt < CH; ++tt) {
            const int o = tt * 64 + kg * 16; const float vv = sv[tt * 128 + vc];
            float y = 0.f;
#pragma unroll
            for (int i = 0; i < 16; ++i) { S[i] = S[i] * sdec[o + i] + sk[o + i] * vv; y += S[i] * sq[o + i]; }
            y += __shfl_xor(y, 1); y += __shfl_xor(y, 2);
            if (kg == 0) so[tt * 128 + vc] = y * 0.125f;
        }
        __syncthreads();
#pragma unroll
        for (int i2 = 0; i2 < 2; ++i2) {
            const int tt = wid + 8 * i2;
            const float o0 = so[tt * 128 + lane], o1 = so[tt * 128 + 64 + lane];
            const float rs = 1.0f / sqrtf(wave_sum(o0 * o0 + o1 * o1) * (1.f / 128.f) + 1e-6f);
            const float g0 = sgt[tt * 128 + lane], g1 = sgt[tt * 128 + 64 + lane];
            bf16* op = out + (size_t)(b * SEQ + t0 + tt) * 512 + h * 128;
            op[lane] = (bf16)f2bf(o0 * rs * ng0 * g0 * sigmoidf_(g0)); op[64 + lane] = (bf16)f2bf(o1 * rs * ng1 * g1 * sigmoidf_(g1));
        }
        __syncthreads();
    }
}
__device__ __forceinline__ void mix_gdn(KArgs a, int L, int b, int h, LAS float* sm, int tid) {
    const bf16* hm = (const bf16*)(a->ws + WS_R); bf16* out = (bf16*)(a->ws + WS_O) + (size_t)2 * M * 512;
    const int lane = tid & 63, wid = tid >> 6;
    LAS float* raw = sm;
    LAS float* sq = sm + 7296; LAS float* sk = sq + 2048; LAS float* sv = sk + 2048; LAS float* sgt = sv + 2048; LAS float* so = sgt + 2048; LAS float* sal = so + 2048; LAS float* sbe = sal + 16;
    const float* cw = a->in[22] + (size_t)L * 4 * 1536;
    const float Ah = __expf(a->in[23][L * 4 + h]), dtb = a->in[24][L * 4 + h];
    const float ng0 = a->in[25][L * 128 + lane], ng1 = a->in[25][L * 128 + 64 + lane];
    float S[32];
#pragma unroll
    for (int i = 0; i < 32; ++i) S[i] = 0.f;
    const int vc = tid >> 2, kg = tid & 3;
#pragma unroll 1
    for (int c = 0; c < SEQ / CH; ++c) {
        const int t0 = c * CH;
        for (int e = tid; e < 19 * 384; e += NTHREADS) {
            const int rr = e / 384, cc = e % 384, t = t0 - 3 + rr;
            const int col = (cc < 128) ? (h * 128 + cc) : (cc < 256 ? 512 + h * 128 + (cc - 128) : 1024 + h * 128 + (cc - 256));
            raw[e] = t >= 0 ? b2f(hm[(size_t)(b * SEQ + t) * LDH + C_GDN + col]) : 0.f;
        }
        for (int e = tid; e < CH * 128; e += NTHREADS) { const int tt = e >> 7, cc = e & 127; sgt[e] = b2f(hm[(size_t)(b * SEQ + t0 + tt) * LDH + C_GDN + 1544 + h * 128 + cc]); }
        if (tid < CH) {
            const size_t ro = (size_t)(b * SEQ + t0 + tid) * LDH + C_GDN;
            const float ai = b2f(hm[ro + 1536 + h]), bi = b2f(hm[ro + 1540 + h]);
            sal[tid] = __expf(-Ah * softplusf_(ai + dtb)); sbe[tid] = sigmoidf_(bi);
        }
        __syncthreads();
        for (int e = tid; e < CH * 384; e += NTHREADS) {
            const int tt = e / 384, cc = e % 384;
            const int ch = (cc < 128) ? (h * 128 + cc) : (cc < 256 ? 512 + h * 128 + (cc - 128) : 1024 + h * 128 + (cc - 256));
            float s = 0.f;
#pragma unroll
            for (int i = 0; i < 4; ++i) s += cw[i * 1536 + ch] * raw[(tt + i) * 384 + cc];
            s = s * sigmoidf_(s);
            if (cc < 128) sq[tt * 128 + cc] = s; else if (cc < 256) sk[tt * 128 + cc - 128] = s; else sv[tt * 128 + cc - 256] = s;
        }
        __syncthreads();
#pragma unroll
        for (int i2 = 0; i2 < 2; ++i2) {
            const int tt = wid + 8 * i2;
            const float q0 = sq[tt * 128 + lane], q1 = sq[tt * 128 + 64 + lane], k0 = sk[tt * 128 + lane], k1 = sk[tt * 128 + 64 + lane];
            const float rq = (1.0f / sqrtf(wave_sum(q0 * q0 + q1 * q1) + 1e-6f)) * 0.08838834764831845f, rk = 1.0f / sqrtf(wave_sum(k0 * k0 + k1 * k1) + 1e-6f);
            sq[tt * 128 + lane] = q0 * rq; sq[tt * 128 + 64 + lane] = q1 * rq; sk[tt * 128 + lane] = k0 * rk; sk[tt * 128 + 64 + lane] = k1 * rk;
        }
        __syncthreads();
#pragma unroll 1
        for (int tt = 0; tt < CH; ++tt) {
            const int o = tt * 128 + kg * 32; const float al = sal[tt], be = sbe[tt];
            float p = 0.f;
#pragma unroll
            for (int i = 0; i < 32; ++i) { S[i] *= al; p += S[i] * sk[o + i]; }
            p += __shfl_xor(p, 1); p += __shfl_xor(p, 2);
            const float vn = be * (sv[tt * 128 + vc] - p);
            float y = 0.f;
#pragma unroll
            for (int i = 0; i < 32; ++i) { S[i] += sk[o + i] * vn; y += S[i] * sq[o + i]; }
            y += __shfl_xor(y, 1); y += __shfl_xor(y, 2);
            if (kg == 0) so[tt * 128 + vc] = y;
        }
        __syncthreads();
#pragma unroll
        for (int i2 = 0; i2 < 2; ++i2) {
            const int tt = wid + 8 * i2;
            const float o0 = so[tt * 128 + lane], o1 = so[tt * 128 + 64 + lane];
            const float rs = 1.0f / sqrtf(wave_sum(o0 * o0 + o1 * o1) * (1.f / 128.f) + 1e-6f);
            const float g0 = sgt[tt * 128 + lane], g1 = sgt[tt * 128 + 64 + lane];
            bf16* op = out + (size_t)(b * SEQ + t0 + tt) * 512 + h * 128;
            op[lane] = (bf16)f2bf(o0 * rs * ng0 * g0 * sigmoidf_(g0)); op[64 + lane] = (bf16)f2bf(o1 * rs * ng1 * g1 * sigmoidf_(g1));
        }
        __syncthreads();
    }
}

constexpr int PH_PER_LAYER = 15, N_PHASES = 1 + DEPTH * PH_PER_LAYER;
#ifndef MK_SINGLE
#define MK_SINGLE 0
#endif
__global__ void __launch_bounds__(NTHREADS, 2) mk_fwd(Args args) {
    extern __shared__ __attribute__((aligned(16))) unsigned char lds_raw[];
    LAS unsigned char* lds = (LAS unsigned char*)lds_raw;
#if MK_SINGLE
    cg::grid_group grid = cg::this_grid();
#endif
#pragma unroll 1
    for (int ph = args.ph_lo; ph < args.ph_hi; ++ph) {
        int tid = threadIdx.x; asm volatile("" : "+v"(tid));
        const int lane = tid & 63, wave = __builtin_amdgcn_readfirstlane(tid >> 6);
        int G = gridDim.x, bid = blockIdx.x;
        KArgs ap = (KArgs)__builtin_amdgcn_kernarg_segment_ptr();
        asm volatile("" : "+s"(G), "+s"(bid), "+s"(ap));
        unsigned char* ws = ap->ws; float* X = ap->out;
        const int gw = bid * NWAVES + wave, NGW = G * NWAVES;
        unsigned char* wb = ws + WS_W;
        bf16* XB = (bf16*)(ws + WS_XB);
        int L = 0, q = 0;
        if (ph > 0) { L = (ph - 1) / PH_PER_LAYER; q = (ph - 1) % PH_PER_LAYER + 1; }
        const int s = q >= 10 ? 1 : 0;
        if (q == 0) {
            convert_weights(ap, 0, lds, wave, lane, gw, NGW);
            for (int m = gw; m < M; m += NGW) row_pass<false>(ap->in[0] + (size_t)m * D, X + (size_t)m * D, XB + (size_t)m * D, nullptr, nullptr, lane);
        } else if (q == 1 || q == 10) {
            pg8::Gemm g{XB, (const bf16*)(wb + (s ? WO_W13_1 : WO_W13_0)), M, 5632, D}; pg8::StaticOrder S; S.init(M, 5632, G, bid);
            pg8::EpiSwiGLU E{(bf16*)(ws + WS_R), FF};
            pg8::gemm_phase<pg8::EpiSwiGLU, pg8::StaticOrder, true, true>(lds, g, S, E, tid);
        } else if (q == 2 || q == 11) {
            pg8::Gemm g{(const bf16*)(ws + WS_R), (const bf16*)(wb + (s ? WO_W2_1 : WO_W2_0)), M, D, FF}; pg8::StaticOrder S; S.init(M, D, G, bid);
            pg8::EpiResid E{X, ALPHA, 0.5f};
            pg8::gemm_phase<pg8::EpiResid, pg8::StaticOrder, true, true>(lds, g, S, E, tid);
        } else if (q == 3 || q == 9 || q == 12 || q == 15) {
            const int li = q == 3 ? 0 : (q == 9 ? 1 : (q == 12 ? 2 : 3));
            const float* lng = ap->in[2] + (size_t)(L * 4 + li) * D; const float* lnb = ap->in[3] + (size_t)(L * 4 + li) * D;
            for (int m = gw; m < M; m += NGW) row_pass<true>(X + (size_t)m * D, X + (size_t)m * D, XB + (size_t)m * D, lng, lnb, lane);
            if (q == 12) {
                const float* ps = ap->in[1] + (size_t)L * M * PLE; bf16* pd = (bf16*)(ws + WS_R);
                for (size_t e = (size_t)(bid * NTHREADS + tid) * 4; e < (size_t)M * PLE; e += (size_t)G * NTHREADS * 4) {
                    const f32x4 v = *(const GAS f32x4*)(ps + e);
                    *(GAS unsigned long long*)(pd + e) = (unsigned long long)pk2(v.x, v.y) | ((unsigned long long)pk2(v.z, v.w) << 32);
                }
            }
            if (q == 15 && L + 1 < DEPTH) convert_weights(ap, L + 1, lds, wave, lane, gw, NGW);
        } else if (q == 4) {
            pg8::Gemm g{XB, (const bf16*)(wb + WO_WIN), M, LDH, D}; pg8::StaticOrder S; S.init(M, LDH, G, bid);
            pg8::EpiStore<0> E{(bf16*)(ws + WS_R), LDH};
            pg8::gemm_phase<pg8::EpiStore<0>, pg8::StaticOrder, true, true>(lds, g, S, E, tid);
        } else if (q == 5) {
            if (bid < 32) mix_rwkv(ap, L, bid >> 3, bid & 7, (LAS float*)lds, tid);
            else if (bid < 48) mix_gla(ap, L, (bid - 32) >> 2, (bid - 32) & 3, (LAS float*)lds, tid);
            else if (bid < 64) mix_gdn(ap, L, (bid - 48) >> 2, (bid - 48) & 3, (LAS float*)lds, tid);
        } else if (q == 6) {
            pg8::Gemm g{XB, (const bf16*)(wb + WO_WG), M, NGATE, D}; pg8::StaticOrder S; S.init(M, NGATE, G, bid);
            pg8::EpiStore<2> E{(bf16*)(ws + WS_R), NGATE};
            pg8::gemm_phase<pg8::EpiStore<2>, pg8::StaticOrder, true, true>(lds, g, S, E, tid);
        } else if (q == 7) {
            pg8::Gemm g{(const bf16*)(ws + WS_O), (const bf16*)(wb + WO_WBR), 3 * M, 3 * 1024, 512}; pg8::BranchOrder S; S.init(G, bid);
            pg8::EpiBranch E{(const bf16*)(ws + WS_R), (float*)(ws + WS_R_ACC), XB};
            pg8::gemm_phase<pg8::EpiBranch, pg8::BranchOrder, true, true>(lds, g, S, E, tid);
        } else if (q == 8) {
            pg8::Gemm g{XB, (const bf16*)(wb + WO_WO), M, D, D}; pg8::StaticOrder S; S.init(M, D, G, bid);
            pg8::EpiResid E{X, ALPHA, 1.0f};
            pg8::gemm_phase<pg8::EpiResid, pg8::StaticOrder, true, true>(lds, g, S, E, tid);
        } else if (q == 13) {
            int kple = PLE; asm volatile("" : "+s"(kple));
            pg8::Gemm g{(const bf16*)(ws + WS_R), (const bf16*)(wb + WO_WPP), M, D, kple}; pg8::StaticOrder S; S.init(M, D, G, bid);
            pg8::EpiStore<0> E{(bf16*)(ws + WS_R_PP), D};
            pg8::gemm_phase<pg8::EpiStore<0>, pg8::StaticOrder, true, true>(lds, g, S, E, tid);
        } else if (q == 14) {
            pg8::Gemm g{XB, (const bf16*)(wb + WO_WPG), M, D, D}; pg8::StaticOrder S; S.init(M, D, G, bid);
            pg8::EpiPle E{X, (const bf16*)(ws + WS_R_PP), ALPHA};
            pg8::gemm_phase<pg8::EpiPle, pg8::StaticOrder, true, true>(lds, g, S, E, tid);
        }
#if MK_SINGLE
        if (ph + 1 < args.ph_hi) grid.sync();
#endif
    }
}

#ifdef MK_DEBUG
constexpr size_t WS_SAVE = WS_R + 100 * MiB;
__device__ __forceinline__ unsigned hsh(unsigned x) { x ^= x >> 16; x *= 0x7feb352du; x ^= x >> 15; x *= 0x846ca68bu; x ^= x >> 16; return x; }
__device__ __forceinline__ void dbg_report(float* dbg, int kind, float got, float ref, int lane) {
    const float rel = fabsf(got - ref) / (fabsf(ref) + 0.5f);
    if (lane == 0) atomicMax((unsigned*)dbg + kind, __float_as_uint(rel));
}
__global__ void __launch_bounds__(512) dbg_check(Args a, int kind, int L, int s, int li) {
    const int lane = threadIdx.x & 63, wave = threadIdx.x >> 6;
    unsigned char* ws = a.ws; float* dbg = (float*)ws;
    const bf16* XB = (const bf16*)(ws + WS_XB); const float* X = a.out; const float* SV = (const float*)(ws + WS_SAVE);
    for (int smp = blockIdx.x * 8 + wave; smp < 512; smp += gridDim.x * 8) {
        const unsigned hh = hsh(smp * 2654435761u + kind * 977u);
        const int r = hh % M; const unsigned h2 = hsh(hh + 12345u);
        if (kind == 1) {
            const int c = h2 % FF; const float* w1 = a.in[4] + (size_t)(L * 2 + s) * 1024 * FF; const float* w3 = a.in[5] + (size_t)(L * 2 + s) * 1024 * FF;
            float g = 0.f, u = 0.f;
            for (int k = lane; k < 1024; k += 64) { const float x = b2f(XB[(size_t)r * 1024 + k]); g += x * w1[(size_t)k * FF + c]; u += x * w3[(size_t)k * FF + c]; }
            g = wave_sum(g); u = wave_sum(u);
            dbg_report(dbg, kind, b2f(((const bf16*)(ws + WS_R))[(size_t)r * FF + c]), g * sigmoidf_(g) * u, lane);
        } else if (kind == 2) {
            const int c = h2 % D; const float* w2 = a.in[6] + (size_t)(L * 2 + s) * FF * 1024; const bf16* H = (const bf16*)(ws + WS_R);
            float acc = 0.f;
            for (int k = lane; k < FF; k += 64) acc += b2f(H[(size_t)r * FF + k]) * w2[(size_t)k * 1024 + c];
            acc = wave_sum(acc);
            dbg_report(dbg, kind, X[(size_t)r * D + c], ALPHA * SV[(size_t)r * D + c] + 0.5f * acc, lane);
        } else if (kind == 3) {
            const int c = h2 % D; float sm = 0.f, sq = 0.f;
            for (int k = lane; k < D; k += 64) { const float v = SV[(size_t)r * D + k]; sm += v; }
            const float mean = wave_sum(sm) / D;
            for (int k = lane; k < D; k += 64) { const float v = SV[(size_t)r * D + k] - mean; sq += v * v; }
            const float rstd = 1.0f / sqrtf(wave_sum(sq) / D + LN_EPS);
            const float ref = (SV[(size_t)r * D + c] - mean) * rstd * a.in[2][(size_t)(L * 4 + li) * D + c] + a.in[3][(size_t)(L * 4 + li) * D + c];
            dbg_report(dbg, kind, X[(size_t)r * D + c], ref, lane);
            dbg_report(dbg, kind, b2f(XB[(size_t)r * D + c]), ref, lane);
        } else if (kind == 4) {
            const int c = h2 % NMIX; const float* w = a.in[7] + (size_t)L * 1024 * DIN; float acc = 0.f;
            for (int k = lane; k < 1024; k += 64) acc += b2f(XB[(size_t)r * 1024 + k]) * w[(size_t)k * DIN + c];
            acc = wave_sum(acc);
            dbg_report(dbg, kind, b2f(((const bf16*)(ws + WS_R))[(size_t)r * LDH + c]), acc, lane);
        } else if (kind == 5) {
            const int c = h2 % NGATE; const float* w = a.in[7] + (size_t)L * 1024 * DIN; float acc = 0.f;
            for (int k = lane; k < 1024; k += 64) acc += b2f(XB[(size_t)r * 1024 + k]) * w[(size_t)k * DIN + NMIX + c];
            acc = wave_sum(acc);
            dbg_report(dbg, kind, b2f(((const bf16*)(ws + WS_R))[(size_t)r * NGATE + c]), sigmoidf_(acc), lane);
        } else if (kind == 6) {
            const int c = h2 % D; const bf16* G = (const bf16*)(ws + WS_R); const bf16* O = (const bf16*)(ws + WS_O); float tot = 0.f;
            for (int b = 0; b < 3; ++b) { const float* w = a.in[26] + (size_t)(L * 3 + b) * 512 * 1024; float acc = 0.f;
                for (int k = lane; k < 512; k += 64) acc += b2f(O[((size_t)b * M + r) * 512 + k]) * w[(size_t)k * 1024 + c];
                tot += b2f(G[(size_t)r * NGATE + b * 1024 + c]) * wave_sum(acc); }
            dbg_report(dbg, kind, b2f(XB[(size_t)r * D + c]), tot, lane);
        } else if (kind == 7) {
            const int c = h2 % D; const float* w = a.in[27] + (size_t)L * 1024 * 1024; float acc = 0.f;
            for (int k = lane; k < 1024; k += 64) acc += b2f(XB[(size_t)r * 1024 + k]) * w[(size_t)k * 1024 + c];
            acc = wave_sum(acc);
            dbg_report(dbg, kind, X[(size_t)r * D + c], ALPHA * SV[(size_t)r * D + c] + acc, lane);
        } else if (kind == 8) {
            const int c = h2 % D; const float* w = a.in[29] + (size_t)L * 256 * 1024; const float* p = a.in[1] + (size_t)L * M * PLE; float acc = 0.f;
            for (int k = lane; k < 256; k += 64) acc += p[(size_t)r * PLE + k] * w[(size_t)k * 1024 + c];
            acc = wave_sum(acc);
            dbg_report(dbg, kind, b2f(((const bf16*)(ws + WS_R_PP))[(size_t)r * D + c]), acc, lane);
        } else if (kind == 9) {
            const int c = h2 % D; const float* w = a.in[28] + (size_t)L * 1024 * 1024; const float* wp = a.in[29] + (size_t)L * 256 * 1024; const float* p = a.in[1] + (size_t)L * M * PLE; float acc = 0.f, pp = 0.f;
            for (int k = lane; k < 1024; k += 64) acc += b2f(XB[(size_t)r * 1024 + k]) * w[(size_t)k * 1024 + c];
            for (int k = lane; k < 256; k += 64) pp += p[(size_t)r * PLE + k] * wp[(size_t)k * 1024 + c];
            acc = wave_sum(acc); pp = wave_sum(pp);
            dbg_report(dbg, kind, X[(size_t)r * D + c], ALPHA * SV[(size_t)r * D + c] + sigmoidf_(acc) * pp, lane);
        }
    }
}
__global__ void dbg_inject(Args a) {
    if (threadIdx.x == 0 && blockIdx.x == 0) {
        const float* dbg = (const float*)a.ws; int code = 0;
        for (int k = 1; k <= 9; ++k) if (code == 0 && dbg[k] > MK_DEBUG_TOL) code = k;
#ifdef MK_DEBUG_SEL
        a.out[0] += 1.0e5f * dbg[MK_DEBUG_SEL];
#else
        a.out[0] += 1.0e4f * code;
#endif
    }
}
#endif
extern "C" void kernel_launch(void* const* d_in, const int* in_sizes, int n_in, void* d_out, int out_size, void* d_ws, size_t ws_size, hipStream_t stream) {
    static int grid = 0;
    if (grid == 0) {
        if (n_in != 30 || out_size != M * D || ws_size < WS_END) { fprintf(stderr, "kernel_launch: unexpected problem: n_in %d out %d ws %zu\n", n_in, out_size, ws_size); grid = -1; return; }
        int dev = 0, cus = 0, per_cu = 0;
        (void)hipGetDevice(&dev); (void)hipDeviceGetAttribute(&cus, hipDeviceAttributeMultiprocessorCount, dev);
        (void)hipFuncSetAttribute((const void*)mk_fwd, hipFuncAttributeMaxDynamicSharedMemorySize, LDS_BYTES);
        (void)hipOccupancyMaxActiveBlocksPerMultiprocessor(&per_cu, (const void*)mk_fwd, NTHREADS, LDS_BYTES);
        (void)hipGetLastError();
        if (per_cu < 1) { fprintf(stderr, "kernel_launch: occupancy query says %d\n", per_cu); per_cu = 1; }
        grid = cus;
        if (grid > 256) grid = 256;
    }
    if (grid < 0) return;
    Args a{};
    for (int i = 0; i < 30; ++i) a.in[i] = (const float*)d_in[i];
    a.out = (float*)d_out; a.ws = (unsigned char*)d_ws;
#if MK_SINGLE
    a.ph_lo = 0; a.ph_hi = N_PHASES;
    void* kargs[] = {&a};
    hipError_t e = hipLaunchCooperativeKernel((const void*)mk_fwd, dim3(grid), dim3(NTHREADS), kargs, LDS_BYTES, stream);
    if (e != hipSuccess) fprintf(stderr, "cooperative launch failed: %s (grid %d)\n", hipGetErrorString(e), grid);
#else
#ifdef MK_DEBUG
    (void)hipMemsetAsync(d_ws, 0, 4096, stream);
#endif
    for (int ph = 0; ph < N_PHASES; ++ph) {
        a.ph_lo = ph; a.ph_hi = ph + 1;
#ifdef MK_DEBUG
        const int L_ = ph > 0 ? (ph - 1) / PH_PER_LAYER : 0, q_ = ph > 0 ? (ph - 1) % PH_PER_LAYER + 1 : 0;
        if (q_ == 2 || q_ == 11 || q_ == 8 || q_ == 14 || q_ == 3 || q_ == 9 || q_ == 12 || q_ == 15) (void)hipMemcpyAsync((char*)d_ws + WS_SAVE, d_out, (size_t)M * D * 4, hipMemcpyDeviceToDevice, stream);
#endif
        hipLaunchKernelGGL(mk_fwd, dim3(grid), dim3(NTHREADS), LDS_BYTES, stream, a);
#ifdef MK_DEBUG
        { int kind = 0, s_ = q_ >= 10 ? 1 : 0, li_ = q_ == 3 ? 0 : (q_ == 9 ? 1 : (q_ == 12 ? 2 : 3));
          if (q_ == 1 || q_ == 10) kind = 1; else if (q_ == 2 || q_ == 11) kind = 2; else if (q_ == 3 || q_ == 9 || q_ == 12 || q_ == 15) kind = 3; else if (q_ == 4) kind = 4; else if (q_ == 6) kind = 5;
          else if (q_ == 7) kind = 6; else if (q_ == 8) kind = 7; else if (q_ == 13) kind = 8; else if (q_ == 14) kind = 9;
          if (kind) hipLaunchKernelGGL(dbg_check, dim3(8), dim3(512), 0, stream, a, kind, L_, s_, li_); }
#endif
    }
#ifdef MK_DEBUG
    hipLaunchKernelGGL(dbg_inject, dim3(1), dim3(64), 0, stream, a);
#endif
#endif
}
```

```cpp
#define MK_SINGLE 1
#include <hip/hip_runtime.h>
#include <hip/hip_cooperative_groups.h>
#include <cstdio>
#include <cstdint>
namespace pg8 {
#define PG8_LAS __attribute__((address_space(3)))
typedef unsigned short bf16_t;
typedef short bf16x8 __attribute__((ext_vector_type(8)));
typedef float f32x4 __attribute__((ext_vector_type(4)));
typedef unsigned u32x4 __attribute__((ext_vector_type(4)));
constexpr int BM = 256, BK = 64, HALF = 128, HTB = HALF * BK * 2  , STAGE_BYTES = 8 * HTB, NXCD = 8, WGM = 8;

__host__ __device__ __forceinline__ int lds_byte(int r, int c) { const int st = (r >> 4) * 2 + (c >> 5), rr = r & 15, cc = c & 31, ob = rr * 64 + cc * 2; return st * 1024 + (ob ^ (((ob >> 9) & 1) << 5)); }
__host__ __device__ __forceinline__ void stage_rc(int b, int& R, int& C) { const int st = b / 1024, sb = b % 1024, swz = sb ^ (((sb >> 9) & 1) << 5); R = (st >> 1) * 16 + swz / 64; C = (st & 1) * 32 + (swz % 64) / 2; }
__host__ __device__ __forceinline__ int perm32(int rho) { const int n = rho >> 4, i = rho & 15; return 8 * (i >> 2) + 4 * n + (i & 3); }

struct Unit { int pm, pn; };
struct Gemm { const bf16_t* A; const bf16_t* Bt; int M, N, K; };

struct StaticOrder {
    int nM, nN, nwg, G, c;
    __host__ __device__ void init(int M, int N, int G_, int c_) { nM = M / BM; nN = N / BM; nwg = nM * nN; G = G_; c = c_; }
    __host__ __device__ bool next(int i, Unit& u) const {
        const long L = (long)i * G + c; if (L >= nwg) return false;
        int wgid = (int)L; { const int q = nwg / NXCD, r = nwg % NXCD, xcd = wgid % NXCD, off = wgid / NXCD; wgid = (xcd < r ? xcd * (q + 1) : r * (q + 1) + (xcd - r) * q) + off; }
        const int nig = WGM * nN, gid = wgid / nig, fm = gid * WGM, gsz = (nM - fm) < WGM ? (nM - fm) : WGM;
        u.pm = fm + ((wgid % nig) % gsz); u.pn = (wgid % nig) / gsz; return true;
    }
    __device__ __forceinline__ void a_ready(const Unit&) const {}
    __device__ __forceinline__ void done(const Unit&) const {}
};

__device__ __forceinline__ unsigned cvt_pk_bf16(float lo, float hi) { unsigned r; asm volatile("v_cvt_pk_bf16_f32 %0, %1, %2" : "=v"(r) : "v"(lo), "v"(hi)); return r; }
typedef unsigned u32x2 __attribute__((ext_vector_type(2)));
__device__ __forceinline__ float fsigmoid(float x) { return __builtin_amdgcn_rcpf(1.0f + __builtin_amdgcn_exp2f(-1.44269504f * x)); }
__device__ __forceinline__ unsigned bf16_sw(float f) { const unsigned u = __float_as_uint(f); return (u + 0x7fffu + ((u >> 16) & 1u)) >> 16; }
__device__ __forceinline__ unsigned pk_bf16_sw(float lo, float hi) { return bf16_sw(lo) | (bf16_sw(hi) << 16); }
__device__ __forceinline__ float bf2f(unsigned short u) { return __uint_as_float((unsigned)u << 16); }
__device__ __forceinline__ float bflo(unsigned w) { return __uint_as_float(w << 16); }
__device__ __forceinline__ float bfhi(unsigned w) { return __uint_as_float(w & 0xffff0000u); }

struct EpiSwiGLU {
    static constexpr bool PERM = true, AFTER_DRAIN = false;
    bf16_t* O; int ldc;
    __device__ __forceinline__ void operator()(const f32x4 (&acc)[2][2][4][2], const Unit& u, int wr, int wc, int fr, int fq) const {
        const int row0 = u.pm * BM + wr * 64 + fr, col0 = u.pn * HALF + wc * 32 + 8 * fq;
#pragma unroll
        for (int ai = 0; ai < 2; ++ai)
#pragma unroll
            for (int m = 0; m < 4; ++m) {
                bf16_t* rowp = O + (size_t)(row0 + ai * HALF + m * 16) * ldc + col0;
                const f32x4 g0 = acc[ai][0][m][0], g1 = acc[ai][0][m][1], u0 = acc[ai][1][m][0], u1 = acc[ai][1][m][1];
                float h[8];
#pragma unroll
                for (int e = 0; e < 4; ++e) { h[e] = g0[e] * fsigmoid(g0[e]) * u0[e]; h[4 + e] = g1[e] * fsigmoid(g1[e]) * u1[e]; }
                u32x4 w; w.x = cvt_pk_bf16(h[0], h[1]); w.y = cvt_pk_bf16(h[2], h[3]); w.z = cvt_pk_bf16(h[4], h[5]); w.w = cvt_pk_bf16(h[6], h[7]);
                *(u32x4*)rowp = w;
            }
    }
};
template <int ACT> struct EpiStore {
    static constexpr bool PERM = true, AFTER_DRAIN = false;
    bf16_t* O; int ldc;
    __device__ __forceinline__ void operator()(const f32x4 (&acc)[2][2][4][2], const Unit& u, int wr, int wc, int fr, int fq) const {
        const int row0 = u.pm * BM + wr * 64 + fr, col0 = u.pn * BM + wc * 32 + 8 * fq;
#pragma unroll
        for (int ai = 0; ai < 2; ++ai)
#pragma unroll
            for (int m = 0; m < 4; ++m) {
                bf16_t* rowp = O + (size_t)(row0 + ai * HALF + m * 16) * ldc + col0;
#pragma unroll
                for (int bj = 0; bj < 2; ++bj) {
                    f32x4 v0 = acc[ai][bj][m][0], v1 = acc[ai][bj][m][1];
                    if (ACT == 2) {
#pragma unroll
                        for (int e = 0; e < 4; ++e) { v0[e] = fsigmoid(v0[e]); v1[e] = fsigmoid(v1[e]); }
                    }
                    u32x4 w;
                    if (ACT == 2) { w.x = pk_bf16_sw(v0[0], v0[1]); w.y = pk_bf16_sw(v0[2], v0[3]); w.z = pk_bf16_sw(v1[0], v1[1]); w.w = pk_bf16_sw(v1[2], v1[3]); }
                    else { w.x = cvt_pk_bf16(v0[0], v0[1]); w.y = cvt_pk_bf16(v0[2], v0[3]); w.z = cvt_pk_bf16(v1[0], v1[1]); w.w = cvt_pk_bf16(v1[2], v1[3]); }
                    *(u32x4*)(rowp + bj * HALF) = w;
                }
            }
    }
};
struct EpiResid {
    static constexpr bool PERM = false, AFTER_DRAIN = false;
    float* X; float alpha, s;
    __device__ __forceinline__ void operator()(const f32x4 (&acc)[2][2][4][2], const Unit& u, int wr, int wc, int fr, int fq) const {
        const int col0 = u.pn * BM + wc * 32 + 4 * fq;
#pragma unroll
        for (int ai = 0; ai < 2; ++ai)
#pragma unroll
            for (int m = 0; m < 4; ++m) {
                const int r = u.pm * BM + ai * HALF + wr * 64 + m * 16 + fr; float* p = X + (size_t)r * 1024 + col0;
#pragma unroll
                for (int bj = 0; bj < 2; ++bj)
#pragma unroll
                    for (int n = 0; n < 2; ++n) { f32x4 v = *(const f32x4*)(p + bj * HALF + n * 16); v = v * alpha + acc[ai][bj][m][n] * s; *(f32x4*)(p + bj * HALF + n * 16) = v; }
                asm volatile("" ::: "memory");
            }
    }
};
struct EpiBranch {
    static constexpr bool PERM = false, AFTER_DRAIN = false;
    const bf16_t* G; float* ACC; bf16_t* MG;
    __device__ __forceinline__ void operator()(const f32x4 (&acc)[2][2][4][2], const Unit& u, int wr, int wc, int fr, int fq) const {
        const int b = u.pm >> 6, pm = u.pm & 63, pn = u.pn & 3;
        const int col0 = pn * BM + wc * 32 + 4 * fq;
#pragma unroll
        for (int ai = 0; ai < 2; ++ai)
#pragma unroll
            for (int m = 0; m < 4; ++m) {
                const int r = pm * BM + ai * HALF + wr * 64 + m * 16 + fr;
                float* pa = ACC + (size_t)r * 1024 + col0; const bf16_t* pg = G + (size_t)r * 3072 + b * 1024 + col0; bf16_t* po = MG + (size_t)r * 1024 + col0;
#pragma unroll
                for (int bj = 0; bj < 2; ++bj)
#pragma unroll
                    for (int n = 0; n < 2; ++n) {
                        const int o = bj * HALF + n * 16;
                        const u32x2 gw = *(const u32x2*)(pg + o);
                        f32x4 v = acc[ai][bj][m][n];
                        v[0] *= bflo(gw.x); v[1] *= bfhi(gw.x); v[2] *= bflo(gw.y); v[3] *= bfhi(gw.y);
#ifdef ZERO_BRANCH
                        if (b == ZERO_BRANCH) v = (f32x4){0.f, 0.f, 0.f, 0.f};
#endif
                        if (b > 0) v += *(const f32x4*)(pa + o);
                        if (b < 2) *(f32x4*)(pa + o) = v;
                        else { u32x2 w; w.x = cvt_pk_bf16(v[0], v[1]); w.y = cvt_pk_bf16(v[2], v[3]); *(u32x2*)(po + o) = w; }
                    }
                asm volatile("" ::: "memory");
            }
    }
};
struct EpiPle {
    static constexpr bool PERM = false, AFTER_DRAIN = false;
    float* X; const bf16_t* P; float alpha;
    __device__ __forceinline__ void operator()(const f32x4 (&acc)[2][2][4][2], const Unit& u, int wr, int wc, int fr, int fq) const {
        const int col0 = u.pn * BM + wc * 32 + 4 * fq;
#pragma unroll
        for (int ai = 0; ai < 2; ++ai)
#pragma unroll
            for (int m = 0; m < 4; ++m) {
                const int r = u.pm * BM + ai * HALF + wr * 64 + m * 16 + fr; float* p = X + (size_t)r * 1024 + col0; const bf16_t* pp = P + (size_t)r * 1024 + col0;
#pragma unroll
                for (int bj = 0; bj < 2; ++bj)
#pragma unroll
                    for (int n = 0; n < 2; ++n) {
                        const int o = bj * HALF + n * 16;
                        f32x4 v = *(const f32x4*)(p + o); const u32x2 pw = *(const u32x2*)(pp + o); const f32x4 a = acc[ai][bj][m][n];
                        v[0] = v[0] * alpha + fsigmoid(a[0]) * bflo(pw.x); v[1] = v[1] * alpha + fsigmoid(a[1]) * bfhi(pw.x);
                        v[2] = v[2] * alpha + fsigmoid(a[2]) * bflo(pw.y); v[3] = v[3] * alpha + fsigmoid(a[3]) * bfhi(pw.y);
                        *(f32x4*)(p + o) = v;
                    }
                asm volatile("" ::: "memory");
            }
    }
};
struct BranchOrder {
    StaticOrder so;
    __host__ __device__ void init(int G_, int c_) { so.init(16384, 1024, G_, c_); }
    __host__ __device__ bool next(int i, Unit& u) const { if (i >= 3) return false; Unit t; if (!so.next(0, t)) return false; u.pm = i * 64 + t.pm; u.pn = i * 4 + t.pn; return true; }
    __device__ __forceinline__ void a_ready(const Unit&) const {}
    __device__ __forceinline__ void done(const Unit&) const {}
};

template <class Epi, class Sched, bool ALIGN_EPI = false, bool SP2 = false>
__device__ __forceinline__ void gemm_phase(PG8_LAS unsigned char* lds, const Gemm g, const Sched& S, const Epi& E, const int tid) {
    const int  wid = __builtin_amdgcn_readfirstlane(tid >> 6), lane = tid & 63, wr = wid >> 2, wc = wid & 3, fr = lane & 15, fq = lane >> 4;
    const int K = g.K, nt = K / BK;
    unsigned voffA[2], voffB[2];
#pragma unroll
    for (int i = 0; i < 2; ++i) { int R, C; stage_rc(tid * 16 + i * 8192, R, C); const int Rb = Epi::PERM ? ((R & ~31) + perm32(R & 31)) : R;
        voffA[i] = (unsigned)(R * K + C) * 2u; voffB[i] = (unsigned)(Rb * K + C) * 2u; }
    const size_t kstep = (size_t)(BK * 2);
    const size_t hstep = (size_t)HALF * K * 2;
    const size_t tstep = 2 * hstep;
    const unsigned ldsw = (unsigned)wid * 1024u;
    const int aoff = lds_byte(wr * 64 + fr, fq * 8), boff = lds_byte(wc * 32 + fr, fq * 8);
#define PG8_SA(b, h) (((b) * 2 + (h)) * HTB)
#define PG8_SB(b, h) ((4 + (b) * 2 + (h)) * HTB)
#define PG8_STAGE(bufoff, gbase, voff) do { _Pragma("unroll") for (int _i = 0; _i < 2; ++_i) \
        __builtin_amdgcn_global_load_lds((const unsigned*)((const char*)(gbase) + (voff)[_i]), (PG8_LAS unsigned*)(lds + (bufoff) + ldsw + _i * 8192), 16, 0, 0); } while (0)
#define PG8_LDA(dst, b, h) do { _Pragma("unroll") for (int m = 0; m < 4; ++m) _Pragma("unroll") for (int k = 0; k < 2; ++k) dst[m][k] = *(const PG8_LAS bf16x8*)(lds + PG8_SA(b, h) + aoff + m * 2048 + k * 1024); } while (0)
#define PG8_LDB(dst, b, h) do { _Pragma("unroll") for (int n = 0; n < 2; ++n) _Pragma("unroll") for (int k = 0; k < 2; ++k) dst[n][k] = *(const PG8_LAS bf16x8*)(lds + PG8_SB(b, h) + boff + n * 2048 + k * 1024); } while (0)
#define PG8_MMA(ai, bj, At, Bt) do { __builtin_amdgcn_s_setprio(1); _Pragma("unroll") for (int m = 0; m < 4; ++m) _Pragma("unroll") for (int n = 0; n < 2; ++n) _Pragma("unroll") for (int k = 0; k < 2; ++k) \
        acc[ai][bj][m][n] = __builtin_amdgcn_mfma_f32_16x16x32_bf16(Bt[n][k], At[m][k], acc[ai][bj][m][n], 0, 0, 0); __builtin_amdgcn_s_setprio(0); } while (0)
#define PG8_WAIT_V(n) asm volatile("s_waitcnt vmcnt(" #n ")" ::: "memory")
#define PG8_WAIT_L(n) asm volatile("s_waitcnt lgkmcnt(" #n ")" ::: "memory")
#define PG8_BAR __builtin_amdgcn_s_barrier()
#define PG8_SCHED __builtin_amdgcn_sched_barrier(0)
    Unit cur, nxt; int ui = 0;
    if (!S.next(0, cur)) return;
    f32x4 acc[2][2][4][2];
#pragma unroll
    for (int a = 0; a < 2; ++a)
#pragma unroll
        for (int b = 0; b < 2; ++b)
#pragma unroll
            for (int m = 0; m < 4; ++m)
#pragma unroll
                for (int n = 0; n < 2; ++n) acc[a][b][m][n] = (f32x4){0.f, 0.f, 0.f, 0.f};
    bf16x8 At[4][2], B0[2][2], B1[2][2];
    const char* cA = (const char*)g.A + (size_t)cur.pm * tstep; const char* cB = (const char*)g.Bt + (size_t)cur.pn * tstep;
    S.a_ready(cur);
    if constexpr (SP2) {
        PG8_STAGE(PG8_SB(0, 0), cB, voffB); PG8_STAGE(PG8_SB(0, 1), cB + hstep, voffB); PG8_STAGE(PG8_SA(0, 0), cA, voffA); PG8_STAGE(PG8_SA(0, 1), cA + hstep, voffA);
        if (wr == 1) PG8_BAR;
        PG8_WAIT_V(2); PG8_BAR;
        PG8_STAGE(PG8_SB(1, 0), cB + kstep, voffB); PG8_STAGE(PG8_SA(1, 0), cA + kstep, voffA); PG8_STAGE(PG8_SB(1, 1), cB + hstep + kstep, voffB);
        PG8_WAIT_V(6); PG8_BAR;
    } else {
        PG8_STAGE(PG8_SB(0, 0), cB, voffB); PG8_STAGE(PG8_SA(0, 0), cA, voffA); PG8_STAGE(PG8_SB(0, 1), cB + hstep, voffB); PG8_STAGE(PG8_SA(0, 1), cA + hstep, voffA);
        if (wr == 1) PG8_BAR;
        PG8_WAIT_V(4); PG8_BAR;
        PG8_STAGE(PG8_SB(1, 0), cB + kstep, voffB); PG8_STAGE(PG8_SA(1, 0), cA + kstep, voffA); PG8_STAGE(PG8_SB(1, 1), cB + hstep + kstep, voffB);
        PG8_WAIT_V(6); PG8_BAR;
    }
    for (;;) {
        const bool has_next = S.next(ui + 1, nxt);
        const char* nA = has_next ? (const char*)g.A + (size_t)nxt.pm * tstep : cA; const char* nB = has_next ? (const char*)g.Bt + (size_t)nxt.pn * tstep : cB;
        for (int t = 0; t < nt; t += 2) {
            const bool last = (t == nt - 2);
            const char* a1 = cA + (size_t)(t + 1) * kstep;
            const char* a2 = last ? nA : cA + (size_t)(t + 2) * kstep; const char* b2 = last ? nB : cB + (size_t)(t + 2) * kstep;
            const char* a3 = a2 + kstep; const char* b3 = b2 + kstep;
            if (last && has_next) S.a_ready(nxt);
            if constexpr (SP2) {
            PG8_LDB(B0, 0, 0); PG8_LDB(B1, 0, 1); PG8_SCHED; PG8_LDA(At, 0, 0); PG8_STAGE(PG8_SA(1, 1), a1 + hstep, voffA);
            PG8_WAIT_V(8); PG8_WAIT_L(0); PG8_BAR; PG8_MMA(0, 0, At, B0); PG8_MMA(0, 1, At, B1); PG8_BAR; PG8_SCHED;
            PG8_LDA(At, 0, 1); PG8_STAGE(PG8_SB(0, 0), b2, voffB); PG8_STAGE(PG8_SB(0, 1), b2 + hstep, voffB); PG8_STAGE(PG8_SA(0, 0), a2, voffA);
            PG8_WAIT_V(8); PG8_WAIT_L(0); PG8_BAR; PG8_MMA(1, 0, At, B0); PG8_MMA(1, 1, At, B1); PG8_BAR; PG8_SCHED;
            PG8_LDB(B0, 1, 0); PG8_LDB(B1, 1, 1); PG8_SCHED; PG8_LDA(At, 1, 0); PG8_STAGE(PG8_SA(0, 1), a2 + hstep, voffA);
            PG8_WAIT_V(8); PG8_WAIT_L(0); PG8_BAR; PG8_MMA(0, 0, At, B0); PG8_MMA(0, 1, At, B1); PG8_BAR; PG8_SCHED;
            PG8_LDA(At, 1, 1); PG8_STAGE(PG8_SB(1, 0), b3, voffB); PG8_STAGE(PG8_SB(1, 1), b3 + hstep, voffB); PG8_STAGE(PG8_SA(1, 0), a3, voffA);
            PG8_WAIT_V(8); PG8_WAIT_L(0); PG8_BAR; PG8_MMA(1, 0, At, B0); PG8_MMA(1, 1, At, B1); PG8_BAR; PG8_SCHED;
            } else {
            PG8_LDB(B0, 0, 0); PG8_SCHED; PG8_LDA(At, 0, 0); PG8_STAGE(PG8_SA(1, 1), a1 + hstep, voffA);
            PG8_WAIT_L(8); PG8_BAR; PG8_WAIT_L(0); PG8_MMA(0, 0, At, B0); PG8_BAR; PG8_SCHED;
            PG8_LDB(B1, 0, 1); PG8_STAGE(PG8_SB(0, 0), b2, voffB);
            PG8_BAR; PG8_WAIT_L(0); PG8_MMA(0, 1, At, B1); PG8_BAR;
            PG8_LDA(At, 0, 1); PG8_STAGE(PG8_SA(0, 0), a2, voffA);
            PG8_BAR; PG8_WAIT_L(0); PG8_MMA(1, 0, At, B0); PG8_BAR; PG8_SCHED;
            PG8_STAGE(PG8_SB(0, 1), b2 + hstep, voffB);
            PG8_WAIT_V(6); PG8_BAR; PG8_MMA(1, 1, At, B1); PG8_BAR;
            PG8_LDB(B0, 1, 0); PG8_SCHED; PG8_LDA(At, 1, 0); PG8_STAGE(PG8_SA(0, 1), a2 + hstep, voffA);
            PG8_WAIT_L(8); PG8_BAR; PG8_WAIT_L(0); PG8_MMA(0, 0, At, B0); PG8_BAR; PG8_SCHED;
            PG8_LDB(B1, 1, 1); PG8_STAGE(PG8_SB(1, 0), b3, voffB);
            PG8_BAR; PG8_WAIT_L(0); PG8_MMA(0, 1, At, B1); PG8_BAR;
            PG8_LDA(At, 1, 1); PG8_STAGE(PG8_SA(1, 0), a3, voffA);
            PG8_BAR; PG8_WAIT_L(0); PG8_MMA(1, 0, At, B0); PG8_BAR; PG8_SCHED;
            PG8_STAGE(PG8_SB(1, 1), b3 + hstep, voffB);
            PG8_WAIT_V(6); PG8_BAR; PG8_MMA(1, 1, At, B1); PG8_BAR;
            }
        }
        if constexpr (ALIGN_EPI) { if (wr == 0) PG8_BAR; }
        if constexpr (!Epi::AFTER_DRAIN) { E(acc, cur, wr, wc, fr, fq); S.done(cur); }
        if (!has_next) break;
#pragma unroll
        for (int a = 0; a < 2; ++a)
#pragma unroll
            for (int b = 0; b < 2; ++b)
#pragma unroll
                for (int m = 0; m < 4; ++m)
#pragma unroll
                    for (int n = 0; n < 2; ++n) acc[a][b][m][n] = (f32x4){0.f, 0.f, 0.f, 0.f};
        cur = nxt; cA = nA; cB = nB; ++ui;
        if constexpr (ALIGN_EPI) { if (wr == 1) PG8_BAR; }
    }
    PG8_WAIT_V(0);
    if constexpr (!ALIGN_EPI) { if (wr == 0) PG8_BAR; }
    PG8_BAR;
    if constexpr (Epi::AFTER_DRAIN) { E.fused(acc, cur, wr, wc, fr, fq, lds, wid, lane); S.done(cur); }
#undef PG8_SA
#undef PG8_SB
#undef PG8_STAGE
#undef PG8_LDA
#undef PG8_LDB
#undef PG8_MMA
#undef PG8_WAIT_V
#undef PG8_WAIT_L
#undef PG8_BAR
#undef PG8_SCHED
}
}
namespace cg = cooperative_groups;
constexpr int NWAVES = 8, NTHREADS = 512;
constexpr int BATCH = 4, SEQ = 4096, D = 1024, FF = 2816, M = BATCH * SEQ, DEPTH = 2, PLE = 256;
constexpr int DIN = 8504, NGATE = 3072;
constexpr int N_RW = 1824, N_GLA = 1552, N_GDN = 2056, LD_RW = 2048, LD_GLA = 1792, LD_GDN = 2304;
constexpr int C_GLA = 1824, C_GDN = 3376, C_GATE = 5432;
constexpr float LN_EPS = 1e-5f, ALPHA = 1.41421356237f;
constexpr size_t MiB = 1u << 20;
constexpr size_t WS_CTL = 0;
constexpr size_t SZ_W13 = (size_t)5632 * 1024 * 2, SZ_W2 = (size_t)1024 * 2816 * 2, SZ_WRW = (size_t)LD_RW * 1024 * 2, SZ_WGLA = (size_t)LD_GLA * 1024 * 2, SZ_WGDN = (size_t)LD_GDN * 1024 * 2, SZ_WG = (size_t)NGATE * 1024 * 2,
                 SZ_WBR = (size_t)3 * 1024 * 512 * 2, SZ_WO = (size_t)1024 * 1024 * 2, SZ_WPP = (size_t)1024 * 256 * 2;
constexpr size_t WS_W = 1 * MiB;
constexpr size_t WO_W13_0 = 0, WO_W2_0 = WO_W13_0 + SZ_W13, WO_W13_1 = WO_W2_0 + SZ_W2, WO_W2_1 = WO_W13_1 + SZ_W13, WO_WRW = WO_W2_1 + SZ_W2, WO_WGLA = WO_WRW + SZ_WRW, WO_WGDN = WO_WGLA + SZ_WGLA, WO_WG = WO_WGDN + SZ_WGDN,
                 WO_WBR = WO_WG + SZ_WG, WO_WO = WO_WBR + SZ_WBR, WO_WPG = WO_WO + SZ_WO, WO_WPP = WO_WPG + SZ_WO, WO_RW2T = WO_WPP + SZ_WPP, WO_RA2T = WO_RW2T + 512 * 64 * 2, WO_RG2T = WO_RA2T + 512 * 64 * 2, WO_END = WO_RG2T + 512 * 160 * 2;
static_assert(WO_END <= 59 * MiB, "weights region");
constexpr size_t WS_XB = 60 * MiB;
constexpr size_t WS_R = 92 * MiB;
constexpr size_t WS_R_ACC = WS_R + 96 * MiB, WS_R_PP = WS_R + 8 * MiB;
constexpr size_t WS_O = 268 * MiB;
constexpr size_t WS_DBG = 316 * MiB;
constexpr size_t WS_END = 324 * MiB;
constexpr int LDS_BYTES = 147456;

#define GAS __attribute__((address_space(1)))
#define LAS __attribute__((address_space(3)))
typedef unsigned short bf16;
typedef unsigned v4u __attribute__((ext_vector_type(4)));
typedef float f32x4 __attribute__((ext_vector_type(4)));
#define LDS_WAIT() asm volatile("s_waitcnt lgkmcnt(0)" ::: "memory")
__device__ __forceinline__ unsigned f2bf(float f) { unsigned u = __builtin_bit_cast(unsigned, f); return (u + 0x7fffu + ((u >> 16) & 1u)) >> 16; }
__device__ __forceinline__ unsigned pk2(float lo, float hi) { return f2bf(lo) | (f2bf(hi) << 16); }
__device__ __forceinline__ float b2f(bf16 u) { return __uint_as_float((unsigned)u << 16); }
__device__ __forceinline__ float wave_sum(float v) {
#pragma unroll
    for (int o = 1; o < 64; o <<= 1) v += __shfl_xor(v, o);
    return v;
}
__device__ __forceinline__ float sigmoidf_(float x) { return 1.0f / (1.0f + __expf(-x)); }
__device__ __forceinline__ float softplusf_(float x) { const float e = __expf(-fabsf(x)); const float l = e < 0.01f ? e * (1.f - e * (0.5f - e * 0.33333334f)) : __logf(1.f + e); return fmaxf(x, 0.f) + l; }
__device__ __forceinline__ float tanhf_(float x) { return 1.f - 2.f / (1.f + __expf(2.f * x)); }

struct Args { const float* in[30]; float* out; unsigned char* ws; int ph_lo, ph_hi; };
typedef const __attribute__((address_space(4))) Args* KArgs;

__device__ __forceinline__ void cvt_item(const float* W, int ld, int c0, int ncols, int K, bf16* WT, int kind, LAS float* scr, int item, int nnb, int lane, int kvalid = 1 << 30) {
    const int kb = item / nnb, nb = item % nnb, k0 = 64 * kb, n0 = 32 * nb;
    const int nn = n0 + (lane & 31); const bool ok = nn < ncols;
#pragma unroll 8
    for (int i = 0; i < 32; ++i) { const int kk = 2 * i + (lane >> 5); scr[kk * 33 + (lane & 31)] = (ok && k0 + kk < kvalid) ? W[(size_t)(k0 + kk) * ld + c0 + nn] : 0.f; }
    LDS_WAIT(); asm volatile("" ::: "memory");
    const int c = lane & 7;
    const int drow0 = (kind == 0) ? n0 : (256 * (n0 >> 7) + (n0 & 127) + (kind == 2 ? 128 : 0));
#pragma unroll
    for (int j = 0; j < 4; ++j) { const int n = (lane >> 3) + 8 * j; const LAS float* s = scr + (8 * c) * 33 + n;
        v4u o; o.x = pk2(s[0 * 33], s[1 * 33]); o.y = pk2(s[2 * 33], s[3 * 33]); o.z = pk2(s[4 * 33], s[5 * 33]); o.w = pk2(s[6 * 33], s[7 * 33]);
        if (k0 + 8 * c < kvalid) *(GAS v4u*)(WT + (size_t)(drow0 + n) * K + k0 + 8 * c) = o; }
    LDS_WAIT(); asm volatile("" ::: "memory");
}
__device__ __forceinline__ void convert_weights(KArgs a, int L, LAS unsigned char* lds, int wave, int lane, int gw, int NGW) {
    LAS float* scr = (LAS float*)(lds + wave * 8704);
    unsigned char* wb = a->ws + WS_W;
    constexpr int I_W1 = 16 * 88, I_W2 = 44 * 32, I_RW = 16 * 64, I_GLA = 16 * 56, I_GDN = 16 * 72, I_WG = 16 * 96, I_BR = 8 * 32, I_O = 16 * 32, I_PP = 4 * 32, I_LR = 16, I_LG = 3 * 16;
    constexpr int NIT = 4 * I_W1 + 2 * I_W2 + I_RW + I_GLA + I_GDN + I_WG + 3 * I_BR + 2 * I_O + I_PP + 2 * I_LR + I_LG;
    for (int it = gw; it < NIT; it += NGW) {
        int r = it;
        if (r < 4 * I_W1) { const int q = r / I_W1, s = q >> 1, w3 = q & 1; r -= q * I_W1;
            cvt_item((w3 ? a->in[5] : a->in[4]) + (size_t)(L * 2 + s) * 1024 * 2816, 2816, 0, 2816, 1024, (bf16*)(wb + (s ? WO_W13_1 : WO_W13_0)), 1 + w3, scr, r, 88, lane); continue; }
        r -= 4 * I_W1;
        if (r < 2 * I_W2) { const int s = r / I_W2; r -= s * I_W2;
            cvt_item(a->in[6] + (size_t)(L * 2 + s) * 2816 * 1024, 1024, 0, 1024, 2816, (bf16*)(wb + (s ? WO_W2_1 : WO_W2_0)), 0, scr, r, 32, lane); continue; }
        r -= 2 * I_W2;
        if (r < I_RW) { cvt_item(a->in[7] + (size_t)L * 1024 * DIN, DIN, 0, N_RW, 1024, (bf16*)(wb + WO_WRW), 0, scr, r, 64, lane); continue; }
        r -= I_RW;
        if (r < I_GLA) { cvt_item(a->in[7] + (size_t)L * 1024 * DIN, DIN, C_GLA, N_GLA, 1024, (bf16*)(wb + WO_WGLA), 0, scr, r, 56, lane); continue; }
        r -= I_GLA;
        if (r < I_GDN) { cvt_item(a->in[7] + (size_t)L * 1024 * DIN, DIN, C_GDN, N_GDN, 1024, (bf16*)(wb + WO_WGDN), 0, scr, r, 72, lane); continue; }
        r -= I_GDN;
        if (r < I_WG) { cvt_item(a->in[7] + (size_t)L * 1024 * DIN, DIN, C_GATE, NGATE, 1024, (bf16*)(wb + WO_WG), 0, scr, r, 96, lane); continue; }
        r -= I_WG;
        if (r < 3 * I_BR) { const int b = r / I_BR; r -= b * I_BR;
            cvt_item(a->in[26] + (size_t)(L * 3 + b) * 512 * 1024, 1024, 0, 1024, 512, (bf16*)(wb + WO_WBR) + (size_t)b * 1024 * 512, 0, scr, r, 32, lane); continue; }
        r -= 3 * I_BR;
        if (r < I_O) { cvt_item(a->in[27] + (size_t)L * 1024 * 1024, 1024, 0, 1024, 1024, (bf16*)(wb + WO_WO), 0, scr, r, 32, lane); continue; }
        r -= I_O;
        if (r < I_O) { cvt_item(a->in[28] + (size_t)L * 1024 * 1024, 1024, 0, 1024, 1024, (bf16*)(wb + WO_WPG), 0, scr, r, 32, lane); continue; }
        r -= I_O;
        if (r < I_PP) { cvt_item(a->in[29] + (size_t)L * 256 * 1024, 1024, 0, 1024, 256, (bf16*)(wb + WO_WPP), 0, scr, r, 32, lane); continue; }
        r -= I_PP;
        if (r < I_LR) { cvt_item(a->in[10] + (size_t)L * 64 * 512, 512, 0, 512, 64, (bf16*)(wb + WO_RW2T), 0, scr, r, 16, lane); continue; }
        r -= I_LR;
        if (r < I_LR) { cvt_item(a->in[12] + (size_t)L * 64 * 512, 512, 0, 512, 64, (bf16*)(wb + WO_RA2T), 0, scr, r, 16, lane); continue; }
        r -= I_LR;
        cvt_item(a->in[13] + (size_t)L * 160 * 512, 512, 0, 512, 160, (bf16*)(wb + WO_RG2T), 0, scr, r, 16, lane, 160);
    }
}
template <bool NORM>
__device__ __forceinline__ void row_pass(const float* src, float* dst, bf16* dstb, const float* g, const float* bta, int lane) {
    const GAS f32x4* xr = (const GAS f32x4*)src + lane;
    f32x4 v[4]; float s = 0.f;
#pragma unroll
    for (int j = 0; j < 4; ++j) { v[j] = xr[64 * j]; s += (v[j].x + v[j].y) + (v[j].z + v[j].w); }
    if (NORM) {
        const float mean = wave_sum(s) * (1.f / D); float s2 = 0.f;
#pragma unroll
        for (int j = 0; j < 4; ++j) { v[j] = v[j] - mean; s2 += (v[j].x * v[j].x + v[j].y * v[j].y) + (v[j].z * v[j].z + v[j].w * v[j].w); }
        const float rstd = 1.f / sqrtf(wave_sum(s2) * (1.f / D) + LN_EPS);
#pragma unroll
        for (int j = 0; j < 4; ++j) { const f32x4 gg = ((const GAS f32x4*)g)[lane + 64 * j], bb = ((const GAS f32x4*)bta)[lane + 64 * j]; v[j] = v[j] * rstd * gg + bb; }
    }
    GAS f32x4* o4 = (GAS f32x4*)dst + lane;
    GAS unsigned long long* o8 = (GAS unsigned long long*)dstb + lane;
#pragma unroll
    for (int j = 0; j < 4; ++j) { o4[64 * j] = v[j]; o8[64 * j] = (unsigned long long)pk2(v[j].x, v[j].y) | ((unsigned long long)pk2(v[j].z, v[j].w) << 32); }
}

constexpr int CH = 16;
__device__ __forceinline__ void mix_rwkv(KArgs a, int L, int b, int h, LAS float* sm, int tid, const bf16* hm, bf16* out) {
    constexpr int LDH = LD_RW, C_RW = 0;
    const int lane = tid & 63, wid = tid >> 6;
    LAS float* w2h = sm; LAS float* a2h = sm + 4096; LAS float* g2h = sm + 8192;
    LAS float* tw = sm + 18432; LAS float* al = tw + 1024; LAS float* gl = al + 1024;
    LAS float* sr = gl + 2560; LAS float* skr = sr + 1024; LAS float* sv = skr + 1024; LAS float* sd = sv + 1024; LAS float* sa = sd + 1024; LAS float* sb = sa + 1024;
    LAS float* sk2 = sb + 1024; LAS float* sg = sk2 + 1024; LAS float* sbon = sg + 1024; LAS float* sy = sbon + 1024;
    const float* mu = a->in[8] + L * 1824;
    for (int e = tid; e < 64 * 64; e += NTHREADS) { const int i = e >> 6, j = e & 63; w2h[e] = a->in[10][(size_t)(L * 64 + i) * 512 + h * 64 + j]; a2h[e] = a->in[12][(size_t)(L * 64 + i) * 512 + h * 64 + j]; }
    for (int e = tid; e < 160 * 64; e += NTHREADS) { const int i = e >> 6, j = e & 63; g2h[e] = a->in[13][(size_t)(L * 160 + i) * 512 + h * 64 + j]; }
    const int hj = L * 512 + h * 64 + lane;
    const float w0j = a->in[9][hj], a0j = a->in[11][hj], kkj = a->in[14][hj], kaj = a->in[15][hj], rkj = a->in[16][hj], gngj = a->in[17][hj], gnbj = a->in[18][hj];
    float S[8];
#pragma unroll
    for (int i = 0; i < 8; ++i) S[i] = 0.f;
    const int vrow = tid >> 3, kg = tid & 7;
    __syncthreads();
#pragma unroll 1
    for (int c = 0; c < SEQ / CH; ++c) {
        const int t0 = c * CH;
        for (int e = tid; e < CH * 480; e += NTHREADS) {
            const int tt = e / 480, cc = e % 480, t = t0 + tt;
            int col; if (cc < 64) col = h * 64 + cc; else if (cc < 128) col = 512 + h * 64 + (cc - 64); else if (cc < 192) col = 1024 + h * 64 + (cc - 128); else col = 1536 + (cc - 192);
            const size_t ro = (size_t)(b * SEQ + t) * LDH + C_RW + col;
            const float cur = b2f(hm[ro]), prev = t > 0 ? b2f(hm[ro - LDH]) : 0.f;
            const float xs = cur + (prev - cur) * mu[col];
            if (cc < 64) sr[tt * 64 + cc] = xs; else if (cc < 128) skr[tt * 64 + cc - 64] = xs; else if (cc < 192) sv[tt * 64 + cc - 128] = xs;
            else if (cc < 256) tw[tt * 64 + cc - 192] = tanhf_(xs); else if (cc < 320) al[tt * 64 + cc - 256] = xs; else gl[tt * 160 + cc - 320] = sigmoidf_(xs);
        }
        __syncthreads();
#pragma unroll
        for (int i2 = 0; i2 < 2; ++i2) {
            const int tt = wid + 8 * i2;
            float w = w0j, av = a0j, g = 0.f;
#pragma unroll 4
            for (int i = 0; i < 64; ++i) { w += tw[tt * 64 + i] * w2h[i * 64 + lane]; av += al[tt * 64 + i] * a2h[i * 64 + lane]; }
#pragma unroll 4
            for (int i = 0; i < 160; ++i) g += gl[tt * 160 + i] * g2h[i * 64 + lane];
            const float wl = -softplusf_(-w) - 0.5f, dec = __expf(-__expf(wl)), asig = sigmoidf_(av);
            const float kraw = skr[tt * 64 + lane], kkr = kraw * kkj;
            const float kk = kkr * (1.0f / sqrtf(wave_sum(kkr * kkr) + 1e-6f));
            const float k2 = kraw * (1.f + (asig - 1.f) * kaj);
            const float rk = wave_sum(sr[tt * 64 + lane] * k2 * rkj);
            sd[tt * 64 + lane] = dec; sa[tt * 64 + lane] = -kk; sb[tt * 64 + lane] = kk * asig; sk2[tt * 64 + lane] = k2; sg[tt * 64 + lane] = g; sbon[tt * 64 + lane] = rk * sv[tt * 64 + lane];
        }
        __syncthreads();
#pragma unroll 1
        for (int tt = 0; tt < CH; ++tt) {
            const int o = tt * 64 + kg * 8;
            float x = 0.f;
#pragma unroll
            for (int i = 0; i < 8; ++i) x += S[i] * sa[o + i];
            x += __shfl_xor(x, 1); x += __shfl_xor(x, 2); x += __shfl_xor(x, 4);
            const float vv = sv[tt * 64 + vrow];
            float y = 0.f;
#pragma unroll
            for (int i = 0; i < 8; ++i) { S[i] = S[i] * sd[o + i] + x * sb[o + i] + vv * sk2[o + i]; y += S[i] * sr[o + i]; }
            y += __shfl_xor(y, 1); y += __shfl_xor(y, 2); y += __shfl_xor(y, 4);
            if (kg == 0) sy[tt * 64 + vrow] = y;
        }
        __syncthreads();
#pragma unroll
        for (int i2 = 0; i2 < 2; ++i2) {
            const int tt = wid + 8 * i2;
            const float y = sy[tt * 64 + lane], mean = wave_sum(y) * (1.f / 64.f), dv = y - mean, var = wave_sum(dv * dv) * (1.f / 64.f);
            const float yn = dv * (1.0f / sqrtf(var + 64e-5f)) * gngj + gnbj;
            const float o = (yn + sbon[tt * 64 + lane]) * sg[tt * 64 + lane];
            out[(size_t)(b * SEQ + t0 + tt) * 512 + h * 64 + lane] = (bf16)f2bf(o);
        }
        __syncthreads();
    }
}
__device__ __forceinline__ void mix_gla(KArgs a, int L, int b, int h, LAS float* sm, int tid, const bf16* hm, bf16* out) {
    constexpr int LDH = LD_GLA, C_GLA = 0;
    const int lane = tid & 63, wid = tid >> 6;
    LAS float* gkw = sm; LAS float* sq = sm + 1024; LAS float* sk = sq + 1024; LAS float* sdec = sk + 1024; LAS float* sv = sdec + 1024; LAS float* sgt = sv + 2048; LAS float* so = sgt + 2048; LAS float* gkl = so + 2048;
    for (int e = tid; e < 16 * 64; e += NTHREADS) { const int i = e >> 6, j = e & 63; gkw[e] = a->in[19][(size_t)(L * 16 + i) * 256 + h * 64 + j]; }
    const float gkbj = a->in[20][L * 256 + h * 64 + lane];
    const float ng0 = a->in[21][L * 128 + lane], ng1 = a->in[21][L * 128 + 64 + lane];
    float S[16];
#pragma unroll
    for (int i = 0; i < 16; ++i) S[i] = 0.f;
    const int vc = tid >> 2, kg = tid & 3;
    __syncthreads();
#pragma unroll 1
    for (int c = 0; c < SEQ / CH; ++c) {
        const int t0 = c * CH;
        for (int e = tid; e < CH * 400; e += NTHREADS) {
            const int tt = e / 400, cc = e % 400;
            int col; if (cc < 64) col = h * 64 + cc; else if (cc < 128) col = 256 + h * 64 + (cc - 64); else if (cc < 256) col = 512 + h * 128 + (cc - 128); else if (cc < 272) col = 1024 + (cc - 256); else col = 1040 + h * 128 + (cc - 272);
            const float x = b2f(hm[(size_t)(b * SEQ + t0 + tt) * LDH + C_GLA + col]);
            if (cc < 64) sq[tt * 64 + cc] = x; else if (cc < 128) sk[tt * 64 + cc - 64] = x; else if (cc < 256) sv[tt * 128 + cc - 128] = x; else if (cc < 272) gkl[tt * 16 + cc - 256] = x; else sgt[tt * 128 + cc - 272] = x;
        }
        __syncthreads();
#pragma unroll
        for (int i2 = 0; i2 < 2; ++i2) {
            const int tt = wid + 8 * i2;
            float z = gkbj;
#pragma unroll
            for (int i = 0; i < 16; ++i) z += gkl[tt * 16 + i] * gkw[i * 64 + lane];
            sdec[tt * 64 + lane] = __expf(-softplusf_(-z) * (1.f / 16.f));
        }
        __syncthreads();
#pragma unroll 1
        for (int tt = 0; tt < CH; ++tt) {
            const int o = tt * 64 + kg * 16; const float vv = sv[tt * 128 + vc];
            float y = 0.f;
#pragma unroll
            for (int i = 0; i < 16; ++i) { S[i] = S[i] * sdec[o + i] + sk[o + i] * vv; y += S[i] * sq[o + i]; }
            y += __shfl_xor(y, 1); y += __shfl_xor(y, 2);
            if (kg == 0) so[tt * 128 + vc] = y * 0.125f;
        }
        __syncthreads();
#pragma unroll
        for (int i2 = 0; i2 < 2; ++i2) {
            const int tt = wid + 8 * i2;
            const float o0 = so[tt * 128 + lane], o1 = so[tt * 128 + 64 + lane];
            const float rs = 1.0f / sqrtf(wave_sum(o0 * o0 + o1 * o1) * (1.f / 128.f) + 1e-6f);
            const float g0 = sgt[tt * 128 + lane], g1 = sgt[tt * 128 + 64 + lane];
            bf16* op = out + (size_t)(b * SEQ + t0 + tt) * 512 + h * 128;
            op[lane] = (bf16)f2bf(o0 * rs * ng0 * g0 * sigmoidf_(g0)); op[64 + lane] = (bf16)f2bf(o1 * rs * ng1 * g1 * sigmoidf_(g1));
        }
        __syncthreads();
    }
}
__device__ __forceinline__ void mix_gdn(KArgs a, int L, int b, int h, LAS float* sm, int tid, const bf16* hm, bf16* out) {
    constexpr int LDH = LD_GDN, C_GDN = 0;
    const int lane = tid & 63, wid = tid >> 6;
    LAS float* raw = sm;
    LAS float* sq = sm + 7296; LAS float* sk = sq + 2048; LAS float* sv = sk + 2048; LAS float* sgt = sv + 2048; LAS float* so = sgt + 2048; LAS float* sal = so + 2048; LAS float* sbe = sal + 16;
    const float* cw = a->in[22] + (size_t)L * 4 * 1536;
    const float Ah = __expf(a->in[23][L * 4 + h]), dtb = a->in[24][L * 4 + h];
    const float ng0 = a->in[25][L * 128 + lane], ng1 = a->in[25][L * 128 + 64 + lane];
    float S[32];
#pragma unroll
    for (int i = 0; i < 32; ++i) S[i] = 0.f;
    const int vc = tid >> 2, kg = tid & 3;
#pragma unroll 1
    for (int c = 0; c < SEQ / CH; ++c) {
        const int t0 = c * CH;
        for (int e = tid; e < 19 * 384; e += NTHREADS) {
            const int rr = e / 384, cc = e % 384, t = t0 - 3 + rr;
            const int col = (cc < 128) ? (h * 128 + cc) : (cc < 256 ? 512 + h * 128 + (cc - 128) : 1024 + h * 128 + (cc - 256));
            raw[e] = t >= 0 ? b2f(hm[(size_t)(b * SEQ + t) * LDH + C_GDN + col]) : 0.f;
        }
        for (int e = tid; e < CH * 128; e += NTHREADS) { const int tt = e >> 7, cc = e & 127; sgt[e] = b2f(hm[(size_t)(b * SEQ + t0 + tt) * LDH + C_GDN + 1544 + h * 128 + cc]); }
        if (tid < CH) {
            const size_t ro = (size_t)(b * SEQ + t0 + tid) * LDH + C_GDN;
            const float ai = b2f(hm[ro + 1536 + h]), bi = b2f(hm[ro + 1540 + h]);
            sal[tid] = __expf(-Ah * softplusf_(ai + dtb)); sbe[tid] = sigmoidf_(bi);
        }
        __syncthreads();
        for (int e = tid; e < CH * 384; e += NTHREADS) {
            const int tt = e / 384, cc = e % 384;
            const int ch = (cc < 128) ? (h * 128 + cc) : (cc < 256 ? 512 + h * 128 + (cc - 128) : 1024 + h * 128 + (cc - 256));
            float s = 0.f;
#pragma unroll
            for (int i = 0; i < 4; ++i) s += cw[i * 1536 + ch] * raw[(tt + i) * 384 + cc];
            s = s * sigmoidf_(s);
            if (cc < 128) sq[tt * 128 + cc] = s; else if (cc < 256) sk[tt * 128 + cc - 128] = s; else sv[tt * 128 + cc - 256] = s;
        }
        __syncthreads();
#pragma unroll
        for (int i2 = 0; i2 < 2; ++i2) {
            const int tt = wid + 8 * i2;
            const float q0 = sq[tt * 128 + lane], q1 = sq[tt * 128 + 64 + lane], k0 = sk[tt * 128 + lane], k1 = sk[tt * 128 + 64 + lane];
            const float rq = (1.0f / sqrtf(wave_sum(q0 * q0 + q1 * q1) + 1e-6f)) * 0.08838834764831845f, rk = 1.0f / sqrtf(wave_sum(k0 * k0 + k1 * k1) + 1e-6f);
            sq[tt * 128 + lane] = q0 * rq; sq[tt * 128 + 64 + lane] = q1 * rq; sk[tt * 128 + lane] = k0 * rk; sk[tt * 128 + 64 + lane] = k1 * rk;
        }
        __syncthreads();
#pragma unroll 1
        for (int tt = 0; tt < CH; ++tt) {
            const int o = tt * 128 + kg * 32; const float al = sal[tt], be = sbe[tt];
            float p = 0.f;
#pragma unroll
            for (int i = 0; i < 32; ++i) { S[i] *= al; p += S[i] * sk[o + i]; }
            p += __shfl_xor(p, 1); p += __shfl_xor(p, 2);
            const float vn = be * (sv[tt * 128 + vc] - p);
            float y = 0.f;
#pragma unroll
            for (int i = 0; i < 32; ++i) { S[i] += sk[o + i] * vn; y += S[i] * sq[o + i]; }
            y += __shfl_xor(y, 1); y += __shfl_xor(y, 2);
            if (kg == 0) so[tt * 128 + vc] = y;
        }
        __syncthreads();
#pragma unroll
        for (int i2 = 0; i2 < 2; ++i2) {
            const int tt = wid + 8 * i2;
            const float o0 = so[tt * 128 + lane], o1 = so[tt * 128 + 64 + lane];
            const float rs = 1.0f / sqrtf(wave_sum(o0 * o0 + o1 * o1) * (1.f / 128.f) + 1e-6f);
            const float g0 = sgt[tt * 128 + lane], g1 = sgt[tt * 128 + 64 + lane];
            bf16* op = out + (size_t)(b * SEQ + t0 + tt) * 512 + h * 128;
            op[lane] = (bf16)f2bf(o0 * rs * ng0 * g0 * sigmoidf_(g0)); op[64 + lane] = (bf16)f2bf(o1 * rs * ng1 * g1 * sigmoidf_(g1));
        }
        __syncthreads();
    }
}

typedef short bf16x8 __attribute__((ext_vector_type(8)));
typedef unsigned u32x2 __attribute__((ext_vector_type(2)));
__device__ __forceinline__ f32x4 mfma16(bf16x8 a, bf16x8 b, f32x4 c) { return __builtin_amdgcn_mfma_f32_16x16x32_bf16(a, b, c, 0, 0, 0); }
template <int K> __device__ __forceinline__ f32x4 mm16(f32x4 acc, const LAS bf16* Ap, int pa, const LAS bf16* Bp, int pb, int lane) {
    const LAS bf16* a = Ap + (lane & 15) * pa + 8 * (lane >> 4); const LAS bf16* b = Bp + (lane & 15) * pb + 8 * (lane >> 4);
#pragma unroll
    for (int kk = 0; kk < K; kk += 32) acc = mfma16(*(const LAS bf16x8*)(a + kk), *(const LAS bf16x8*)(b + kk), acc);
    return acc;
}
__device__ __forceinline__ u32x2 pack4(f32x4 v) { u32x2 w; w.x = pk2(v[0], v[1]); w.y = pk2(v[2], v[3]); return w; }
__device__ __forceinline__ f32x4 unpack4(u32x2 w) { f32x4 v; v[0] = __uint_as_float(w.x << 16); v[1] = __uint_as_float(w.x & 0xffff0000u); v[2] = __uint_as_float(w.y << 16); v[3] = __uint_as_float(w.y & 0xffff0000u); return v; }
__device__ __forceinline__ void storeT(LAS bf16* Out, int po, int m0, int n0, f32x4 acc, int lane) { *(LAS u32x2*)(Out + (n0 + (lane & 15)) * po + m0 + 4 * (lane >> 4)) = pack4(acc); }
__device__ __forceinline__ void storeR(LAS bf16* Out, int po, int m0, int n0, f32x4 acc, int lane) {
#pragma unroll
    for (int r = 0; r < 4; ++r) Out[(m0 + 4 * (lane >> 4) + r) * po + n0 + (lane & 15)] = (bf16)f2bf(acc[r]);
}
__device__ __forceinline__ int kperm(int d) { return (d & ~31) | (((d >> 2) & 3) << 3) | (((d >> 4) & 1) << 2) | (d & 3); }
__device__ __forceinline__ bf16x8 frag_of(f32x4 lo, f32x4 hi) {
    u32x2 a = pack4(lo), b = pack4(hi); v4u w; w.x = a.x; w.y = a.y; w.z = b.x; w.w = b.y; return __builtin_bit_cast(bf16x8, w);
}

constexpr size_t GLA_QP = 56 * MiB, GLA_NN = 64 * MiB, GLA_E = 80 * MiB, GLA_DEC = 96 * MiB;
constexpr int P64 = 72;
__device__ __forceinline__ void m1_gla(KArgs a, int L, int item, LAS unsigned char* lds, int tid) {
    const int lane = tid & 63, wave = tid >> 6, h = item & 3, tok0 = (item >> 2) * 64;
    unsigned char* R = a->ws + WS_R;
    const bf16* hg = (const bf16*)R; bf16* QP = (bf16*)(R + GLA_QP) + (size_t)item * 4096; bf16* NN = (bf16*)(R + GLA_NN) + (size_t)item * 8192;
    bf16* E = (bf16*)(R + GLA_E); float* DEC = (float*)(R + GLA_DEC) + item * 64; bf16* Y = (bf16*)(a->ws + WS_O) + (size_t)M * 512;
    LAS float* LA = (LAS float*)lds;
    LAS bf16* QS = (LAS bf16*)(lds + 16384); LAS bf16* KS = QS + 64 * P64; LAS bf16* KHT = KS + 64 * P64; LAS bf16* VT = KHT + 64 * P64; LAS bf16* ATT = VT + 128 * P64;
    LAS float* GKL = (LAS float*)(lds + 16384 + (64 * 4 + 128) * P64 * 2);
    for (int e = tid; e < 1024; e += NTHREADS) GKL[e] = b2f(hg[(size_t)(tok0 + (e >> 4)) * LD_GLA + 1024 + (e & 15)]);
    __syncthreads();
    {
        const int t = tid >> 3, d0 = (tid & 7) * 8; float z[8];
#pragma unroll
        for (int j = 0; j < 8; ++j) z[j] = a->in[20][L * 256 + h * 64 + d0 + j];
        for (int i = 0; i < 16; ++i) { const float g = GKL[t * 16 + i]; const float* w = a->in[19] + (size_t)(L * 16 + i) * 256 + h * 64 + d0;
#pragma unroll
            for (int j = 0; j < 8; ++j) z[j] += g * w[j]; }
#pragma unroll
        for (int j = 0; j < 8; ++j) LA[t * 64 + d0 + j] = -softplusf_(-z[j]) * (1.f / 16.f);
    }
    __syncthreads();
    if (tid < 64) { float run = 0.f; for (int t = 0; t < 64; ++t) { run += LA[t * 64 + tid]; LA[t * 64 + tid] = run; } }
    __syncthreads();
    for (int e = tid; e < 4096; e += NTHREADS) {
        const int t = e >> 6, d = e & 63; const float bb = LA[e], be = LA[63 * 64 + d];
        const size_t ro = (size_t)(tok0 + t) * LD_GLA + h * 64 + d;
        const float q = b2f(hg[ro]) * 0.125f * __expf(bb), k = b2f(hg[ro + 256]);
        const bf16 qb = (bf16)f2bf(q);
        QS[t * P64 + d] = qb; QP[t * 64 + kperm(d)] = qb;
        KS[t * P64 + d] = (bf16)f2bf(k * __expf(-bb)); KHT[d * P64 + t] = (bf16)f2bf(k * __expf(be - bb));
        if (t == 63) DEC[d] = __expf(be);
    }
    for (int e = tid; e < 8192; e += NTHREADS) {
        const int t = e >> 7, j = e & 127; const size_t ro = (size_t)(tok0 + t) * LD_GLA + h * 128 + j;
        VT[j * P64 + t] = hg[ro + 512];
        const float gt = b2f(hg[ro + 1040]);
        E[(size_t)(tok0 + t) * 512 + h * 128 + j] = (bf16)f2bf(a->in[21][L * 128 + j] * gt * sigmoidf_(gt));
    }
    __syncthreads();
#pragma unroll
    for (int i = 0; i < 2; ++i) {
        const int idx = wave * 2 + i, T = idx >> 2, S = idx & 3;
        f32x4 acc = {0.f, 0.f, 0.f, 0.f};
        if (S <= T) acc = mm16<64>(acc, QS + 16 * T * P64, P64, KS + 16 * S * P64, P64, lane);
#pragma unroll
        for (int r = 0; r < 4; ++r) if (16 * S + (lane & 15) > 16 * T + 4 * (lane >> 4) + r) acc[r] = 0.f;
        storeR(ATT, P64, 16 * T, 16 * S, acc, lane);
    }
    __syncthreads();
#pragma unroll
    for (int i = 0; i < 4; ++i) {
        const int idx = wave * 4 + i, Jt = idx >> 2, T = idx & 3;
        f32x4 acc = {0.f, 0.f, 0.f, 0.f};
        acc = mm16<64>(acc, VT + 16 * Jt * P64, P64, ATT + 16 * T * P64, P64, lane);
        *(u32x2*)(Y + (size_t)(tok0 + 16 * T + (lane & 15)) * 512 + h * 128 + 16 * Jt + 4 * (lane >> 4)) = pack4(acc);
    }
#pragma unroll
    for (int i = 0; i < 4; ++i) {
        const int idx = wave * 4 + i, J = idx >> 2, I = idx & 3;
        f32x4 acc = {0.f, 0.f, 0.f, 0.f};
        acc = mm16<64>(acc, KHT + 16 * I * P64, P64, VT + 16 * J * P64, P64, lane);
        *(u32x2*)(NN + (size_t)((J * 4 + I) * 64 + lane) * 4) = pack4(acc);
    }
    __syncthreads();
}
__device__ __forceinline__ void m2_gla(KArgs a, int b, int h, int tid) {
    const int lane = tid & 63, J = tid >> 6, g = lane >> 4, n = lane & 15;
    unsigned char* R = a->ws + WS_R;
    const bf16* QPb = (const bf16*)(R + GLA_QP); const bf16* NNb = (const bf16*)(R + GLA_NN); const float* DECb = (const float*)(R + GLA_DEC); bf16* Y = (bf16*)(a->ws + WS_O) + (size_t)M * 512;
    f32x4 H[4];
#pragma unroll
    for (int I = 0; I < 4; ++I) H[I] = (f32x4){0.f, 0.f, 0.f, 0.f};
    bf16x8 bq[4][2], bqn[4][2]; u32x2 yi[4], yin[4], nn[4], nnn[4]; f32x4 dc[4], dcn[4];
#define GLA_LOAD(c, BQ, YI, NNv, DC) do { const int item_ = ((b * 64 + (c)) * 4 + h); const bf16* qp_ = QPb + (size_t)item_ * 4096; \
        _Pragma("unroll") for (int T = 0; T < 4; ++T) { _Pragma("unroll") for (int s = 0; s < 2; ++s) BQ[T][s] = *(const bf16x8*)(qp_ + (16 * T + n) * 64 + 32 * s + 8 * g); \
            YI[T] = *(const u32x2*)(Y + (size_t)((b * 64 + (c)) * 64 + 16 * T + n) * 512 + h * 128 + 16 * J + 4 * g); } \
        _Pragma("unroll") for (int I = 0; I < 4; ++I) { NNv[I] = *(const u32x2*)(NNb + (size_t)item_ * 8192 + (size_t)((J * 4 + I) * 64 + lane) * 4); DC[I] = *(const f32x4*)(DECb + item_ * 64 + 16 * I + 4 * g); } } while (0)
    GLA_LOAD(0, bq, yi, nn, dc);
#pragma unroll 1
    for (int c = 0; c < 64; ++c) {
        if (c + 1 < 64) GLA_LOAD(c + 1, bqn, yin, nnn, dcn);
        const bf16x8 a0 = frag_of(H[0], H[1]), a1 = frag_of(H[2], H[3]);
#pragma unroll
        for (int T = 0; T < 4; ++T) {
            f32x4 acc = unpack4(yi[T]);
            acc = mfma16(a0, bq[T][0], acc); acc = mfma16(a1, bq[T][1], acc);
            *(u32x2*)(Y + (size_t)((b * 64 + c) * 64 + 16 * T + n) * 512 + h * 128 + 16 * J + 4 * g) = pack4(acc);
        }
#pragma unroll
        for (int I = 0; I < 4; ++I) H[I] = H[I] * dc[I] + unpack4(nn[I]);
#pragma unroll
        for (int T = 0; T < 4; ++T) { bq[T][0] = bqn[T][0]; bq[T][1] = bqn[T][1]; yi[T] = yin[T]; nn[T] = nnn[T]; dc[T] = dcn[T]; }
    }
#undef GLA_LOAD
}
__device__ __forceinline__ void m3_rms(bf16* Y, const bf16* E, int gw, int NGW, int lane) {
    for (int m = gw; m < M; m += NGW) {
        const v4u yw = *(const v4u*)(Y + (size_t)m * 512 + lane * 8), ew = *(const v4u*)(E + (size_t)m * 512 + lane * 8);
        float y[8], e[8];
        y[0] = __uint_as_float(yw.x << 16); y[1] = __uint_as_float(yw.x & 0xffff0000u); y[2] = __uint_as_float(yw.y << 16); y[3] = __uint_as_float(yw.y & 0xffff0000u);
        y[4] = __uint_as_float(yw.z << 16); y[5] = __uint_as_float(yw.z & 0xffff0000u); y[6] = __uint_as_float(yw.w << 16); y[7] = __uint_as_float(yw.w & 0xffff0000u);
        e[0] = __uint_as_float(ew.x << 16); e[1] = __uint_as_float(ew.x & 0xffff0000u); e[2] = __uint_as_float(ew.y << 16); e[3] = __uint_as_float(ew.y & 0xffff0000u);
        e[4] = __uint_as_float(ew.z << 16); e[5] = __uint_as_float(ew.z & 0xffff0000u); e[6] = __uint_as_float(ew.w << 16); e[7] = __uint_as_float(ew.w & 0xffff0000u);
        float ss = 0.f;
#pragma unroll
        for (int i = 0; i < 8; ++i) ss += y[i] * y[i];
        ss += __shfl_xor(ss, 1); ss += __shfl_xor(ss, 2); ss += __shfl_xor(ss, 4); ss += __shfl_xor(ss, 8);
        const float rs = 1.0f / sqrtf(ss * (1.f / 128.f) + 1e-6f);
        v4u o; o.x = pk2(y[0] * rs * e[0], y[1] * rs * e[1]); o.y = pk2(y[2] * rs * e[2], y[3] * rs * e[3]); o.z = pk2(y[4] * rs * e[4], y[5] * rs * e[5]); o.w = pk2(y[6] * rs * e[6], y[7] * rs * e[7]);
        *(v4u*)(Y + (size_t)m * 512 + lane * 8) = o;
    }
}
constexpr size_t GDN_QP = 72 * MiB, GDN_MM = 88 * MiB, GDN_NN = 120 * MiB, GDN_E = 152 * MiB;
constexpr int P128 = 136;
__device__ __forceinline__ void m1_gdn(KArgs a, int L, int item, LAS unsigned char* lds, int tid) {
    const int lane = tid & 63, wave = tid >> 6, g = lane >> 4, n = lane & 15, h = item & 3, bc = item >> 2, c = bc & 63, tok0 = bc * 64;
    unsigned char* R = a->ws + WS_R;
    const bf16* hg = (const bf16*)R; bf16* QPg = (bf16*)(R + GDN_QP) + (size_t)item * 8192; bf16* MMg = (bf16*)(R + GDN_MM) + (size_t)item * 16384; bf16* NNg = (bf16*)(R + GDN_NN) + (size_t)item * 16384;
    bf16* E = (bf16*)(R + GDN_E); bf16* Y = (bf16*)(a->ws + WS_O) + (size_t)2 * M * 512;
    LAS bf16* KN = (LAS bf16*)lds; LAS bf16* QN = (LAS bf16*)(lds + 17408); LAS bf16* KNT = (LAS bf16*)(lds + 34816); LAS bf16* VT = (LAS bf16*)(lds + 53248); LAS bf16* KHT = (LAS bf16*)(lds + 71680);
    LAS bf16* S = (LAS bf16*)(lds + 90112); LAS bf16* ST = (LAS bf16*)(lds + 99328); LAS bf16* ATT = (LAS bf16*)(lds + 108544); LAS bf16* S2 = (LAS bf16*)(lds + 117760); LAS bf16* S2T = (LAS bf16*)(lds + 126976);
    LAS bf16* P = (LAS bf16*)(lds + 136192); LAS float* GC = (LAS float*)(lds + 145408); LAS float* BETA = GC + 64;
    LAS bf16* RAW = S;
    LAS bf16* WT = KN; LAS bf16* UT = S2;
    for (int ch = tid; ch < 67 * 48; ch += NTHREADS) {
        const int rr = ch / 48, cc = (ch % 48) * 8;
        const int sc = cc < 128 ? h * 128 + cc : (cc < 256 ? 512 + h * 128 + (cc - 128) : 1024 + h * 128 + (cc - 256));
        v4u val = {0u, 0u, 0u, 0u};
        if (c * 64 - 3 + rr >= 0) val = *(const v4u*)(hg + (size_t)(tok0 - 3 + rr) * LD_GDN + sc);
        *(LAS v4u*)(RAW + rr * 384 + cc) = val;
    }
    if (tid < 64) {
        const size_t ro = (size_t)(tok0 + tid) * LD_GDN;
        const float ai = b2f(hg[ro + 1536 + h]), bi = b2f(hg[ro + 1540 + h]);
        float v = -__expf(a->in[23][L * 4 + h]) * softplusf_(ai + a->in[24][L * 4 + h]);
#pragma unroll
        for (int off = 1; off < 64; off <<= 1) { const float u = __shfl_up(v, off); if (lane >= off) v += u; }
        GC[tid] = v; BETA[tid] = sigmoidf_(bi);
    }
    __syncthreads();
    {
        const float gend = GC[63]; const float* cw = a->in[22] + (size_t)L * 4 * 1536;
        float cwq[2][4], cwk[2][4], cwv[2][4];
#pragma unroll
        for (int u = 0; u < 2; ++u)
#pragma unroll
            for (int i = 0; i < 4; ++i) { const int d = lane + 64 * u; cwq[u][i] = cw[i * 1536 + h * 128 + d]; cwk[u][i] = cw[i * 1536 + 512 + h * 128 + d]; cwv[u][i] = cw[i * 1536 + 1024 + h * 128 + d]; }
        const float ng0 = a->in[25][L * 128 + lane], ng1 = a->in[25][L * 128 + 64 + lane];
#pragma unroll 1
        for (int tt = 0; tt < 8; ++tt) {
            const int t = wave * 8 + tt; const float gct = GC[t];
            float q[2], k[2], v[2];
#pragma unroll
            for (int u = 0; u < 2; ++u) { const int d = lane + 64 * u; float sq = 0.f, sk = 0.f, sv = 0.f;
#pragma unroll
                for (int i = 0; i < 4; ++i) { const LAS bf16* rp = RAW + (t + i) * 384 + d; sq += cwq[u][i] * b2f(rp[0]); sk += cwk[u][i] * b2f(rp[128]); sv += cwv[u][i] * b2f(rp[256]); }
                q[u] = sq * sigmoidf_(sq); k[u] = sk * sigmoidf_(sk); v[u] = sv * sigmoidf_(sv); }
            const float rq = (1.0f / sqrtf(wave_sum(q[0] * q[0] + q[1] * q[1]) + 1e-6f)) * 0.08838834764831845f, rk = 1.0f / sqrtf(wave_sum(k[0] * k[0] + k[1] * k[1]) + 1e-6f);
            const float eg = __expf(gct), eh = __expf(gend - gct);
#pragma unroll
            for (int u = 0; u < 2; ++u) { const int d = lane + 64 * u; const float kn = k[u] * rk, qn = q[u] * rq; const bf16 kb = (bf16)f2bf(kn);
                KN[t * P128 + d] = kb; KNT[d * P64 + t] = kb; QN[t * P128 + d] = (bf16)f2bf(qn); KHT[d * P64 + t] = (bf16)f2bf(kn * eh); VT[d * P64 + t] = (bf16)f2bf(v[u]);
                QPg[t * 128 + kperm(d)] = (bf16)f2bf(qn * eg);
                const float gt = b2f(hg[(size_t)(tok0 + t) * LD_GDN + 1544 + h * 128 + d]);
                E[(size_t)(tok0 + t) * 512 + h * 128 + d] = (bf16)f2bf((u ? ng1 : ng0) * gt * sigmoidf_(gt)); }
        }
    }
    __syncthreads();
#pragma unroll
    for (int i = 0; i < 4; ++i) {
        const int idx = wave * 4 + i, kind = idx >> 4, T = (idx >> 2) & 3, Sx = idx & 3;
        f32x4 acc = {0.f, 0.f, 0.f, 0.f};
        if (Sx <= T) acc = mm16<128>(acc, (kind ? QN : KN) + 16 * T * P128, P128, KN + 16 * Sx * P128, P128, lane);
        const int s = 16 * Sx + n; const float gs = GC[s];
#pragma unroll
        for (int r = 0; r < 4; ++r) { const int t = 16 * T + 4 * g + r; const float dec = __expf(fminf(GC[t] - gs, 0.f));
            acc[r] = kind ? (s <= t ? acc[r] * dec : 0.f) : (s < t ? -BETA[t] * acc[r] * dec : 0.f); }
        if (kind) storeR(ATT, P64, 16 * T, 16 * Sx, acc, lane);
        else { storeR(S, P64, 16 * T, 16 * Sx, acc, lane); storeT(ST, P64, 16 * T, 16 * Sx, acc, lane); }
    }
    __syncthreads();
    for (int e = tid; e < 4096; e += NTHREADS) { const int t = e >> 6, s = e & 63; P[t * P64 + s] = (bf16)f2bf((t == s ? 1.f : 0.f) + b2f(S[t * P64 + s])); }
    __syncthreads();
    {
        LAS bf16* cur = S; LAS bf16* curT = ST; LAS bf16* nxt = S2; LAS bf16* nxtT = S2T;
#pragma unroll 1
        for (int k = 0; k < 5; ++k) {
#pragma unroll
            for (int i = 0; i < 2; ++i) { const int idx = wave * 2 + i, T = idx >> 2, Sx = idx & 3; f32x4 acc = {0.f, 0.f, 0.f, 0.f};
                acc = mm16<64>(acc, cur + 16 * T * P64, P64, curT + 16 * Sx * P64, P64, lane);
                storeR(nxt, P64, 16 * T, 16 * Sx, acc, lane); storeT(nxtT, P64, 16 * T, 16 * Sx, acc, lane); }
            __syncthreads();
            f32x4 pacc[2];
#pragma unroll
            for (int i = 0; i < 2; ++i) { const int idx = wave * 2 + i, T = idx >> 2, Sx = idx & 3;
#pragma unroll
                for (int r = 0; r < 4; ++r) pacc[i][r] = b2f(P[(16 * T + 4 * g + r) * P64 + 16 * Sx + n]);
                pacc[i] = mm16<64>(pacc[i], P + 16 * T * P64, P64, nxtT + 16 * Sx * P64, P64, lane); }
            __syncthreads();
#pragma unroll
            for (int i = 0; i < 2; ++i) { const int idx = wave * 2 + i, T = idx >> 2, Sx = idx & 3; storeR(P, P64, 16 * T, 16 * Sx, pacc[i], lane); }
            __syncthreads();
            LAS bf16* t0 = cur; cur = nxt; nxt = t0; LAS bf16* t1 = curT; curT = nxtT; nxtT = t1;
        }
    }
    for (int e = tid; e < 4096; e += NTHREADS) { const int t = e >> 6, s = e & 63; const float p = b2f(P[t * P64 + s]) * BETA[s]; S[t * P64 + s] = (bf16)f2bf(p * __expf(GC[s])); ST[t * P64 + s] = (bf16)f2bf(p); }
    __syncthreads();
#pragma unroll
    for (int i = 0; i < 8; ++i) {
        const int idx = wave * 8 + i, kind = idx >> 5, T = (idx >> 3) & 3, Dt = idx & 7;
        f32x4 acc = {0.f, 0.f, 0.f, 0.f};
        acc = mm16<64>(acc, (kind ? ST : S) + 16 * T * P64, P64, (kind ? VT : KNT) + 16 * Dt * P64, P64, lane);
        storeT(kind ? UT : WT, P64, 16 * T, 16 * Dt, acc, lane);
    }
    __syncthreads();
    const float egend = __expf(GC[63]);
#pragma unroll
    for (int i = 0; i < 8; ++i) {
        const int idx = wave * 8 + i, kind = idx >> 5, Dt = (idx >> 2) & 7, T = idx & 3;
        f32x4 acc = {0.f, 0.f, 0.f, 0.f};
        acc = mm16<64>(acc, (kind ? UT : WT) + 16 * Dt * P64, P64, ATT + 16 * T * P64, P64, lane);
        const int t = 16 * T + n;
        if (kind) *(u32x2*)(Y + (size_t)(tok0 + t) * 512 + h * 128 + 16 * Dt + 4 * g) = pack4(acc);
        else { bf16* qp = QPg + t * 128 + (Dt >> 1) * 32 + 8 * g + 4 * (Dt & 1); const f32x4 q0 = unpack4(*(const u32x2*)qp); *(u32x2*)qp = pack4(q0 - acc); }
    }
#pragma unroll
    for (int i = 0; i < 16; ++i) {
        const int idx = wave * 16 + i, kind = idx >> 6, A8 = (idx >> 3) & 7, B8 = idx & 7;
        f32x4 acc = {0.f, 0.f, 0.f, 0.f};
        if (kind == 0) {
            acc = mm16<64>(acc, WT + 16 * A8 * P64, P64, KHT + 16 * B8 * P64, P64, lane);
            const int ip = 16 * B8 + n;
#pragma unroll
            for (int r = 0; r < 4; ++r) acc[r] = ((16 * A8 + 4 * g + r) == ip ? egend : 0.f) - acc[r];
            *(u32x2*)(MMg + ip * 128 + (A8 >> 1) * 32 + 8 * g + 4 * (A8 & 1)) = pack4(acc);
        } else {
            acc = mm16<64>(acc, KHT + 16 * A8 * P64, P64, UT + 16 * B8 * P64, P64, lane);
            *(u32x2*)(NNg + (size_t)((B8 * 8 + A8) * 64 + lane) * 4) = pack4(acc);
        }
    }
    __syncthreads();
}
__device__ __forceinline__ void m2_gdn(KArgs a, int b, int h, LAS unsigned char* lds, int tid) {
    const int lane = tid & 63, J = tid >> 6, g = lane >> 4, n = lane & 15;
    unsigned char* R = a->ws + WS_R;
    const bf16* QPb = (const bf16*)(R + GDN_QP); const bf16* MMb = (const bf16*)(R + GDN_MM); const bf16* NNb = (const bf16*)(R + GDN_NN); bf16* Y = (bf16*)(a->ws + WS_O) + (size_t)2 * M * 512;
    constexpr int SLOT = 52224;
    f32x4 H[8];
#pragma unroll
    for (int I = 0; I < 8; ++I) H[I] = (f32x4){0.f, 0.f, 0.f, 0.f};
    v4u pre[6]; u32x2 nn[8], nnn[8], yi[4], yin[4];
#define GDN_GLOAD(c, PRE, NNv, YI) do { const int item_ = (b * 64 + (c)) * 4 + h; \
        _Pragma("unroll") for (int u = 0; u < 6; ++u) { const int ch = tid + 512 * u; PRE[u] = ch < 2048 ? *(const v4u*)(MMb + (size_t)item_ * 16384 + ch * 8) : *(const v4u*)(QPb + (size_t)item_ * 8192 + (ch - 2048) * 8); } \
        _Pragma("unroll") for (int I = 0; I < 8; ++I) NNv[I] = *(const u32x2*)(NNb + (size_t)item_ * 16384 + (size_t)((J * 8 + I) * 64 + lane) * 4); \
        _Pragma("unroll") for (int T = 0; T < 4; ++T) YI[T] = *(const u32x2*)(Y + (size_t)((b * 64 + (c)) * 64 + 16 * T + n) * 512 + h * 128 + 16 * J + 4 * g); } while (0)
#define GDN_LWRITE(slot, PRE) do { LAS unsigned char* base_ = lds + (slot) * SLOT; \
        _Pragma("unroll") for (int u = 0; u < 6; ++u) { const int ch = tid + 512 * u; const int cq = ch < 2048 ? ch : ch - 2048; \
            *(LAS v4u*)(base_ + (ch < 2048 ? 0 : 34816) + (cq >> 4) * (P128 * 2) + (cq & 15) * 16) = PRE[u]; } } while (0)
    GDN_GLOAD(0, pre, nn, yi);
    GDN_LWRITE(0, pre);
    __syncthreads();
#pragma unroll 1
    for (int c = 0; c < 64; ++c) {
        if (c + 1 < 64) GDN_GLOAD(c + 1, pre, nnn, yin);
        const LAS bf16* MMs = (const LAS bf16*)(lds + (c & 1) * SLOT); const LAS bf16* QPs = (const LAS bf16*)(lds + (c & 1) * SLOT + 34816);
        bf16x8 bH[4];
#pragma unroll
        for (int s = 0; s < 4; ++s) bH[s] = frag_of(H[2 * s], H[2 * s + 1]);
#pragma unroll
        for (int T = 0; T < 4; ++T) {
            f32x4 acc = unpack4(yi[T]);
#pragma unroll
            for (int s = 0; s < 4; ++s) acc = mfma16(bH[s], *(const LAS bf16x8*)(QPs + (16 * T + n) * P128 + 32 * s + 8 * g), acc);
            *(u32x2*)(Y + (size_t)((b * 64 + c) * 64 + 16 * T + n) * 512 + h * 128 + 16 * J + 4 * g) = pack4(acc);
        }
#pragma unroll
        for (int I = 0; I < 8; ++I) {
            f32x4 acc = unpack4(nn[I]);
#pragma unroll
            for (int s = 0; s < 4; ++s) acc = mfma16(*(const LAS bf16x8*)(MMs + (16 * I + n) * P128 + 32 * s + 8 * g), bH[s], acc);
            H[I] = acc;
        }
        if (c + 1 < 64) GDN_LWRITE((c + 1) & 1, pre);
        __syncthreads();
#pragma unroll
        for (int I = 0; I < 8; ++I) nn[I] = nnn[I];
#pragma unroll
        for (int T = 0; T < 4; ++T) yi[T] = yin[T];
    }
#undef GDN_GLOAD
#undef GDN_LWRITE
}
constexpr size_t RW_RP = 64 * MiB, RW_MM = 80 * MiB, RW_NN = 96 * MiB, RW_E1 = 112 * MiB, RW_E2 = 128 * MiB, RW_DC = 144 * MiB;
constexpr int P160 = 168;
template <int K> __device__ __forceinline__ f32x4 mm16g(f32x4 acc, const LAS bf16* Ap, int pa, const bf16* Bg, int pbg, int lane) {
    const LAS bf16* a = Ap + (lane & 15) * pa + 8 * (lane >> 4); const bf16* b = Bg + (size_t)(lane & 15) * pbg + 8 * (lane >> 4);
#pragma unroll
    for (int kk = 0; kk < K; kk += 32) acc = mfma16(*(const LAS bf16x8*)(a + kk), *(const bf16x8*)(b + kk), acc);
    return acc;
}
__device__ __forceinline__ void tri_inv(LAS bf16* S, LAS bf16* ST, LAS bf16* S2, LAS bf16* S2T, LAS bf16* P, int wave, int lane, int tid) {
    const int g = lane >> 4, n = lane & 15;
    for (int e = tid; e < 4096; e += NTHREADS) { const int t = e >> 6, s = e & 63; P[t * P64 + s] = (bf16)f2bf((t == s ? 1.f : 0.f) + b2f(S[t * P64 + s])); }
    __syncthreads();
    LAS bf16* cur = S; LAS bf16* curT = ST; LAS bf16* nxt = S2; LAS bf16* nxtT = S2T;
#pragma unroll 1
    for (int k = 0; k < 5; ++k) {
#pragma unroll
        for (int i = 0; i < 2; ++i) { const int idx = wave * 2 + i, T = idx >> 2, Sx = idx & 3; f32x4 acc = {0.f, 0.f, 0.f, 0.f};
            acc = mm16<64>(acc, cur + 16 * T * P64, P64, curT + 16 * Sx * P64, P64, lane);
            storeR(nxt, P64, 16 * T, 16 * Sx, acc, lane); storeT(nxtT, P64, 16 * T, 16 * Sx, acc, lane); }
        __syncthreads();
        f32x4 pacc[2];
#pragma unroll
        for (int i = 0; i < 2; ++i) { const int idx = wave * 2 + i, T = idx >> 2, Sx = idx & 3;
#pragma unroll
            for (int r = 0; r < 4; ++r) pacc[i][r] = b2f(P[(16 * T + 4 * g + r) * P64 + 16 * Sx + n]);
            pacc[i] = mm16<64>(pacc[i], P + 16 * T * P64, P64, nxtT + 16 * Sx * P64, P64, lane); }
        __syncthreads();
#pragma unroll
        for (int i = 0; i < 2; ++i) { const int idx = wave * 2 + i, T = idx >> 2, Sx = idx & 3; storeR(P, P64, 16 * T, 16 * Sx, pacc[i], lane); }
        __syncthreads();
        LAS bf16* t0 = cur; cur = nxt; nxt = t0; LAS bf16* t1 = curT; curT = nxtT; nxtT = t1;
    }
}
__device__ __forceinline__ void m1_rw(KArgs a, int L, int item, LAS unsigned char* lds, int tid) {
    const int lane = tid & 63, wave = tid >> 6, g = lane >> 4, n = lane & 15, h = item & 7, bc = item >> 3, c = bc & 63, tok0 = bc * 64;
    unsigned char* R = a->ws + WS_R; unsigned char* wb = a->ws + WS_W;
    const bf16* hr = (const bf16*)R; bf16* RPg = (bf16*)(R + RW_RP) + (size_t)item * 4096; bf16* MMg = (bf16*)(R + RW_MM) + (size_t)item * 4096; bf16* NNg = (bf16*)(R + RW_NN) + (size_t)item * 4096;
    bf16* E1 = (bf16*)(R + RW_E1); bf16* E2 = (bf16*)(R + RW_E2); bf16* Y = (bf16*)(a->ws + WS_O); float* DCg = (float*)(R + RW_DC) + (size_t)item * 64;
    const float* mu = a->in[8] + L * 1824;
    LAS bf16* ATr = (LAS bf16*)lds; LAS bf16* BTr = ATr + 64 * P64; LAS bf16* KTr = BTr + 64 * P64; LAS bf16* RTr = KTr + 64 * P64;
    LAS bf16* ATt = RTr + 64 * P64; LAS bf16* VTt = ATt + 64 * P64; LAS bf16* BHt = VTt + 64 * P64; LAS bf16* KHt = BHt + 64 * P64;
    LAS bf16* S = KHt + 64 * P64; LAS bf16* ST = S + 64 * P64; LAS bf16* S2 = ST + 64 * P64; LAS bf16* S2T = S2 + 64 * P64; LAS bf16* P = S2T + 64 * P64;
    LAS bf16* AAK = P + 64 * P64; LAS bf16* ARB = AAK + 64 * P64; LAS bf16* ARK = ARB + 64 * P64;
    LAS bf16* WT = ATr; LAS bf16* UT = BTr; LAS bf16* XT = KTr;
    LAS bf16* TW = S; LAS bf16* AL = ST; LAS bf16* GL = S2;
    LAS float* LW = (LAS float*)(lds + 73728 + 39936); LAS float* ASIG = LW + 4096;
    for (int ch = tid; ch < 64 * 36; ch += NTHREADS) {
        const int t = ch / 36, cc = (ch % 36) * 8; const size_t ro = (size_t)(tok0 + t) * LD_RW + 1536 + cc;
        const v4u cw = *(const v4u*)(hr + ro); v4u pw = {0u, 0u, 0u, 0u};
        if (c * 64 + t > 0) pw = *(const v4u*)(hr + ro - LD_RW);
        const unsigned cu[4] = {cw.x, cw.y, cw.z, cw.w}, pu[4] = {pw.x, pw.y, pw.z, pw.w};
#pragma unroll
        for (int e = 0; e < 8; ++e) {
            const float cur = (e & 1) ? __uint_as_float(cu[e >> 1] & 0xffff0000u) : __uint_as_float(cu[e >> 1] << 16), prv = (e & 1) ? __uint_as_float(pu[e >> 1] & 0xffff0000u) : __uint_as_float(pu[e >> 1] << 16);
            const int col = cc + e; const float xs = cur + (prv - cur) * mu[1536 + col];
            if (col < 64) TW[t * P64 + col] = (bf16)f2bf(tanhf_(xs)); else if (col < 128) AL[t * P64 + col - 64] = (bf16)f2bf(xs); else GL[t * P160 + col - 128] = (bf16)f2bf(sigmoidf_(xs));
        }
    }
    __syncthreads();
#pragma unroll
    for (int i = 0; i < 6; ++i) {
        const int idx = wave * 6 + i, kind = idx >> 4, T = (idx >> 2) & 3, Jt = idx & 3;
        f32x4 acc = {0.f, 0.f, 0.f, 0.f};
        if (kind == 0) acc = mm16g<64>(acc, TW + 16 * T * P64, P64, (const bf16*)(wb + WO_RW2T) + (size_t)(h * 64 + 16 * Jt) * 64, 64, lane);
        else if (kind == 1) acc = mm16g<64>(acc, AL + 16 * T * P64, P64, (const bf16*)(wb + WO_RA2T) + (size_t)(h * 64 + 16 * Jt) * 64, 64, lane);
        else acc = mm16g<160>(acc, GL + 16 * T * P160, P160, (const bf16*)(wb + WO_RG2T) + (size_t)(h * 64 + 16 * Jt) * 160, 160, lane);
        const int j = 16 * Jt + n, hj = L * 512 + h * 64 + j;
#pragma unroll
        for (int r = 0; r < 4; ++r) { const int t = 16 * T + 4 * g + r;
            if (kind == 0) { const float w = acc[r] + a->in[9][hj]; LW[t * 64 + j] = -__expf(-softplusf_(-w) - 0.5f); }
            else if (kind == 1) ASIG[t * 64 + j] = sigmoidf_(acc[r] + a->in[11][hj]);
            else E1[(size_t)(tok0 + t) * 512 + h * 64 + j] = (bf16)f2bf(acc[r]); }
    }
    __syncthreads();
    if (tid < 64) { float run = 0.f; for (int t = 0; t < 64; ++t) { run += LW[t * 64 + tid]; LW[t * 64 + tid] = run; } }
    __syncthreads();
    {
        const int hj = L * 512 + h * 64 + lane;
        const float kkj = a->in[14][hj], kaj = a->in[15][hj], rkj = a->in[16][hj], gngj = a->in[17][hj], gnbj = a->in[18][hj];
        const float mur = mu[h * 64 + lane], muk = mu[512 + h * 64 + lane], muv = mu[1024 + h * 64 + lane];
        const float cend = LW[63 * 64 + lane];
        if (wave == 0) DCg[lane] = __expf(cend);
#pragma unroll 1
        for (int tt = 0; tt < 8; ++tt) {
            const int t = wave * 8 + tt; const size_t ro = (size_t)(tok0 + t) * LD_RW + h * 64 + lane; const bool hp = (c * 64 + t) > 0;
            const float rc = b2f(hr[ro]), kc = b2f(hr[ro + 512]), vc = b2f(hr[ro + 1024]);
            const float rp = hp ? b2f(hr[ro - LD_RW]) : 0.f, kp = hp ? b2f(hr[ro + 512 - LD_RW]) : 0.f, vp = hp ? b2f(hr[ro + 1024 - LD_RW]) : 0.f;
            const float r = rc + (rp - rc) * mur, kr = kc + (kp - kc) * muk, v = vc + (vp - vc) * muv;
            const float C = LW[t * 64 + lane], Cm = t > 0 ? LW[(t - 1) * 64 + lane] : 0.f, asig = ASIG[t * 64 + lane];
            const float kkr = kr * kkj, kk = kkr * (1.0f / sqrtf(wave_sum(kkr * kkr) + 1e-6f));
            const float k2 = kr * (1.f + (asig - 1.f) * kaj), av = -kk, bv = kk * asig;
            const float bon = wave_sum(r * k2 * rkj) * v;
            const float eC = __expf(C), eCm = __expf(Cm), eN = __expf(-C), eE = __expf(cend - C);
            const bf16 ab = (bf16)f2bf(av * eCm), rb = (bf16)f2bf(r * eC);
            ATr[t * P64 + lane] = ab; ATt[lane * P64 + t] = ab; BTr[t * P64 + lane] = (bf16)f2bf(bv * eN); KTr[t * P64 + lane] = (bf16)f2bf(k2 * eN); RTr[t * P64 + lane] = rb;
            VTt[lane * P64 + t] = (bf16)f2bf(v); BHt[lane * P64 + t] = (bf16)f2bf(bv * eE); KHt[lane * P64 + t] = (bf16)f2bf(k2 * eE);
            RPg[t * 64 + kperm(lane)] = rb;
            const size_t eo = (size_t)(tok0 + t) * 512 + h * 64 + lane; const float gg = b2f(E1[eo]);
            E1[eo] = (bf16)f2bf(gngj * gg); E2[eo] = (bf16)f2bf((gnbj + bon) * gg);
        }
    }
    __syncthreads();
#pragma unroll
    for (int i = 0; i < 8; ++i) {
        const int idx = wave * 8 + i, kind = idx >> 4, T = (idx >> 2) & 3, Sx = idx & 3;
        f32x4 acc = {0.f, 0.f, 0.f, 0.f};
        if (Sx <= T) acc = mm16<64>(acc, ((kind & 2) ? RTr : ATr) + 16 * T * P64, P64, ((kind & 1) ? KTr : BTr) + 16 * Sx * P64, P64, lane);
        const int s = 16 * Sx + n;
#pragma unroll
        for (int r = 0; r < 4; ++r) { const int t = 16 * T + 4 * g + r; if ((kind & 2) ? (s > t) : (s >= t)) acc[r] = 0.f; }
        if (kind == 0) { storeR(S, P64, 16 * T, 16 * Sx, acc, lane); storeT(ST, P64, 16 * T, 16 * Sx, acc, lane); }
        else storeR(kind == 1 ? AAK : (kind == 2 ? ARB : ARK), P64, 16 * T, 16 * Sx, acc, lane);
    }
    __syncthreads();
    tri_inv(S, ST, S2, S2T, P, wave, lane, tid);
#pragma unroll
    for (int i = 0; i < 4; ++i) {
        const int idx = wave * 4 + i, kind = idx >> 4, T = (idx >> 2) & 3, Dt = idx & 3;
        f32x4 acc = {0.f, 0.f, 0.f, 0.f};
        acc = mm16<64>(acc, (kind ? P : AAK) + 16 * T * P64, P64, (kind ? ATt : VTt) + 16 * Dt * P64, P64, lane);
        storeT(kind ? WT : XT, P64, 16 * T, 16 * Dt, acc, lane);
    }
    __syncthreads();
#pragma unroll
    for (int i = 0; i < 2; ++i) {
        const int idx = wave * 2 + i, T = idx >> 2, Dt = idx & 3;
        f32x4 acc = {0.f, 0.f, 0.f, 0.f};
        acc = mm16<64>(acc, P + 16 * T * P64, P64, XT + 16 * Dt * P64, P64, lane);
        storeT(UT, P64, 16 * T, 16 * Dt, acc, lane);
    }
    __syncthreads();
#pragma unroll
    for (int i = 0; i < 8; ++i) {
        const int idx = wave * 8 + i, kind = idx >> 4, A4 = (idx >> 2) & 3, B4 = idx & 3;
        f32x4 acc = {0.f, 0.f, 0.f, 0.f};
        if (kind == 0) {
            acc = mm16<64>(acc, WT + 16 * A4 * P64, P64, ARB + 16 * B4 * P64, P64, lane);
            bf16* rp = RPg + (16 * B4 + n) * 64 + (A4 >> 1) * 32 + 8 * g + 4 * (A4 & 1); const f32x4 r0 = unpack4(*(const u32x2*)rp); *(u32x2*)rp = pack4(r0 + acc);
        } else if (kind == 1) {
            acc = mm16<64>(acc, UT + 16 * A4 * P64, P64, ARB + 16 * B4 * P64, P64, lane);
            acc = mm16<64>(acc, VTt + 16 * A4 * P64, P64, ARK + 16 * B4 * P64, P64, lane);
            *(u32x2*)(Y + (size_t)(tok0 + 16 * B4 + n) * 512 + h * 64 + 16 * A4 + 4 * g) = pack4(acc);
        } else if (kind == 2) {
            acc = mm16<64>(acc, WT + 16 * A4 * P64, P64, BHt + 16 * B4 * P64, P64, lane);
            const int ip = 16 * B4 + n; const float dc = DCg[ip];
#pragma unroll
            for (int r = 0; r < 4; ++r) if (16 * A4 + 4 * g + r == ip) acc[r] += dc;
            *(u32x2*)(MMg + ip * 64 + (A4 >> 1) * 32 + 8 * g + 4 * (A4 & 1)) = pack4(acc);
        } else {
            acc = mm16<64>(acc, BHt + 16 * A4 * P64, P64, UT + 16 * B4 * P64, P64, lane);
            acc = mm16<64>(acc, KHt + 16 * A4 * P64, P64, VTt + 16 * B4 * P64, P64, lane);
            *(u32x2*)(NNg + (size_t)((B4 * 4 + A4) * 64 + lane) * 4) = pack4(acc);
        }
    }
    __syncthreads();
}
__device__ __forceinline__ void m2_rw(KArgs a, int b, int h, int tid) {
    const int lane = tid & 63, J = tid >> 6, g = lane >> 4, n = lane & 15;
    if (J >= 4) return;
    unsigned char* R = a->ws + WS_R;
    const bf16* RPb = (const bf16*)(R + RW_RP); const bf16* MMb = (const bf16*)(R + RW_MM); const bf16* NNb = (const bf16*)(R + RW_NN); bf16* Y = (bf16*)(a->ws + WS_O);
    f32x4 H[4];
#pragma unroll
    for (int I = 0; I < 4; ++I) H[I] = (f32x4){0.f, 0.f, 0.f, 0.f};
    bf16x8 bq[4][2], bqn[4][2];
#define RW_LOAD(c, BQ) do { const bf16* rp_ = RPb + (size_t)((b * 64 + (c)) * 8 + h) * 4096 + n * 64 + 8 * g; \
        _Pragma("unroll") for (int T = 0; T < 4; ++T) { _Pragma("unroll") for (int s = 0; s < 2; ++s) BQ[T][s] = *(const bf16x8*)(rp_ + T * 1024 + 32 * s); } } while (0)
    RW_LOAD(0, bq);
#pragma unroll 1
    for (int c = 0; c < 64; ++c) {
        const int item = (b * 64 + c) * 8 + h;
        bf16x8 am[4][2]; u32x2 yi[4], nn[4];
        { const bf16* mp_ = MMb + (size_t)item * 4096 + n * 64 + 8 * g; bf16* yp_ = Y + (size_t)((b * 64 + c) * 64 + n) * 512 + h * 64 + 16 * J + 4 * g; const bf16* np_ = NNb + (size_t)item * 4096 + (size_t)(J * 4 * 64 + lane) * 4;
#pragma unroll
          for (int T = 0; T < 4; ++T) { am[T][0] = *(const bf16x8*)(mp_ + T * 1024); am[T][1] = *(const bf16x8*)(mp_ + T * 1024 + 32); yi[T] = *(const u32x2*)(yp_ + (size_t)T * 16 * 512); nn[T] = *(const u32x2*)(np_ + T * 256); } }
        if (c + 1 < 64) RW_LOAD(c + 1, bqn);
        const bf16x8 h0 = frag_of(H[0], H[1]), h1 = frag_of(H[2], H[3]);
#pragma unroll
        for (int T = 0; T < 4; ++T) {
            f32x4 acc = {0.f, 0.f, 0.f, 0.f};
            acc = mfma16(h0, bq[T][0], acc); acc = mfma16(h1, bq[T][1], acc);
            *(u32x2*)(Y + (size_t)((b * 64 + c) * 64 + 16 * T + n) * 512 + h * 64 + 16 * J + 4 * g) = pack4(acc + unpack4(yi[T]));
        }
#pragma unroll
        for (int I = 0; I < 4; ++I) { f32x4 acc = {0.f, 0.f, 0.f, 0.f}; acc = mfma16(am[I][0], h0, acc); acc = mfma16(am[I][1], h1, acc); H[I] = acc + unpack4(nn[I]); }
#pragma unroll
        for (int T = 0; T < 4; ++T) { bq[T][0] = bqn[T][0]; bq[T][1] = bqn[T][1]; }
    }
#undef RW_LOAD
}
__device__ __forceinline__ void m3_rw(bf16* Y, const bf16* E1, const bf16* E2, int gw, int NGW, int lane) {
    for (int m = gw; m < M; m += NGW) {
        const v4u yw = *(const v4u*)(Y + (size_t)m * 512 + lane * 8), e1w = *(const v4u*)(E1 + (size_t)m * 512 + lane * 8), e2w = *(const v4u*)(E2 + (size_t)m * 512 + lane * 8);
        const unsigned yu[4] = {yw.x, yw.y, yw.z, yw.w}, e1u[4] = {e1w.x, e1w.y, e1w.z, e1w.w}, e2u[4] = {e2w.x, e2w.y, e2w.z, e2w.w};
        float y[8], e1[8], e2[8];
#pragma unroll
        for (int i = 0; i < 4; ++i) { y[2 * i] = __uint_as_float(yu[i] << 16); y[2 * i + 1] = __uint_as_float(yu[i] & 0xffff0000u); e1[2 * i] = __uint_as_float(e1u[i] << 16); e1[2 * i + 1] = __uint_as_float(e1u[i] & 0xffff0000u);
            e2[2 * i] = __uint_as_float(e2u[i] << 16); e2[2 * i + 1] = __uint_as_float(e2u[i] & 0xffff0000u); }
        float sm = 0.f;
#pragma unroll
        for (int i = 0; i < 8; ++i) sm += y[i];
        sm += __shfl_xor(sm, 1); sm += __shfl_xor(sm, 2); sm += __shfl_xor(sm, 4);
        const float mean = sm * (1.f / 64.f); float sq = 0.f;
#pragma unroll
        for (int i = 0; i < 8; ++i) { y[i] -= mean; sq += y[i] * y[i]; }
        sq += __shfl_xor(sq, 1); sq += __shfl_xor(sq, 2); sq += __shfl_xor(sq, 4);
        const float rs = 1.0f / sqrtf(sq * (1.f / 64.f) + 64e-5f);
        v4u o; o.x = pk2(y[0] * rs * e1[0] + e2[0], y[1] * rs * e1[1] + e2[1]); o.y = pk2(y[2] * rs * e1[2] + e2[2], y[3] * rs * e1[3] + e2[3]);
        o.z = pk2(y[4] * rs * e1[4] + e2[4], y[5] * rs * e1[5] + e2[5]); o.w = pk2(y[6] * rs * e1[6] + e2[6], y[7] * rs * e1[7] + e2[7]);
        *(v4u*)(Y + (size_t)m * 512 + lane * 8) = o;
    }
}
constexpr int PH_PER_LAYER = 25, N_PHASES = 1 + DEPTH * PH_PER_LAYER;
#ifndef MK_SINGLE
#define MK_SINGLE 0
#endif
#ifndef CHUNK_GLA
#define CHUNK_GLA 1
#endif
#ifndef CHUNK_GDN
#define CHUNK_GDN 1
#endif
#ifndef CHUNK_RW
#define CHUNK_RW 1
#endif
template <int PH> __device__ __forceinline__ void run_phase(LAS unsigned char* lds) {
    constexpr int L = PH > 0 ? (PH - 1) / PH_PER_LAYER : 0, q = PH > 0 ? (PH - 1) % PH_PER_LAYER + 1 : 0, s = q >= 20 ? 1 : 0;
    const int tid = threadIdx.x, lane = tid & 63, wave = __builtin_amdgcn_readfirstlane(tid >> 6);
    const int G = gridDim.x, bid = blockIdx.x;
    KArgs ap = (KArgs)__builtin_amdgcn_kernarg_segment_ptr();
    unsigned char* ws = ap->ws; float* X = ap->out;
    const int gw = bid * NWAVES + wave, NGW = G * NWAVES;
    unsigned char* wb = ws + WS_W;
    bf16* XB = (bf16*)(ws + WS_XB);
    bf16* OB = (bf16*)(ws + WS_O);
    (void)lane; (void)gw; (void)NGW; (void)wb; (void)XB; (void)OB; (void)X; (void)s;
        if constexpr (q == 0) {
            convert_weights(ap, 0, lds, wave, lane, gw, NGW);
            for (int m = gw; m < M; m += NGW) row_pass<false>(ap->in[0] + (size_t)m * D, X + (size_t)m * D, XB + (size_t)m * D, nullptr, nullptr, lane);
        } else if constexpr (q == 1 || q == 20) {
            pg8::Gemm g{XB, (const bf16*)(wb + (s ? WO_W13_1 : WO_W13_0)), M, 5632, D}; pg8::StaticOrder S; S.init(M, 5632, G, bid);
            pg8::EpiSwiGLU E{(bf16*)(ws + WS_R), FF};
            pg8::gemm_phase<pg8::EpiSwiGLU, pg8::StaticOrder, true, true>(lds, g, S, E, tid);
        } else if constexpr (q == 2 || q == 21) {
            pg8::Gemm g{(const bf16*)(ws + WS_R), (const bf16*)(wb + (s ? WO_W2_1 : WO_W2_0)), M, D, FF}; pg8::StaticOrder S; S.init(M, D, G, bid);
            pg8::EpiResid E{X, ALPHA, 0.5f};
            pg8::gemm_phase<pg8::EpiResid, pg8::StaticOrder, true, true>(lds, g, S, E, tid);
        } else if constexpr (q == 3 || q == 19 || q == 22 || q == 25) {
            const int li = q == 3 ? 0 : (q == 19 ? 1 : (q == 22 ? 2 : 3));
            const float* lng = ap->in[2] + (size_t)(L * 4 + li) * D; const float* lnb = ap->in[3] + (size_t)(L * 4 + li) * D;
            for (int m = gw; m < M; m += NGW) row_pass<true>(X + (size_t)m * D, X + (size_t)m * D, XB + (size_t)m * D, lng, lnb, lane);
            if (q == 22) {
                const float* ps = ap->in[1] + (size_t)L * M * PLE; bf16* pd = (bf16*)(ws + WS_R);
                for (size_t e = (size_t)(bid * NTHREADS + tid) * 4; e < (size_t)M * PLE; e += (size_t)G * NTHREADS * 4) {
                    const f32x4 v = *(const GAS f32x4*)(ps + e);
                    *(GAS unsigned long long*)(pd + e) = (unsigned long long)pk2(v.x, v.y) | ((unsigned long long)pk2(v.z, v.w) << 32);
                }
            }
            if (q == 25 && L + 1 < DEPTH) convert_weights(ap, L + 1, lds, wave, lane, gw, NGW);
        } else if constexpr (q == 4 || q == 8 || q == 12) {
            const int ld = q == 4 ? LD_RW : (q == 8 ? LD_GLA : LD_GDN); const size_t wo = q == 4 ? WO_WRW : (q == 8 ? WO_WGLA : WO_WGDN);
            pg8::Gemm g{XB, (const bf16*)(wb + wo), M, ld, D}; pg8::StaticOrder S; S.init(M, ld, G, bid);
            pg8::EpiStore<0> E{(bf16*)(ws + WS_R), ld};
            pg8::gemm_phase<pg8::EpiStore<0>, pg8::StaticOrder, true, true>(lds, g, S, E, tid);
        } else if constexpr (q == 5) {
#if CHUNK_RW
            for (int it = bid; it < 2048; it += G) m1_rw(ap, L, it, lds, tid);
#endif
        } else if constexpr (q == 6) {
#if CHUNK_RW
            if (bid < 32) m2_rw(ap, bid >> 3, bid & 7, tid);
#else
            if (bid < 32) mix_rwkv(ap, L, bid >> 3, bid & 7, (LAS float*)lds, tid, (const bf16*)(ws + WS_R), OB);
#endif
        } else if constexpr (q == 7) {
#if CHUNK_RW
            m3_rw(OB, (const bf16*)(ws + WS_R + RW_E1), (const bf16*)(ws + WS_R + RW_E2), gw, NGW, lane);
#endif
        } else if constexpr (q == 9) {
#if CHUNK_GLA
            for (int it = bid; it < 1024; it += G) m1_gla(ap, L, it, lds, tid);
#endif
        } else if constexpr (q == 10) {
#if CHUNK_GLA
            if (bid < 16) m2_gla(ap, bid >> 2, bid & 3, tid);
#else
            if (bid < 16) mix_gla(ap, L, bid >> 2, bid & 3, (LAS float*)lds, tid, (const bf16*)(ws + WS_R), OB + (size_t)M * 512);
#endif
        } else if constexpr (q == 11) {
#if CHUNK_GLA
            m3_rms(OB + (size_t)M * 512, (const bf16*)(ws + WS_R + GLA_E), gw, NGW, lane);
#endif
        } else if constexpr (q == 13) {
#if CHUNK_GDN
            for (int it = bid; it < 1024; it += G) m1_gdn(ap, L, it, lds, tid);
#endif
        } else if constexpr (q == 14) {
#if CHUNK_GDN
            if (bid < 16) m2_gdn(ap, bid >> 2, bid & 3, lds, tid);
#else
            if (bid < 16) mix_gdn(ap, L, bid >> 2, bid & 3, (LAS float*)lds, tid, (const bf16*)(ws + WS_R), OB + (size_t)2 * M * 512);
#endif
        } else if constexpr (q == 15) {
#if CHUNK_GDN
            m3_rms(OB + (size_t)2 * M * 512, (const bf16*)(ws + WS_R + GDN_E), gw, NGW, lane);
#endif
        } else if constexpr (q == 16) {
            pg8::Gemm g{XB, (const bf16*)(wb + WO_WG), M, NGATE, D}; pg8::StaticOrder S; S.init(M, NGATE, G, bid);
            pg8::EpiStore<2> E{(bf16*)(ws + WS_R), NGATE};
            pg8::gemm_phase<pg8::EpiStore<2>, pg8::StaticOrder, true, true>(lds, g, S, E, tid);
        } else if constexpr (q == 17) {
            pg8::Gemm g{(const bf16*)(ws + WS_O), (const bf16*)(wb + WO_WBR), 3 * M, 3 * 1024, 512}; pg8::BranchOrder S; S.init(G, bid);
            pg8::EpiBranch E{(const bf16*)(ws + WS_R), (float*)(ws + WS_R_ACC), XB};
            pg8::gemm_phase<pg8::EpiBranch, pg8::BranchOrder, true, true>(lds, g, S, E, tid);
        } else if constexpr (q == 18) {
            pg8::Gemm g{XB, (const bf16*)(wb + WO_WO), M, D, D}; pg8::StaticOrder S; S.init(M, D, G, bid);
            pg8::EpiResid E{X, ALPHA, 1.0f};
            pg8::gemm_phase<pg8::EpiResid, pg8::StaticOrder, true, true>(lds, g, S, E, tid);
        } else if constexpr (q == 23) {
            int kple = PLE; asm volatile("" : "+s"(kple));
            pg8::Gemm g{(const bf16*)(ws + WS_R), (const bf16*)(wb + WO_WPP), M, D, kple}; pg8::StaticOrder S; S.init(M, D, G, bid);
            pg8::EpiStore<0> E{(bf16*)(ws + WS_R_PP), D};
            pg8::gemm_phase<pg8::EpiStore<0>, pg8::StaticOrder, true, true>(lds, g, S, E, tid);
        } else if constexpr (q == 24) {
            pg8::Gemm g{XB, (const bf16*)(wb + WO_WPG), M, D, D}; pg8::StaticOrder S; S.init(M, D, G, bid);
            pg8::EpiPle E{X, (const bf16*)(ws + WS_R_PP), ALPHA};
            pg8::gemm_phase<pg8::EpiPle, pg8::StaticOrder, true, true>(lds, g, S, E, tid);
        }
}
__global__ void __launch_bounds__(NTHREADS, 2) mk_fwd(Args args) {
    extern __shared__ __attribute__((aligned(16))) unsigned char lds_raw[];
    LAS unsigned char* lds = (LAS unsigned char*)lds_raw;
#if MK_SINGLE
    cg::grid_group grid = cg::this_grid();
#define PHASE(k) if (args.ph_lo <= (k) && (k) < args.ph_hi) { run_phase<(k)>(lds); if ((k) + 1 < args.ph_hi) grid.sync(); }
#else
#define PHASE(k) if (args.ph_lo <= (k) && (k) < args.ph_hi) { run_phase<(k)>(lds); }
#endif
    PHASE(0)
    PHASE(1)
    PHASE(2)
    PHASE(3)
    PHASE(4)
    PHASE(5)
    PHASE(6)
    PHASE(7)
    PHASE(8)
    PHASE(9)
    PHASE(10)
    PHASE(11)
    PHASE(12)
    PHASE(13)
    PHASE(14)
    PHASE(15)
    PHASE(16)
    PHASE(17)
    PHASE(18)
    PHASE(19)
    PHASE(20)
    PHASE(21)
    PHASE(22)
    PHASE(23)
    PHASE(24)
    PHASE(25)
    PHASE(26)
    PHASE(27)
    PHASE(28)
    PHASE(29)
    PHASE(30)
    PHASE(31)
    PHASE(32)
    PHASE(33)
    PHASE(34)
    PHASE(35)
    PHASE(36)
    PHASE(37)
    PHASE(38)
    PHASE(39)
    PHASE(40)
    PHASE(41)
    PHASE(42)
    PHASE(43)
    PHASE(44)
    PHASE(45)
    PHASE(46)
    PHASE(47)
    PHASE(48)
    PHASE(49)
    PHASE(50)
#undef PHASE
    static_assert(N_PHASES == 51, "phase slots");
}

#ifdef MK_DEBUG
__global__ void __launch_bounds__(NTHREADS, 2) dbg_naive(Args args, int which, int L) {
    extern __shared__ __attribute__((aligned(16))) unsigned char lds_raw[];
    KArgs ap = (KArgs)__builtin_amdgcn_kernarg_segment_ptr();
    const int tid = threadIdx.x, bid = blockIdx.x;
    bf16* dst = (bf16*)(args.ws + WS_DBG);
    if (which == 0) mix_rwkv(ap, L, 0, bid, (LAS float*)lds_raw, tid, (const bf16*)(args.ws + WS_R), dst);
    else if (which == 1) mix_gla(ap, L, 0, bid, (LAS float*)lds_raw, tid, (const bf16*)(args.ws + WS_R), dst);
    else mix_gdn(ap, L, 0, bid, (LAS float*)lds_raw, tid, (const bf16*)(args.ws + WS_R), dst);
}
__global__ void dbg_cmp(Args args, int which) {
    const bf16* o = (const bf16*)(args.ws + WS_O) + (size_t)which * M * 512; const bf16* r = (const bf16*)(args.ws + WS_DBG);
    float mx = 0.f;
    for (size_t e = (size_t)blockIdx.x * blockDim.x + threadIdx.x; e < (size_t)SEQ * 512; e += (size_t)gridDim.x * blockDim.x) {
#ifdef MK_DEBUG_TMAX
        if ((int)(e / 512) >= MK_DEBUG_TMAX) continue;
#endif
        mx = fmaxf(mx, fabsf(b2f(o[e]) - b2f(r[e])));
    }
    atomicMax((unsigned*)args.ws + 1 + which, __float_as_uint(mx));
}
__global__ void dbg_inject(Args args) {
    if (threadIdx.x == 0 && blockIdx.x == 0) { const float* d = (const float*)args.ws; args.out[0] += 1.0e4f * d[1 + MK_DEBUG]; }
}
#endif

extern "C" void kernel_launch(void* const* d_in, const int* in_sizes, int n_in, void* d_out, int out_size, void* d_ws, size_t ws_size, hipStream_t stream) {
    static int grid = 0;
    if (grid == 0) {
        if (n_in != 30 || out_size != M * D || ws_size < WS_END) { fprintf(stderr, "kernel_launch: unexpected problem: n_in %d out %d ws %zu\n", n_in, out_size, ws_size); grid = -1; return; }
        int dev = 0, cus = 0, per_cu = 0;
        (void)hipGetDevice(&dev); (void)hipDeviceGetAttribute(&cus, hipDeviceAttributeMultiprocessorCount, dev);
        (void)hipFuncSetAttribute((const void*)mk_fwd, hipFuncAttributeMaxDynamicSharedMemorySize, LDS_BYTES);
#ifdef MK_DEBUG
        (void)hipFuncSetAttribute((const void*)dbg_naive, hipFuncAttributeMaxDynamicSharedMemorySize, LDS_BYTES);
#endif
        (void)hipOccupancyMaxActiveBlocksPerMultiprocessor(&per_cu, (const void*)mk_fwd, NTHREADS, LDS_BYTES);
        (void)hipGetLastError();
        if (per_cu < 1) { fprintf(stderr, "kernel_launch: occupancy query says %d\n", per_cu); per_cu = 1; }
        grid = cus;
        if (grid > 256) grid = 256;
    }
    if (grid < 0) return;
    Args a{};
    for (int i = 0; i < 30; ++i) a.in[i] = (const float*)d_in[i];
    a.out = (float*)d_out; a.ws = (unsigned char*)d_ws;
#if MK_SINGLE
    a.ph_lo = 0; a.ph_hi = N_PHASES;
    void* kargs[] = {&a};
    hipError_t e = hipLaunchCooperativeKernel((const void*)mk_fwd, dim3(grid), dim3(NTHREADS), kargs, LDS_BYTES, stream);
    if (e != hipSuccess) fprintf(stderr, "cooperative launch failed: %s (grid %d)\n", hipGetErrorString(e), grid);
#else
#ifdef MK_DEBUG
    (void)hipMemsetAsync(d_ws, 0, 4096, stream);
#endif
    for (int ph = 0; ph < N_PHASES; ++ph) {
        a.ph_lo = ph; a.ph_hi = ph + 1;
        hipLaunchKernelGGL(mk_fwd, dim3(grid), dim3(NTHREADS), LDS_BYTES, stream, a);
#ifdef MK_DEBUG
        { const int L_ = ph > 0 ? (ph - 1) / PH_PER_LAYER : 0, q_ = ph > 0 ? (ph - 1) % PH_PER_LAYER + 1 : 0;
          const int which = q_ == 7 ? 0 : (q_ == 11 ? 1 : (q_ == 15 ? 2 : -1));
          if (which == MK_DEBUG) { hipLaunchKernelGGL(dbg_naive, dim3(which == 0 ? 8 : 4), dim3(NTHREADS), LDS_BYTES, stream, a, which, L_); hipLaunchKernelGGL(dbg_cmp, dim3(256), dim3(256), 0, stream, a, which); } }
#endif
    }
#ifdef MK_DEBUG
    hipLaunchKernelGGL(dbg_inject, dim3(1), dim3(64), 0, stream, a);
#endif
#endif
}
```

```cpp
#define MK_SINGLE 1
#include <hip/hip_runtime.h>
#include <hip/hip_cooperative_groups.h>
#include <cstdio>
#include <cstdint>
namespace pg8 {
#define PG8_LAS __attribute__((address_space(3)))
typedef unsigned short bf16_t;
typedef short bf16x8 __attribute__((ext_vector_type(8)));
typedef float f32x4 __attribute__((ext_vector_type(4)));
typedef unsigned u32x4 __attribute__((ext_vector_type(4)));
constexpr int BM = 256, BK = 64, HALF = 128, HTB = HALF * BK * 2  , STAGE_BYTES = 8 * HTB, NXCD = 8, WGM = 8;

__host__ __device__ __forceinline__ int lds_byte(int r, int c) { const int st = (r >> 4) * 2 + (c >> 5), rr = r & 15, cc = c & 31, ob = rr * 64 + cc * 2; return st * 1024 + (ob ^ (((ob >> 9) & 1) << 5)); }
__host__ __device__ __forceinline__ void stage_rc(int b, int& R, int& C) { const int st = b / 1024, sb = b % 1024, swz = sb ^ (((sb >> 9) & 1) << 5); R = (st >> 1) * 16 + swz / 64; C = (st & 1) * 32 + (swz % 64) / 2; }
__host__ __device__ __forceinline__ int perm32(int rho) { const int n = rho >> 4, i = rho & 15; return 8 * (i >> 2) + 4 * n + (i & 3); }

struct Unit { int pm, pn; };
struct Gemm { const bf16_t* A; const bf16_t* Bt; int M, N, K; };

struct StaticOrder {
    int nM, nN, nwg, G, c;
    __host__ __device__ void init(int M, int N, int G_, int c_) { nM = M / BM; nN = N / BM; nwg = nM * nN; G = G_; c = c_; }
    __host__ __device__ bool next(int i, Unit& u) const {
        const long L = (long)i * G + c; if (L >= nwg) return false;
        int wgid = (int)L; { const int q = nwg / NXCD, r = nwg % NXCD, xcd = wgid % NXCD, off = wgid / NXCD; wgid = (xcd < r ? xcd * (q + 1) : r * (q + 1) + (xcd - r) * q) + off; }
        const int nig = WGM * nN, gid = wgid / nig, fm = gid * WGM, gsz = (nM - fm) < WGM ? (nM - fm) : WGM;
        u.pm = fm + ((wgid % nig) % gsz); u.pn = (wgid % nig) / gsz; return true;
    }
    __device__ __forceinline__ void a_ready(const Unit&) const {}
    __device__ __forceinline__ void done(const Unit&) const {}
};

__device__ __forceinline__ unsigned cvt_pk_bf16(float lo, float hi) { unsigned r; asm volatile("v_cvt_pk_bf16_f32 %0, %1, %2" : "=v"(r) : "v"(lo), "v"(hi)); return r; }
typedef unsigned u32x2 __attribute__((ext_vector_type(2)));
__device__ __forceinline__ float fsigmoid(float x) { return __builtin_amdgcn_rcpf(1.0f + __builtin_amdgcn_exp2f(-1.44269504f * x)); }
__device__ __forceinline__ unsigned bf16_sw(float f) { const unsigned u = __float_as_uint(f); return (u + 0x7fffu + ((u >> 16) & 1u)) >> 16; }
__device__ __forceinline__ unsigned pk_bf16_sw(float lo, float hi) { return bf16_sw(lo) | (bf16_sw(hi) << 16); }
__device__ __forceinline__ float bf2f(unsigned short u) { return __uint_as_float((unsigned)u << 16); }
__device__ __forceinline__ float bflo(unsigned w) { return __uint_as_float(w << 16); }
__device__ __forceinline__ float bfhi(unsigned w) { return __uint_as_float(w & 0xffff0000u); }

struct EpiSwiGLU {
    static constexpr bool PERM = true, AFTER_DRAIN = false;
    bf16_t* O; int ldc;
    __device__ __forceinline__ void operator()(const f32x4 (&acc)[2][2][4][2], const Unit& u, int wr, int wc, int fr, int fq) const {
        const int row0 = u.pm * BM + wr * 64 + fr, col0 = u.pn * HALF + wc * 32 + 8 * fq;
#pragma unroll
        for (int ai = 0; ai < 2; ++ai)
#pragma unroll
            for (int m = 0; m < 4; ++m) {
                bf16_t* rowp = O + (size_t)(row0 + ai * HALF + m * 16) * ldc + col0;
                const f32x4 g0 = acc[ai][0][m][0], g1 = acc[ai][0][m][1], u0 = acc[ai][1][m][0], u1 = acc[ai][1][m][1];
                float h[8];
#pragma unroll
                for (int e = 0; e < 4; ++e) { h[e] = g0[e] * fsigmoid(g0[e]) * u0[e]; h[4 + e] = g1[e] * fsigmoid(g1[e]) * u1[e]; }
                u32x4 w; w.x = cvt_pk_bf16(h[0], h[1]); w.y = cvt_pk_bf16(h[2], h[3]); w.z = cvt_pk_bf16(h[4], h[5]); w.w = cvt_pk_bf16(h[6], h[7]);
                *(u32x4*)rowp = w;
            }
    }
};
template <int ACT> struct EpiStore {
    static constexpr bool PERM = true, AFTER_DRAIN = false;
    bf16_t* O; int ldc;
    __device__ __forceinline__ void operator()(const f32x4 (&acc)[2][2][4][2], const Unit& u, int wr, int wc, int fr, int fq) const {
        const int row0 = u.pm * BM + wr * 64 + fr, col0 = u.pn * BM + wc * 32 + 8 * fq;
#pragma unroll
        for (int ai = 0; ai < 2; ++ai)
#pragma unroll
            for (int m = 0; m < 4; ++m) {
                bf16_t* rowp = O + (size_t)(row0 + ai * HALF + m * 16) * ldc + col0;
#pragma unroll
                for (int bj = 0; bj < 2; ++bj) {
                    f32x4 v0 = acc[ai][bj][m][0], v1 = acc[ai][bj][m][1];
                    if (ACT == 2) {
#pragma unroll
                        for (int e = 0; e < 4; ++e) { v0[e] = fsigmoid(v0[e]); v1[e] = fsigmoid(v1[e]); }
                    }
                    u32x4 w;
                    if (ACT == 2) { w.x = pk_bf16_sw(v0[0], v0[1]); w.y = pk_bf16_sw(v0[2], v0[3]); w.z = pk_bf16_sw(v1[0], v1[1]); w.w = pk_bf16_sw(v1[2], v1[3]); }
                    else { w.x = cvt_pk_bf16(v0[0], v0[1]); w.y = cvt_pk_bf16(v0[2], v0[3]); w.z = cvt_pk_bf16(v1[0], v1[1]); w.w = cvt_pk_bf16(v1[2], v1[3]); }
                    *(u32x4*)(rowp + bj * HALF) = w;
                }
            }
    }
};
struct EpiResid {
    static constexpr bool PERM = false, AFTER_DRAIN = false;
    float* X; float alpha, s;
    __device__ __forceinline__ void operator()(const f32x4 (&acc)[2][2][4][2], const Unit& u, int wr, int wc, int fr, int fq) const {
        const int col0 = u.pn * BM + wc * 32 + 4 * fq;
#pragma unroll
        for (int ai = 0; ai < 2; ++ai)
#pragma unroll
            for (int m = 0; m < 4; ++m) {
                const int r = u.pm * BM + ai * HALF + wr * 64 + m * 16 + fr; float* p = X + (size_t)r * 1024 + col0;
#pragma unroll
                for (int bj = 0; bj < 2; ++bj)
#pragma unroll
                    for (int n = 0; n < 2; ++n) { f32x4 v = *(const f32x4*)(p + bj * HALF + n * 16); v = v * alpha + acc[ai][bj][m][n] * s; *(f32x4*)(p + bj * HALF + n * 16) = v; }
                asm volatile("" ::: "memory");
            }
    }
};
struct EpiBranch {
    static constexpr bool PERM = false, AFTER_DRAIN = false;
    const bf16_t* G; float* ACC; bf16_t* MG;
    __device__ __forceinline__ void operator()(const f32x4 (&acc)[2][2][4][2], const Unit& u, int wr, int wc, int fr, int fq) const {
        const int b = u.pm >> 6, pm = u.pm & 63, pn = u.pn & 3;
        const int col0 = pn * BM + wc * 32 + 4 * fq;
#pragma unroll
        for (int ai = 0; ai < 2; ++ai)
#pragma unroll
            for (int m = 0; m < 4; ++m) {
                const int r = pm * BM + ai * HALF + wr * 64 + m * 16 + fr;
                float* pa = ACC + (size_t)r * 1024 + col0; const bf16_t* pg = G + (size_t)r * 3072 + b * 1024 + col0; bf16_t* po = MG + (size_t)r * 1024 + col0;
#pragma unroll
                for (int bj = 0; bj < 2; ++bj)
#pragma unroll
                    for (int n = 0; n < 2; ++n) {
                        const int o = bj * HALF + n * 16;
                        const u32x2 gw = *(const u32x2*)(pg + o);
                        f32x4 v = acc[ai][bj][m][n];
                        v[0] *= bflo(gw.x); v[1] *= bfhi(gw.x); v[2] *= bflo(gw.y); v[3] *= bfhi(gw.y);
#ifdef ZERO_BRANCH
                        if (b == ZERO_BRANCH) v = (f32x4){0.f, 0.f, 0.f, 0.f};
#endif
                        if (b > 0) v += *(const f32x4*)(pa + o);
                        if (b < 2) *(f32x4*)(pa + o) = v;
                        else { u32x2 w; w.x = cvt_pk_bf16(v[0], v[1]); w.y = cvt_pk_bf16(v[2], v[3]); *(u32x2*)(po + o) = w; }
                    }
                asm volatile("" ::: "memory");
            }
    }
};
struct EpiPle {
    static constexpr bool PERM = false, AFTER_DRAIN = false;
    float* X; const bf16_t* P; float alpha;
    __device__ __forceinline__ void operator()(const f32x4 (&acc)[2][2][4][2], const Unit& u, int wr, int wc, int fr, int fq) const {
        const int col0 = u.pn * BM + wc * 32 + 4 * fq;
#pragma unroll
        for (int ai = 0; ai < 2; ++ai)
#pragma unroll
            for (int m = 0; m < 4; ++m) {
                const int r = u.pm * BM + ai * HALF + wr * 64 + m * 16 + fr; float* p = X + (size_t)r * 1024 + col0; const bf16_t* pp = P + (size_t)r * 1024 + col0;
#pragma unroll
                for (int bj = 0; bj < 2; ++bj)
#pragma unroll
                    for (int n = 0; n < 2; ++n) {
                        const int o = bj * HALF + n * 16;
                        f32x4 v = *(const f32x4*)(p + o); const u32x2 pw = *(const u32x2*)(pp + o); const f32x4 a = acc[ai][bj][m][n];
                        v[0] = v[0] * alpha + fsigmoid(a[0]) * bflo(pw.x); v[1] = v[1] * alpha + fsigmoid(a[1]) * bfhi(pw.x);
                        v[2] = v[2] * alpha + fsigmoid(a[2]) * bflo(pw.y); v[3] = v[3] * alpha + fsigmoid(a[3]) * bfhi(pw.y);
                        *(f32x4*)(p + o) = v;
                    }
                asm volatile("" ::: "memory");
            }
    }
};
struct BranchOrder {
    StaticOrder so;
    __host__ __device__ void init(int G_, int c_) { so.init(16384, 1024, G_, c_); }
    __host__ __device__ bool next(int i, Unit& u) const { if (i >= 3) return false; Unit t; if (!so.next(0, t)) return false; u.pm = i * 64 + t.pm; u.pn = i * 4 + t.pn; return true; }
    __device__ __forceinline__ void a_ready(const Unit&) const {}
    __device__ __forceinline__ void done(const Unit&) const {}
};

template <class Epi, class Sched, bool ALIGN_EPI = false, bool SP2 = false>
__device__ __forceinline__ void gemm_phase(PG8_LAS unsigned char* lds, const Gemm g, const Sched& S, const Epi& E, const int tid) {
    const int  wid = __builtin_amdgcn_readfirstlane(tid >> 6), lane = tid & 63, wr = wid >> 2, wc = wid & 3, fr = lane & 15, fq = lane >> 4;
    const int K = g.K, nt = K / BK;
    unsigned voffA[2], voffB[2];
#pragma unroll
    for (int i = 0; i < 2; ++i) { int R, C; stage_rc(tid * 16 + i * 8192, R, C); const int Rb = Epi::PERM ? ((R & ~31) + perm32(R & 31)) : R;
        voffA[i] = (unsigned)(R * K + C) * 2u; voffB[i] = (unsigned)(Rb * K + C) * 2u; }
    const size_t kstep = (size_t)(BK * 2);
    const size_t hstep = (size_t)HALF * K * 2;
    const size_t tstep = 2 * hstep;
    const unsigned ldsw = (unsigned)wid * 1024u;
    const int aoff = lds_byte(wr * 64 + fr, fq * 8), boff = lds_byte(wc * 32 + fr, fq * 8);
#define PG8_SA(b, h) (((b) * 2 + (h)) * HTB)
#define PG8_SB(b, h) ((4 + (b) * 2 + (h)) * HTB)
#define PG8_STAGE(bufoff, gbase, voff) do { _Pragma("unroll") for (int _i = 0; _i < 2; ++_i) \
        __builtin_amdgcn_global_load_lds((const unsigned*)((const char*)(gbase) + (voff)[_i]), (PG8_LAS unsigned*)(lds + (bufoff) + ldsw + _i * 8192), 16, 0, 0); } while (0)
#define PG8_LDA(dst, b, h) do { _Pragma("unroll") for (int m = 0; m < 4; ++m) _Pragma("unroll") for (int k = 0; k < 2; ++k) dst[m][k] = *(const PG8_LAS bf16x8*)(lds + PG8_SA(b, h) + aoff + m * 2048 + k * 1024); } while (0)
#define PG8_LDB(dst, b, h) do { _Pragma("unroll") for (int n = 0; n < 2; ++n) _Pragma("unroll") for (int k = 0; k < 2; ++k) dst[n][k] = *(const PG8_LAS bf16x8*)(lds + PG8_SB(b, h) + boff + n * 2048 + k * 1024); } while (0)
#define PG8_MMA(ai, bj, At, Bt) do { __builtin_amdgcn_s_setprio(1); _Pragma("unroll") for (int m = 0; m < 4; ++m) _Pragma("unroll") for (int n = 0; n < 2; ++n) _Pragma("unroll") for (int k = 0; k < 2; ++k) \
        acc[ai][bj][m][n] = __builtin_amdgcn_mfma_f32_16x16x32_bf16(Bt[n][k], At[m][k], acc[ai][bj][m][n], 0, 0, 0); __builtin_amdgcn_s_setprio(0); } while (0)
#define PG8_WAIT_V(n) asm volatile("s_waitcnt vmcnt(" #n ")" ::: "memory")
#define PG8_WAIT_L(n) asm volatile("s_waitcnt lgkmcnt(" #n ")" ::: "memory")
#define PG8_BAR __builtin_amdgcn_s_barrier()
#define PG8_SCHED __builtin_amdgcn_sched_barrier(0)
    Unit cur, nxt; int ui = 0;
    if (!S.next(0, cur)) return;
    f32x4 acc[2][2][4][2];
#pragma unroll
    for (int a = 0; a < 2; ++a)
#pragma unroll
        for (int b = 0; b < 2; ++b)
#pragma unroll
            for (int m = 0; m < 4; ++m)
#pragma unroll
                for (int n = 0; n < 2; ++n) acc[a][b][m][n] = (f32x4){0.f, 0.f, 0.f, 0.f};
    bf16x8 At[4][2], B0[2][2], B1[2][2];
    const char* cA = (const char*)g.A + (size_t)cur.pm * tstep; const char* cB = (const char*)g.Bt + (size_t)cur.pn * tstep;
    S.a_ready(cur);
    if constexpr (SP2) {
        PG8_STAGE(PG8_SB(0, 0), cB, voffB); PG8_STAGE(PG8_SB(0, 1), cB + hstep, voffB); PG8_STAGE(PG8_SA(0, 0), cA, voffA); PG8_STAGE(PG8_SA(0, 1), cA + hstep, voffA);
        if (wr == 1) PG8_BAR;
        PG8_WAIT_V(2); PG8_BAR;
        PG8_STAGE(PG8_SB(1, 0), cB + kstep, voffB); PG8_STAGE(PG8_SA(1, 0), cA + kstep, voffA); PG8_STAGE(PG8_SB(1, 1), cB + hstep + kstep, voffB);
        PG8_WAIT_V(6); PG8_BAR;
    } else {
        PG8_STAGE(PG8_SB(0, 0), cB, voffB); PG8_STAGE(PG8_SA(0, 0), cA, voffA); PG8_STAGE(PG8_SB(0, 1), cB + hstep, voffB); PG8_STAGE(PG8_SA(0, 1), cA + hstep, voffA);
        if (wr == 1) PG8_BAR;
        PG8_WAIT_V(4); PG8_BAR;
        PG8_STAGE(PG8_SB(1, 0), cB + kstep, voffB); PG8_STAGE(PG8_SA(1, 0), cA + kstep, voffA); PG8_STAGE(PG8_SB(1, 1), cB + hstep + kstep, voffB);
        PG8_WAIT_V(6); PG8_BAR;
    }
    for (;;) {
        const bool has_next = S.next(ui + 1, nxt);
        const char* nA = has_next ? (const char*)g.A + (size_t)nxt.pm * tstep : cA; const char* nB = has_next ? (const char*)g.Bt + (size_t)nxt.pn * tstep : cB;
        for (int t = 0; t < nt; t += 2) {
            const bool last = (t == nt - 2);
            const char* a1 = cA + (size_t)(t + 1) * kstep;
            const char* a2 = last ? nA : cA + (size_t)(t + 2) * kstep; const char* b2 = last ? nB : cB + (size_t)(t + 2) * kstep;
            const char* a3 = a2 + kstep; const char* b3 = b2 + kstep;
            if (last && has_next) S.a_ready(nxt);
            if constexpr (SP2) {
            PG8_LDB(B0, 0, 0); PG8_LDB(B1, 0, 1); PG8_SCHED; PG8_LDA(At, 0, 0); PG8_STAGE(PG8_SA(1, 1), a1 + hstep, voffA);
            PG8_WAIT_V(8); PG8_WAIT_L(0); PG8_BAR; PG8_MMA(0, 0, At, B0); PG8_MMA(0, 1, At, B1); PG8_BAR; PG8_SCHED;
            PG8_LDA(At, 0, 1); PG8_STAGE(PG8_SB(0, 0), b2, voffB); PG8_STAGE(PG8_SB(0, 1), b2 + hstep, voffB); PG8_STAGE(PG8_SA(0, 0), a2, voffA);
            PG8_WAIT_V(8); PG8_WAIT_L(0); PG8_BAR; PG8_MMA(1, 0, At, B0); PG8_MMA(1, 1, At, B1); PG8_BAR; PG8_SCHED;
            PG8_LDB(B0, 1, 0); PG8_LDB(B1, 1, 1); PG8_SCHED; PG8_LDA(At, 1, 0); PG8_STAGE(PG8_SA(0, 1), a2 + hstep, voffA);
            PG8_WAIT_V(8); PG8_WAIT_L(0); PG8_BAR; PG8_MMA(0, 0, At, B0); PG8_MMA(0, 1, At, B1); PG8_BAR; PG8_SCHED;
            PG8_LDA(At, 1, 1); PG8_STAGE(PG8_SB(1, 0), b3, voffB); PG8_STAGE(PG8_SB(1, 1), b3 + hstep, voffB); PG8_STAGE(PG8_SA(1, 0), a3, voffA);
            PG8_WAIT_V(8); PG8_WAIT_L(0); PG8_BAR; PG8_MMA(1, 0, At, B0); PG8_MMA(1, 1, At, B1); PG8_BAR; PG8_SCHED;
            } else {
            PG8_LDB(B0, 0, 0); PG8_SCHED; PG8_LDA(At, 0, 0); PG8_STAGE(PG8_SA(1, 1), a1 + hstep, voffA);
            PG8_WAIT_L(8); PG8_BAR; PG8_WAIT_L(0); PG8_MMA(0, 0, At, B0); PG8_BAR; PG8_SCHED;
            PG8_LDB(B1, 0, 1); PG8_STAGE(PG8_SB(0, 0), b2, voffB);
            PG8_BAR; PG8_WAIT_L(0); PG8_MMA(0, 1, At, B1); PG8_BAR;
            PG8_LDA(At, 0, 1); PG8_STAGE(PG8_SA(0, 0), a2, voffA);
            PG8_BAR; PG8_WAIT_L(0); PG8_MMA(1, 0, At, B0); PG8_BAR; PG8_SCHED;
            PG8_STAGE(PG8_SB(0, 1), b2 + hstep, voffB);
            PG8_WAIT_V(6); PG8_BAR; PG8_MMA(1, 1, At, B1); PG8_BAR;
            PG8_LDB(B0, 1, 0); PG8_SCHED; PG8_LDA(At, 1, 0); PG8_STAGE(PG8_SA(0, 1), a2 + hstep, voffA);
            PG8_WAIT_L(8); PG8_BAR; PG8_WAIT_L(0); PG8_MMA(0, 0, At, B0); PG8_BAR; PG8_SCHED;
            PG8_LDB(B1, 1, 1); PG8_STAGE(PG8_SB(1, 0), b3, voffB);
            PG8_BAR; PG8_WAIT_L(0); PG8_MMA(0, 1, At, B1); PG8_BAR;
            PG8_LDA(At, 1, 1); PG8_STAGE(PG8_SA(1, 0), a3, voffA);
            PG8_BAR; PG8_WAIT_L(0); PG8_MMA(1, 0, At, B0); PG8_BAR; PG8_SCHED;
            PG8_STAGE(PG8_SB(1, 1), b3 + hstep, voffB);
            PG8_WAIT_V(6); PG8_BAR; PG8_MMA(1, 1, At, B1); PG8_BAR;
            }
        }
        if constexpr (ALIGN_EPI) { if (wr == 0) PG8_BAR; }
        if constexpr (!Epi::AFTER_DRAIN) { E(acc, cur, wr, wc, fr, fq); S.done(cur); }
        if (!has_next) break;
#pragma unroll
        for (int a = 0; a < 2; ++a)
#pragma unroll
            for (int b = 0; b < 2; ++b)
#pragma unroll
                for (int m = 0; m < 4; ++m)
#pragma unroll
                    for (int n = 0; n < 2; ++n) acc[a][b][m][n] = (f32x4){0.f, 0.f, 0.f, 0.f};
        cur = nxt; cA = nA; cB = nB; ++ui;
        if constexpr (ALIGN_EPI) { if (wr == 1) PG8_BAR; }
    }
    PG8_WAIT_V(0);
    if constexpr (!ALIGN_EPI) { if (wr == 0) PG8_BAR; }
    PG8_BAR;
    if constexpr (Epi::AFTER_DRAIN) { E.fused(acc, cur, wr, wc, fr, fq, lds, wid, lane); S.done(cur); }
#undef PG8_SA
#undef PG8_SB
#undef PG8_STAGE
#undef PG8_LDA
#undef PG8_LDB
#undef PG8_MMA
#undef PG8_WAIT_V
#undef PG8_WAIT_L
#undef PG8_BAR
#undef PG8_SCHED
}
}
namespace cg = cooperative_groups;
constexpr int NWAVES = 8, NTHREADS = 512;
constexpr int BATCH = 4, SEQ = 4096, D = 1024, FF = 2816, M = BATCH * SEQ, DEPTH = 2, PLE = 256;
constexpr int DIN = 8504, NGATE = 3072;
constexpr int N_RW = 1824, N_GLA = 1552, N_GDN = 2056, LD_RW = 2048, LD_GLA = 1792, LD_GDN = 2304;
constexpr int C_GLA = 1824, C_GDN = 3376, C_GATE = 5432;
constexpr float LN_EPS = 1e-5f, ALPHA = 1.41421356237f;
constexpr size_t MiB = 1u << 20;
constexpr size_t WS_CTL = 0;
constexpr size_t SZ_W13 = (size_t)5632 * 1024 * 2, SZ_W2 = (size_t)1024 * 2816 * 2, SZ_WRW = (size_t)LD_RW * 1024 * 2, SZ_WGLA = (size_t)LD_GLA * 1024 * 2, SZ_WGDN = (size_t)LD_GDN * 1024 * 2, SZ_WG = (size_t)NGATE * 1024 * 2,
                 SZ_WBR = (size_t)3 * 1024 * 512 * 2, SZ_WO = (size_t)1024 * 1024 * 2, SZ_WPP = (size_t)1024 * 256 * 2;
constexpr size_t WS_W = 1 * MiB;
constexpr size_t WO_W13_0 = 0, WO_W2_0 = WO_W13_0 + SZ_W13, WO_W13_1 = WO_W2_0 + SZ_W2, WO_W2_1 = WO_W13_1 + SZ_W13, WO_WRW = WO_W2_1 + SZ_W2, WO_WGLA = WO_WRW + SZ_WRW, WO_WGDN = WO_WGLA + SZ_WGLA, WO_WG = WO_WGDN + SZ_WGDN,
                 WO_WBR = WO_WG + SZ_WG, WO_WO = WO_WBR + SZ_WBR, WO_WPG = WO_WO + SZ_WO, WO_WPP = WO_WPG + SZ_WO, WO_RW2T = WO_WPP + SZ_WPP, WO_RA2T = WO_RW2T + 512 * 64 * 2, WO_RG2T = WO_RA2T + 512 * 64 * 2, WO_END = WO_RG2T + 512 * 160 * 2;
static_assert(WO_END <= 59 * MiB, "weights region");
constexpr size_t WS_XB = 60 * MiB;
constexpr size_t WS_R = 92 * MiB;
constexpr size_t WS_R_ACC = WS_R + 96 * MiB, WS_R_PP = WS_R + 8 * MiB;
constexpr size_t WS_O = 268 * MiB;
constexpr size_t WS_DBG = 316 * MiB;
constexpr size_t WS_END = 324 * MiB;
constexpr int LDS_BYTES = 147456 + 64;

#define GAS __attribute__((address_space(1)))
#define LAS __attribute__((address_space(3)))
typedef unsigned short bf16;
typedef unsigned v4u __attribute__((ext_vector_type(4)));
typedef float f32x4 __attribute__((ext_vector_type(4)));
#define LDS_WAIT() asm volatile("s_waitcnt lgkmcnt(0)" ::: "memory")
__device__ __forceinline__ unsigned f2bf(float f) { unsigned u = __builtin_bit_cast(unsigned, f); return (u + 0x7fffu + ((u >> 16) & 1u)) >> 16; }
__device__ __forceinline__ unsigned pk2(float lo, float hi) { return f2bf(lo) | (f2bf(hi) << 16); }
__device__ __forceinline__ float b2f(bf16 u) { return __uint_as_float((unsigned)u << 16); }
__device__ __forceinline__ float wave_sum(float v) {
#pragma unroll
    for (int o = 1; o < 64; o <<= 1) v += __shfl_xor(v, o);
    return v;
}
__device__ __forceinline__ float sigmoidf_(float x) { return 1.0f / (1.0f + __expf(-x)); }
__device__ __forceinline__ float softplusf_(float x) { const float e = __expf(-fabsf(x)); const float l = e < 0.01f ? e * (1.f - e * (0.5f - e * 0.33333334f)) : __logf(1.f + e); return fmaxf(x, 0.f) + l; }
__device__ __forceinline__ float tanhf_(float x) { return 1.f - 2.f / (1.f + __expf(2.f * x)); }

struct Args { const float* in[30]; float* out; unsigned char* ws; int ph_lo, ph_hi; };
typedef const __attribute__((address_space(4))) Args* KArgs;

__device__ __forceinline__ void cvt_item(const float* W, int ld, int c0, int ncols, int K, bf16* WT, int kind, LAS float* scr, int item, int nnb, int lane, int kvalid = 1 << 30) {
    const int kb = item / nnb, nb = item % nnb, k0 = 64 * kb, n0 = 32 * nb;
    const int nn = n0 + (lane & 31); const bool ok = nn < ncols;
#pragma unroll 8
    for (int i = 0; i < 32; ++i) { const int kk = 2 * i + (lane >> 5); scr[kk * 33 + (lane & 31)] = (ok && k0 + kk < kvalid) ? W[(size_t)(k0 + kk) * ld + c0 + nn] : 0.f; }
    LDS_WAIT(); asm volatile("" ::: "memory");
    const int c = lane & 7;
    const int drow0 = (kind == 0) ? n0 : (256 * (n0 >> 7) + (n0 & 127) + (kind == 2 ? 128 : 0));
#pragma unroll
    for (int j = 0; j < 4; ++j) { const int n = (lane >> 3) + 8 * j; const LAS float* s = scr + (8 * c) * 33 + n;
        v4u o; o.x = pk2(s[0 * 33], s[1 * 33]); o.y = pk2(s[2 * 33], s[3 * 33]); o.z = pk2(s[4 * 33], s[5 * 33]); o.w = pk2(s[6 * 33], s[7 * 33]);
        if (k0 + 8 * c < kvalid) *(GAS v4u*)(WT + (size_t)(drow0 + n) * K + k0 + 8 * c) = o; }
    LDS_WAIT(); asm volatile("" ::: "memory");
}
__device__ __forceinline__ void convert_weights(KArgs a, int L, LAS unsigned char* lds, int wave, int lane, int gw, int NGW) {
    LAS float* scr = (LAS float*)(lds + wave * 8704);
    unsigned char* wb = a->ws + WS_W;
    constexpr int I_W1 = 16 * 88, I_W2 = 44 * 32, I_RW = 16 * 64, I_GLA = 16 * 56, I_GDN = 16 * 72, I_WG = 16 * 96, I_BR = 8 * 32, I_O = 16 * 32, I_PP = 4 * 32, I_LR = 16, I_LG = 3 * 16;
    constexpr int NIT = 4 * I_W1 + 2 * I_W2 + I_RW + I_GLA + I_GDN + I_WG + 3 * I_BR + 2 * I_O + I_PP + 2 * I_LR + I_LG;
    for (int it = gw; it < NIT; it += NGW) {
        int r = it;
        if (r < 4 * I_W1) { const int q = r / I_W1, s = q >> 1, w3 = q & 1; r -= q * I_W1;
            cvt_item((w3 ? a->in[5] : a->in[4]) + (size_t)(L * 2 + s) * 1024 * 2816, 2816, 0, 2816, 1024, (bf16*)(wb + (s ? WO_W13_1 : WO_W13_0)), 1 + w3, scr, r, 88, lane); continue; }
        r -= 4 * I_W1;
        if (r < 2 * I_W2) { const int s = r / I_W2; r -= s * I_W2;
            cvt_item(a->in[6] + (size_t)(L * 2 + s) * 2816 * 1024, 1024, 0, 1024, 2816, (bf16*)(wb + (s ? WO_W2_1 : WO_W2_0)), 0, scr, r, 32, lane); continue; }
        r -= 2 * I_W2;
        if (r < I_RW) { cvt_item(a->in[7] + (size_t)L * 1024 * DIN, DIN, 0, N_RW, 1024, (bf16*)(wb + WO_WRW), 0, scr, r, 64, lane); continue; }
        r -= I_RW;
        if (r < I_GLA) { cvt_item(a->in[7] + (size_t)L * 1024 * DIN, DIN, C_GLA, N_GLA, 1024, (bf16*)(wb + WO_WGLA), 0, scr, r, 56, lane); continue; }
        r -= I_GLA;
        if (r < I_GDN) { cvt_item(a->in[7] + (size_t)L * 1024 * DIN, DIN, C_GDN, N_GDN, 1024, (bf16*)(wb + WO_WGDN), 0, scr, r, 72, lane); continue; }
        r -= I_GDN;
        if (r < I_WG) { cvt_item(a->in[7] + (size_t)L * 1024 * DIN, DIN, C_GATE, NGATE, 1024, (bf16*)(wb + WO_WG), 0, scr, r, 96, lane); continue; }
        r -= I_WG;
        if (r < 3 * I_BR) { const int b = r / I_BR; r -= b * I_BR;
            cvt_item(a->in[26] + (size_t)(L * 3 + b) * 512 * 1024, 1024, 0, 1024, 512, (bf16*)(wb + WO_WBR) + (size_t)b * 1024 * 512, 0, scr, r, 32, lane); continue; }
        r -= 3 * I_BR;
        if (r < I_O) { cvt_item(a->in[27] + (size_t)L * 1024 * 1024, 1024, 0, 1024, 1024, (bf16*)(wb + WO_WO), 0, scr, r, 32, lane); continue; }
        r -= I_O;
        if (r < I_O) { cvt_item(a->in[28] + (size_t)L * 1024 * 1024, 1024, 0, 1024, 1024, (bf16*)(wb + WO_WPG), 0, scr, r, 32, lane); continue; }
        r -= I_O;
        if (r < I_PP) { cvt_item(a->in[29] + (size_t)L * 256 * 1024, 1024, 0, 1024, 256, (bf16*)(wb + WO_WPP), 0, scr, r, 32, lane); continue; }
        r -= I_PP;
        if (r < I_LR) { cvt_item(a->in[10] + (size_t)L * 64 * 512, 512, 0, 512, 64, (bf16*)(wb + WO_RW2T), 0, scr, r, 16, lane); continue; }
        r -= I_LR;
        if (r < I_LR) { cvt_item(a->in[12] + (size_t)L * 64 * 512, 512, 0, 512, 64, (bf16*)(wb + WO_RA2T), 0, scr, r, 16, lane); continue; }
        r -= I_LR;
        cvt_item(a->in[13] + (size_t)L * 160 * 512, 512, 0, 512, 160, (bf16*)(wb + WO_RG2T), 0, scr, r, 16, lane, 160);
    }
}
template <bool NORM>
__device__ __forceinline__ void row_pass(const float* src, float* dst, bf16* dstb, const float* g, const float* bta, int lane) {
    const GAS f32x4* xr = (const GAS f32x4*)src + lane;
    f32x4 v[4]; float s = 0.f;
#pragma unroll
    for (int j = 0; j < 4; ++j) { v[j] = xr[64 * j]; s += (v[j].x + v[j].y) + (v[j].z + v[j].w); }
    if (NORM) {
        const float mean = wave_sum(s) * (1.f / D); float s2 = 0.f;
#pragma unroll
        for (int j = 0; j < 4; ++j) { v[j] = v[j] - mean; s2 += (v[j].x * v[j].x + v[j].y * v[j].y) + (v[j].z * v[j].z + v[j].w * v[j].w); }
        const float rstd = 1.f / sqrtf(wave_sum(s2) * (1.f / D) + LN_EPS);
#pragma unroll
        for (int j = 0; j < 4; ++j) { const f32x4 gg = ((const GAS f32x4*)g)[lane + 64 * j], bb = ((const GAS f32x4*)bta)[lane + 64 * j]; v[j] = v[j] * rstd * gg + bb; }
    }
    GAS f32x4* o4 = (GAS f32x4*)dst + lane;
    GAS unsigned long long* o8 = (GAS unsigned long long*)dstb + lane;
#pragma unroll
    for (int j = 0; j < 4; ++j) { o4[64 * j] = v[j]; o8[64 * j] = (unsigned long long)pk2(v[j].x, v[j].y) | ((unsigned long long)pk2(v[j].z, v[j].w) << 32); }
}

constexpr int CH = 16;
__device__ __forceinline__ void mix_rwkv(KArgs a, int L, int b, int h, LAS float* sm, int tid, const bf16* hm, bf16* out) {
    constexpr int LDH = LD_RW, C_RW = 0;
    const int lane = tid & 63, wid = tid >> 6;
    LAS float* w2h = sm; LAS float* a2h = sm + 4096; LAS float* g2h = sm + 8192;
    LAS float* tw = sm + 18432; LAS float* al = tw + 1024; LAS float* gl = al + 1024;
    LAS float* sr = gl + 2560; LAS float* skr = sr + 1024; LAS float* sv = skr + 1024; LAS float* sd = sv + 1024; LAS float* sa = sd + 1024; LAS float* sb = sa + 1024;
    LAS float* sk2 = sb + 1024; LAS float* sg = sk2 + 1024; LAS float* sbon = sg + 1024; LAS float* sy = sbon + 1024;
    const float* mu = a->in[8] + L * 1824;
    for (int e = tid; e < 64 * 64; e += NTHREADS) { const int i = e >> 6, j = e & 63; w2h[e] = a->in[10][(size_t)(L * 64 + i) * 512 + h * 64 + j]; a2h[e] = a->in[12][(size_t)(L * 64 + i) * 512 + h * 64 + j]; }
    for (int e = tid; e < 160 * 64; e += NTHREADS) { const int i = e >> 6, j = e & 63; g2h[e] = a->in[13][(size_t)(L * 160 + i) * 512 + h * 64 + j]; }
    const int hj = L * 512 + h * 64 + lane;
    const float w0j = a->in[9][hj], a0j = a->in[11][hj], kkj = a->in[14][hj], kaj = a->in[15][hj], rkj = a->in[16][hj], gngj = a->in[17][hj], gnbj = a->in[18][hj];
    float S[8];
#pragma unroll
    for (int i = 0; i < 8; ++i) S[i] = 0.f;
    const int vrow = tid >> 3, kg = tid & 7;
    __syncthreads();
#pragma unroll 1
    for (int c = 0; c < SEQ / CH; ++c) {
        const int t0 = c * CH;
        for (int e = tid; e < CH * 480; e += NTHREADS) {
            const int tt = e / 480, cc = e % 480, t = t0 + tt;
            int col; if (cc < 64) col = h * 64 + cc; else if (cc < 128) col = 512 + h * 64 + (cc - 64); else if (cc < 192) col = 1024 + h * 64 + (cc - 128); else col = 1536 + (cc - 192);
            const size_t ro = (size_t)(b * SEQ + t) * LDH + C_RW + col;
            const float cur = b2f(hm[ro]), prev = t > 0 ? b2f(hm[ro - LDH]) : 0.f;
            const float xs = cur + (prev - cur) * mu[col];
            if (cc < 64) sr[tt * 64 + cc] = xs; else if (cc < 128) skr[tt * 64 + cc - 64] = xs; else if (cc < 192) sv[tt * 64 + cc - 128] = xs;
            else if (cc < 256) tw[tt * 64 + cc - 192] = tanhf_(xs); else if (cc < 320) al[tt * 64 + cc - 256] = xs; else gl[tt * 160 + cc - 320] = sigmoidf_(xs);
        }
        __syncthreads();
#pragma unroll
        for (int i2 = 0; i2 < 2; ++i2) {
            const int tt = wid + 8 * i2;
            float w = w0j, av = a0j, g = 0.f;
#pragma unroll 4
            for (int i = 0; i < 64; ++i) { w += tw[tt * 64 + i] * w2h[i * 64 + lane]; av += al[tt * 64 + i] * a2h[i * 64 + lane]; }
#pragma unroll 4
            for (int i = 0; i < 160; ++i) g += gl[tt * 160 + i] * g2h[i * 64 + lane];
            const float wl = -softplusf_(-w) - 0.5f, dec = __expf(-__expf(wl)), asig = sigmoidf_(av);
            const float kraw = skr[tt * 64 + lane], kkr = kraw * kkj;
            const float kk = kkr * (1.0f / sqrtf(wave_sum(kkr * kkr) + 1e-6f));
            const float k2 = kraw * (1.f + (asig - 1.f) * kaj);
            const float rk = wave_sum(sr[tt * 64 + lane] * k2 * rkj);
            sd[tt * 64 + lane] = dec; sa[tt * 64 + lane] = -kk; sb[tt * 64 + lane] = kk * asig; sk2[tt * 64 + lane] = k2; sg[tt * 64 + lane] = g; sbon[tt * 64 + lane] = rk * sv[tt * 64 + lane];
        }
        __syncthreads();
#pragma unroll 1
        for (int tt = 0; tt < CH; ++tt) {
            const int o = tt * 64 + kg * 8;
            float x = 0.f;
#pragma unroll
            for (int i = 0; i < 8; ++i) x += S[i] * sa[o + i];
            x += __shfl_xor(x, 1); x += __shfl_xor(x, 2); x += __shfl_xor(x, 4);
            const float vv = sv[tt * 64 + vrow];
            float y = 0.f;
#pragma unroll
            for (int i = 0; i < 8; ++i) { S[i] = S[i] * sd[o + i] + x * sb[o + i] + vv * sk2[o + i]; y += S[i] * sr[o + i]; }
            y += __shfl_xor(y, 1); y += __shfl_xor(y, 2); y += __shfl_xor(y, 4);
            if (kg == 0) sy[tt * 64 + vrow] = y;
        }
        __syncthreads();
#pragma unroll
        for (int i2 = 0; i2 < 2; ++i2) {
            const int tt = wid + 8 * i2;
            const float y = sy[tt * 64 + lane], mean = wave_sum(y) * (1.f / 64.f), dv = y - mean, var = wave_sum(dv * dv) * (1.f / 64.f);
            const float yn = dv * (1.0f / sqrtf(var + 64e-5f)) * gngj + gnbj;
            const float o = (yn + sbon[tt * 64 + lane]) * sg[tt * 64 + lane];
            out[(size_t)(b * SEQ + t0 + tt) * 512 + h * 64 + lane] = (bf16)f2bf(o);
        }
        __syncthreads();
    }
}
__device__ __forceinline__ void mix_gla(KArgs a, int L, int b, int h, LAS float* sm, int tid, const bf16* hm, bf16* out) {
    constexpr int LDH = LD_GLA, C_GLA = 0;
    const int lane = tid & 63, wid = tid >> 6;
    LAS float* gkw = sm; LAS float* sq = sm + 1024; LAS float* sk = sq + 1024; LAS float* sdec = sk + 1024; LAS float* sv = sdec + 1024; LAS float* sgt = sv + 2048; LAS float* so = sgt + 2048; LAS float* gkl = so + 2048;
    for (int e = tid; e < 16 * 64; e += NTHREADS) { const int i = e >> 6, j = e & 63; gkw[e] = a->in[19][(size_t)(L * 16 + i) * 256 + h * 64 + j]; }
    const float gkbj = a->in[20][L * 256 + h * 64 + lane];
    const float ng0 = a->in[21][L * 128 + lane], ng1 = a->in[21][L * 128 + 64 + lane];
    float S[16];
#pragma unroll
    for (int i = 0; i < 16; ++i) S[i] = 0.f;
    const int vc = tid >> 2, kg = tid & 3;
    __syncthreads();
#pragma unroll 1
    for (int c = 0; c < SEQ / CH; ++c) {
        const int t0 = c * CH;
        for (int e = tid; e < CH * 400; e += NTHREADS) {
            const int tt = e / 400, cc = e % 400;
            int col; if (cc < 64) col = h * 64 + cc; else if (cc < 128) col = 256 + h * 64 + (cc - 64); else if (cc < 256) col = 512 + h * 128 + (cc - 128); else if (cc < 272) col = 1024 + (cc - 256); else col = 1040 + h * 128 + (cc - 272);
            const float x = b2f(hm[(size_t)(b * SEQ + t0 + tt) * LDH + C_GLA + col]);
            if (cc < 64) sq[tt * 64 + cc] = x; else if (cc < 128) sk[tt * 64 + cc - 64] = x; else if (cc < 256) sv[tt * 128 + cc - 128] = x; else if (cc < 272) gkl[tt * 16 + cc - 256] = x; else sgt[tt * 128 + cc - 272] = x;
        }
        __syncthreads();
#pragma unroll
        for (int i2 = 0; i2 < 2; ++i2) {
            const int tt = wid + 8 * i2;
            float z = gkbj;
#pragma unroll
            for (int i = 0; i < 16; ++i) z += gkl[tt * 16 + i] * gkw[i * 64 + lane];
            sdec[tt * 64 + lane] = __expf(-softplusf_(-z) * (1.f / 16.f));
        }
        __syncthreads();
#pragma unroll 1
        for (int tt = 0; tt < CH; ++tt) {
            const int o = tt * 64 + kg * 16; const float vv = sv[tt * 128 + vc];
            float y = 0.f;
#pragma unroll
            for (int i = 0; i < 16; ++i) { S[i] = S[i] * sdec[o + i] + sk[o + i] * vv; y += S[i] * sq[o + i]; }
            y += __shfl_xor(y, 1); y += __shfl_xor(y, 2);
            if (kg == 0) so[tt * 128 + vc] = y * 0.125f;
        }
        __syncthreads();
#pragma unroll
        for (int i2 = 0; i2 < 2; ++i2) {
            const int tt = wid + 8 * i2;
            const float o0 = so[tt * 128 + lane], o1 = so[tt * 128 + 64 + lane];
            const float rs = 1.0f / sqrtf(wave_sum(o0 * o0 + o1 * o1) * (1.f / 128.f) + 1e-6f);
            const float g0 = sgt[tt * 128 + lane], g1 = sgt[tt * 128 + 64 + lane];
            bf16* op = out + (size_t)(b * SEQ + t0 + tt) * 512 + h * 128;
            op[lane] = (bf16)f2bf(o0 * rs * ng0 * g0 * sigmoidf_(g0)); op[64 + lane] = (bf16)f2bf(o1 * rs * ng1 * g1 * sigmoidf_(g1));
        }
        __syncthreads();
    }
}
__device__ __forceinline__ void mix_gdn(KArgs a, int L, int b, int h, LAS float* sm, int tid, const bf16* hm, bf16* out) {
    constexpr int LDH = LD_GDN, C_GDN = 0;
    const int lane = tid & 63, wid = tid >> 6;
    LAS float* raw = sm;
    LAS float* sq = sm + 7296; LAS float* sk = sq + 2048; LAS float* sv = sk + 2048; LAS float* sgt = sv + 2048; LAS float* so = sgt + 2048; LAS float* sal = so + 2048; LAS float* sbe = sal + 16;
    const float* cw = a->in[22] + (size_t)L * 4 * 1536;
    const float Ah = __expf(a->in[23][L * 4 + h]), dtb = a->in[24][L * 4 + h];
    const float ng0 = a->in[25][L * 128 + lane], ng1 = a->in[25][L * 128 + 64 + lane];
    float S[32];
#pragma unroll
    for (int i = 0; i < 32; ++i) S[i] = 0.f;
    const int vc = tid >> 2, kg = tid & 3;
#pragma unroll 1
    for (int c = 0; c < SEQ / CH; ++c) {
        const int t0 = c * CH;
        for (int e = tid; e < 19 * 384; e += NTHREADS) {
            const int rr = e / 384, cc = e % 384, t = t0 - 3 + rr;
            const int col = (cc < 128) ? (h * 128 + cc) : (cc < 256 ? 512 + h * 128 + (cc - 128) : 1024 + h * 128 + (cc - 256));
            raw[e] = t >= 0 ? b2f(hm[(size_t)(b * SEQ + t) * LDH + C_GDN + col]) : 0.f;
        }
        for (int e = tid; e < CH * 128; e += NTHREADS) { const int tt = e >> 7, cc = e & 127; sgt[e] = b2f(hm[(size_t)(b * SEQ + t0 + tt) * LDH + C_GDN + 1544 + h * 128 + cc]); }
        if (tid < CH) {
            const size_t ro = (size_t)(b * SEQ + t0 + tid) * LDH + C_GDN;
            const float ai = b2f(hm[ro + 1536 + h]), bi = b2f(hm[ro + 1540 + h]);
            sal[tid] = __expf(-Ah * softplusf_(ai + dtb)); sbe[tid] = sigmoidf_(bi);
        }
        __syncthreads();
        for (int e = tid; e < CH * 384; e += NTHREADS) {
            const int tt = e / 384, cc = e % 384;
            const int ch = (cc < 128) ? (h * 128 + cc) : (cc < 256 ? 512 + h * 128 + (cc - 128) : 1024 + h * 128 + (cc - 256));
            float s = 0.f;
#pragma unroll
            for (int i = 0; i < 4; ++i) s += cw[i * 1536 + ch] * raw[(tt + i) * 384 + cc];
            s = s * sigmoidf_(s);
            if (cc < 128) sq[tt * 128 + cc] = s; else if (cc < 256) sk[tt * 128 + cc - 128] = s; else sv[tt * 128 + cc - 256] = s;
        }
        __syncthreads();
#pragma unroll
        for (int i2 = 0; i2 < 2; ++i2) {
            const int tt = wid + 8 * i2;
            const float q0 = sq[tt * 128 + lane], q1 = sq[tt * 128 + 64 + lane], k0 = sk[tt * 128 + lane], k1 = sk[tt * 128 + 64 + lane];
            const float rq = (1.0f / sqrtf(wave_sum(q0 * q0 + q1 * q1) + 1e-6f)) * 0.08838834764831845f, rk = 1.0f / sqrtf(wave_sum(k0 * k0 + k1 * k1) + 1e-6f);
            sq[tt * 128 + lane] = q0 * rq; sq[tt * 128 + 64 + lane] = q1 * rq; sk[tt * 128 + lane] = k0 * rk; sk[tt * 128 + 64 + lane] = k1 * rk;
        }
        __syncthreads();
#pragma unroll 1
        for (int tt = 0; tt < CH; ++tt) {
            const int o = tt * 128 + kg * 32; const float al = sal[tt], be = sbe[tt];
            float p = 0.f;
#pragma unroll
            for (int i = 0; i < 32; ++i) { S[i] *= al; p += S[i] * sk[o + i]; }
            p += __shfl_xor(p, 1); p += __shfl_xor(p, 2);
            const float vn = be * (sv[tt * 128 + vc] - p);
            float y = 0.f;
#pragma unroll
            for (int i = 0; i < 32; ++i) { S[i] += sk[o + i] * vn; y += S[i] * sq[o + i]; }
            y += __shfl_xor(y, 1); y += __shfl_xor(y, 2);
            if (kg == 0) so[tt * 128 + vc] = y;
        }
        __syncthreads();
#pragma unroll
        for (int i2 = 0; i2 < 2; ++i2) {
            const int tt = wid + 8 * i2;
            const float o0 = so[tt * 128 + lane], o1 = so[tt * 128 + 64 + lane];
            const float rs = 1.0f / sqrtf(wave_sum(o0 * o0 + o1 * o1) * (1.f / 128.f) + 1e-6f);
            const float g0 = sgt[tt * 128 + lane], g1 = sgt[tt * 128 + 64 + lane];
            bf16* op = out + (size_t)(b * SEQ + t0 + tt) * 512 + h * 128;
            op[lane] = (bf16)f2bf(o0 * rs * ng0 * g0 * sigmoidf_(g0)); op[64 + lane] = (bf16)f2bf(o1 * rs * ng1 * g1 * sigmoidf_(g1));
        }
        __syncthreads();
    }
}

typedef short bf16x8 __attribute__((ext_vector_type(8)));
typedef unsigned u32x2 __attribute__((ext_vector_type(2)));
__device__ __forceinline__ f32x4 mfma16(bf16x8 a, bf16x8 b, f32x4 c) { return __builtin_amdgcn_mfma_f32_16x16x32_bf16(a, b, c, 0, 0, 0); }
template <int K> __device__ __forceinline__ f32x4 mm16(f32x4 acc, const LAS bf16* Ap, int pa, const LAS bf16* Bp, int pb, int lane) {
    const LAS bf16* a = Ap + (lane & 15) * pa + 8 * (lane >> 4); const LAS bf16* b = Bp + (lane & 15) * pb + 8 * (lane >> 4);
#pragma unroll
    for (int kk = 0; kk < K; kk += 32) acc = mfma16(*(const LAS bf16x8*)(a + kk), *(const LAS bf16x8*)(b + kk), acc);
    return acc;
}
__device__ __forceinline__ u32x2 pack4(f32x4 v) { u32x2 w; w.x = pk2(v[0], v[1]); w.y = pk2(v[2], v[3]); return w; }
__device__ __forceinline__ f32x4 unpack4(u32x2 w) { f32x4 v; v[0] = __uint_as_float(w.x << 16); v[1] = __uint_as_float(w.x & 0xffff0000u); v[2] = __uint_as_float(w.y << 16); v[3] = __uint_as_float(w.y & 0xffff0000u); return v; }
__device__ __forceinline__ void storeT(LAS bf16* Out, int po, int m0, int n0, f32x4 acc, int lane) { *(LAS u32x2*)(Out + (n0 + (lane & 15)) * po + m0 + 4 * (lane >> 4)) = pack4(acc); }
__device__ __forceinline__ void storeR(LAS bf16* Out, int po, int m0, int n0, f32x4 acc, int lane) {
#pragma unroll
    for (int r = 0; r < 4; ++r) Out[(m0 + 4 * (lane >> 4) + r) * po + n0 + (lane & 15)] = (bf16)f2bf(acc[r]);
}
__device__ __forceinline__ int kperm(int d) { return (d & ~31) | (((d >> 2) & 3) << 3) | (((d >> 4) & 1) << 2) | (d & 3); }
__device__ __forceinline__ bf16x8 frag_of(f32x4 lo, f32x4 hi) {
    u32x2 a = pack4(lo), b = pack4(hi); v4u w; w.x = a.x; w.y = a.y; w.z = b.x; w.w = b.y; return __builtin_bit_cast(bf16x8, w);
}

constexpr size_t GLA_QP = 56 * MiB, GLA_NN = 64 * MiB, GLA_E = 80 * MiB, GLA_DEC = 96 * MiB;
constexpr int P64 = 72;
__device__ __forceinline__ void m1_gla(KArgs a, int L, int item, LAS unsigned char* lds, int tid) {
    const int lane = tid & 63, wave = tid >> 6, h = item & 3, tok0 = (item >> 2) * 64;
    unsigned char* R = a->ws + WS_R;
    const bf16* hg = (const bf16*)R; bf16* QP = (bf16*)(R + GLA_QP) + (size_t)item * 4096; bf16* NN = (bf16*)(R + GLA_NN) + (size_t)item * 8192;
    bf16* E = (bf16*)(R + GLA_E); float* DEC = (float*)(R + GLA_DEC) + item * 64; bf16* Y = (bf16*)(a->ws + WS_O) + (size_t)M * 512;
    LAS float* LA = (LAS float*)lds;
    LAS bf16* QS = (LAS bf16*)(lds + 16384); LAS bf16* KS = QS + 64 * P64; LAS bf16* KHT = KS + 64 * P64; LAS bf16* VT = KHT + 64 * P64; LAS bf16* ATT = VT + 128 * P64;
    LAS float* GKL = (LAS float*)(lds + 16384 + (64 * 4 + 128) * P64 * 2);
    for (int e = tid; e < 1024; e += NTHREADS) GKL[e] = b2f(hg[(size_t)(tok0 + (e >> 4)) * LD_GLA + 1024 + (e & 15)]);
    __syncthreads();
    {
        const int t = tid >> 3, d0 = (tid & 7) * 8; float z[8];
#pragma unroll
        for (int j = 0; j < 8; ++j) z[j] = a->in[20][L * 256 + h * 64 + d0 + j];
        for (int i = 0; i < 16; ++i) { const float g = GKL[t * 16 + i]; const float* w = a->in[19] + (size_t)(L * 16 + i) * 256 + h * 64 + d0;
#pragma unroll
            for (int j = 0; j < 8; ++j) z[j] += g * w[j]; }
#pragma unroll
        for (int j = 0; j < 8; ++j) LA[t * 64 + d0 + j] = -softplusf_(-z[j]) * (1.f / 16.f);
    }
    __syncthreads();
    if (tid < 64) { float run = 0.f; for (int t = 0; t < 64; ++t) { run += LA[t * 64 + tid]; LA[t * 64 + tid] = run; } }
    __syncthreads();
    for (int e = tid; e < 4096; e += NTHREADS) {
        const int t = e >> 6, d = e & 63; const float bb = LA[e], be = LA[63 * 64 + d];
        const size_t ro = (size_t)(tok0 + t) * LD_GLA + h * 64 + d;
        const float q = b2f(hg[ro]) * 0.125f * __expf(bb), k = b2f(hg[ro + 256]);
        const bf16 qb = (bf16)f2bf(q);
        QS[t * P64 + d] = qb; QP[t * 64 + kperm(d)] = qb;
        KS[t * P64 + d] = (bf16)f2bf(k * __expf(-bb)); KHT[d * P64 + t] = (bf16)f2bf(k * __expf(be - bb));
        if (t == 63) DEC[d] = __expf(be);
    }
    for (int e = tid; e < 8192; e += NTHREADS) {
        const int t = e >> 7, j = e & 127; const size_t ro = (size_t)(tok0 + t) * LD_GLA + h * 128 + j;
        VT[j * P64 + t] = hg[ro + 512];
        const float gt = b2f(hg[ro + 1040]);
        E[(size_t)(tok0 + t) * 512 + h * 128 + j] = (bf16)f2bf(a->in[21][L * 128 + j] * gt * sigmoidf_(gt));
    }
    __syncthreads();
#pragma unroll
    for (int i = 0; i < 2; ++i) {
        const int idx = wave * 2 + i, T = idx >> 2, S = idx & 3;
        f32x4 acc = {0.f, 0.f, 0.f, 0.f};
        if (S <= T) acc = mm16<64>(acc, QS + 16 * T * P64, P64, KS + 16 * S * P64, P64, lane);
#pragma unroll
        for (int r = 0; r < 4; ++r) if (16 * S + (lane & 15) > 16 * T + 4 * (lane >> 4) + r) acc[r] = 0.f;
        storeR(ATT, P64, 16 * T, 16 * S, acc, lane);
    }
    __syncthreads();
#pragma unroll
    for (int i = 0; i < 4; ++i) {
        const int idx = wave * 4 + i, Jt = idx >> 2, T = idx & 3;
        f32x4 acc = {0.f, 0.f, 0.f, 0.f};
        acc = mm16<64>(acc, VT + 16 * Jt * P64, P64, ATT + 16 * T * P64, P64, lane);
        *(u32x2*)(Y + (size_t)(tok0 + 16 * T + (lane & 15)) * 512 + h * 128 + 16 * Jt + 4 * (lane >> 4)) = pack4(acc);
    }
#pragma unroll
    for (int i = 0; i < 4; ++i) {
        const int idx = wave * 4 + i, J = idx >> 2, I = idx & 3;
        f32x4 acc = {0.f, 0.f, 0.f, 0.f};
        acc = mm16<64>(acc, KHT + 16 * I * P64, P64, VT + 16 * J * P64, P64, lane);
        *(u32x2*)(NN + (size_t)((J * 4 + I) * 64 + lane) * 4) = pack4(acc);
    }
    __syncthreads();
}
__device__ __forceinline__ void m2_gla(KArgs a, int b, int h, int tid) {
    const int lane = tid & 63, J = tid >> 6, g = lane >> 4, n = lane & 15;
    unsigned char* R = a->ws + WS_R;
    const bf16* QPb = (const bf16*)(R + GLA_QP); const bf16* NNb = (const bf16*)(R + GLA_NN); const float* DECb = (const float*)(R + GLA_DEC); bf16* Y = (bf16*)(a->ws + WS_O) + (size_t)M * 512;
    f32x4 H[4];
#pragma unroll
    for (int I = 0; I < 4; ++I) H[I] = (f32x4){0.f, 0.f, 0.f, 0.f};
    bf16x8 bq[4][2], bqn[4][2]; u32x2 yi[4], yin[4], nn[4], nnn[4]; f32x4 dc[4], dcn[4];
#define GLA_LOAD(c, BQ, YI, NNv, DC) do { const int item_ = ((b * 64 + (c)) * 4 + h); const bf16* qp_ = QPb + (size_t)item_ * 4096; \
        _Pragma("unroll") for (int T = 0; T < 4; ++T) { _Pragma("unroll") for (int s = 0; s < 2; ++s) BQ[T][s] = *(const bf16x8*)(qp_ + (16 * T + n) * 64 + 32 * s + 8 * g); \
            YI[T] = *(const u32x2*)(Y + (size_t)((b * 64 + (c)) * 64 + 16 * T + n) * 512 + h * 128 + 16 * J + 4 * g); } \
        _Pragma("unroll") for (int I = 0; I < 4; ++I) { NNv[I] = *(const u32x2*)(NNb + (size_t)item_ * 8192 + (size_t)((J * 4 + I) * 64 + lane) * 4); DC[I] = *(const f32x4*)(DECb + item_ * 64 + 16 * I + 4 * g); } } while (0)
    GLA_LOAD(0, bq, yi, nn, dc);
#pragma unroll 1
    for (int c = 0; c < 64; ++c) {
        if (c + 1 < 64) GLA_LOAD(c + 1, bqn, yin, nnn, dcn);
        const bf16x8 a0 = frag_of(H[0], H[1]), a1 = frag_of(H[2], H[3]);
#pragma unroll
        for (int T = 0; T < 4; ++T) {
            f32x4 acc = unpack4(yi[T]);
            acc = mfma16(a0, bq[T][0], acc); acc = mfma16(a1, bq[T][1], acc);
            *(u32x2*)(Y + (size_t)((b * 64 + c) * 64 + 16 * T + n) * 512 + h * 128 + 16 * J + 4 * g) = pack4(acc);
        }
#pragma unroll
        for (int I = 0; I < 4; ++I) H[I] = H[I] * dc[I] + unpack4(nn[I]);
#pragma unroll
        for (int T = 0; T < 4; ++T) { bq[T][0] = bqn[T][0]; bq[T][1] = bqn[T][1]; yi[T] = yin[T]; nn[T] = nnn[T]; dc[T] = dcn[T]; }
    }
#undef GLA_LOAD
}
__device__ __forceinline__ void m3_rms(bf16* Y, const bf16* E, int gw, int NGW, int lane) {
    for (int m = gw; m < M; m += NGW) {
        const v4u yw = *(const v4u*)(Y + (size_t)m * 512 + lane * 8), ew = *(const v4u*)(E + (size_t)m * 512 + lane * 8);
        float y[8], e[8];
        y[0] = __uint_as_float(yw.x << 16); y[1] = __uint_as_float(yw.x & 0xffff0000u); y[2] = __uint_as_float(yw.y << 16); y[3] = __uint_as_float(yw.y & 0xffff0000u);
        y[4] = __uint_as_float(yw.z << 16); y[5] = __uint_as_float(yw.z & 0xffff0000u); y[6] = __uint_as_float(yw.w << 16); y[7] = __uint_as_float(yw.w & 0xffff0000u);
        e[0] = __uint_as_float(ew.x << 16); e[1] = __uint_as_float(ew.x & 0xffff0000u); e[2] = __uint_as_float(ew.y << 16); e[3] = __uint_as_float(ew.y & 0xffff0000u);
        e[4] = __uint_as_float(ew.z << 16); e[5] = __uint_as_float(ew.z & 0xffff0000u); e[6] = __uint_as_float(ew.w << 16); e[7] = __uint_as_float(ew.w & 0xffff0000u);
        float ss = 0.f;
#pragma unroll
        for (int i = 0; i < 8; ++i) ss += y[i] * y[i];
        ss += __shfl_xor(ss, 1); ss += __shfl_xor(ss, 2); ss += __shfl_xor(ss, 4); ss += __shfl_xor(ss, 8);
        const float rs = 1.0f / sqrtf(ss * (1.f / 128.f) + 1e-6f);
        v4u o; o.x = pk2(y[0] * rs * e[0], y[1] * rs * e[1]); o.y = pk2(y[2] * rs * e[2], y[3] * rs * e[3]); o.z = pk2(y[4] * rs * e[4], y[5] * rs * e[5]); o.w = pk2(y[6] * rs * e[6], y[7] * rs * e[7]);
        *(v4u*)(Y + (size_t)m * 512 + lane * 8) = o;
    }
}
constexpr size_t GDN_QP = 72 * MiB, GDN_MM = 88 * MiB, GDN_NN = 120 * MiB, GDN_E = 152 * MiB;
constexpr int P128 = 136;
__device__ __forceinline__ void m1_gdn(KArgs a, int L, int item, LAS unsigned char* lds, int tid) {
    const int lane = tid & 63, wave = tid >> 6, g = lane >> 4, n = lane & 15, h = item & 3, bc = item >> 2, c = bc & 63, tok0 = bc * 64;
    unsigned char* R = a->ws + WS_R;
    const bf16* hg = (const bf16*)R; bf16* QPg = (bf16*)(R + GDN_QP) + (size_t)item * 8192; bf16* MMg = (bf16*)(R + GDN_MM) + (size_t)item * 16384; bf16* NNg = (bf16*)(R + GDN_NN) + (size_t)item * 16384;
    bf16* E = (bf16*)(R + GDN_E); bf16* Y = (bf16*)(a->ws + WS_O) + (size_t)2 * M * 512;
    LAS bf16* KN = (LAS bf16*)lds; LAS bf16* QN = (LAS bf16*)(lds + 17408); LAS bf16* KNT = (LAS bf16*)(lds + 34816); LAS bf16* VT = (LAS bf16*)(lds + 53248); LAS bf16* KHT = (LAS bf16*)(lds + 71680);
    LAS bf16* S = (LAS bf16*)(lds + 90112); LAS bf16* ST = (LAS bf16*)(lds + 99328); LAS bf16* ATT = (LAS bf16*)(lds + 108544); LAS bf16* S2 = (LAS bf16*)(lds + 117760); LAS bf16* S2T = (LAS bf16*)(lds + 126976);
    LAS bf16* P = (LAS bf16*)(lds + 136192); LAS float* GC = (LAS float*)(lds + 145408); LAS float* BETA = GC + 64;
    LAS bf16* RAW = S;
    LAS bf16* WT = KN; LAS bf16* UT = S2;
    for (int ch = tid; ch < 67 * 48; ch += NTHREADS) {
        const int rr = ch / 48, cc = (ch % 48) * 8;
        const int sc = cc < 128 ? h * 128 + cc : (cc < 256 ? 512 + h * 128 + (cc - 128) : 1024 + h * 128 + (cc - 256));
        v4u val = {0u, 0u, 0u, 0u};
        if (c * 64 - 3 + rr >= 0) val = *(const v4u*)(hg + (size_t)(tok0 - 3 + rr) * LD_GDN + sc);
        *(LAS v4u*)(RAW + rr * 384 + cc) = val;
    }
    if (tid < 64) {
        const size_t ro = (size_t)(tok0 + tid) * LD_GDN;
        const float ai = b2f(hg[ro + 1536 + h]), bi = b2f(hg[ro + 1540 + h]);
        float v = -__expf(a->in[23][L * 4 + h]) * softplusf_(ai + a->in[24][L * 4 + h]);
#pragma unroll
        for (int off = 1; off < 64; off <<= 1) { const float u = __shfl_up(v, off); if (lane >= off) v += u; }
        GC[tid] = v; BETA[tid] = sigmoidf_(bi);
    }
    __syncthreads();
    {
        const float gend = GC[63]; const float* cw = a->in[22] + (size_t)L * 4 * 1536;
        float cwq[2][4], cwk[2][4], cwv[2][4];
#pragma unroll
        for (int u = 0; u < 2; ++u)
#pragma unroll
            for (int i = 0; i < 4; ++i) { const int d = lane + 64 * u; cwq[u][i] = cw[i * 1536 + h * 128 + d]; cwk[u][i] = cw[i * 1536 + 512 + h * 128 + d]; cwv[u][i] = cw[i * 1536 + 1024 + h * 128 + d]; }
        const float ng0 = a->in[25][L * 128 + lane], ng1 = a->in[25][L * 128 + 64 + lane];
#pragma unroll 1
        for (int tt = 0; tt < 8; ++tt) {
            const int t = wave * 8 + tt; const float gct = GC[t];
            float q[2], k[2], v[2];
#pragma unroll
            for (int u = 0; u < 2; ++u) { const int d = lane + 64 * u; float sq = 0.f, sk = 0.f, sv = 0.f;
#pragma unroll
                for (int i = 0; i < 4; ++i) { const LAS bf16* rp = RAW + (t + i) * 384 + d; sq += cwq[u][i] * b2f(rp[0]); sk += cwk[u][i] * b2f(rp[128]); sv += cwv[u][i] * b2f(rp[256]); }
                q[u] = sq * sigmoidf_(sq); k[u] = sk * sigmoidf_(sk); v[u] = sv * sigmoidf_(sv); }
            const float rq = (1.0f / sqrtf(wave_sum(q[0] * q[0] + q[1] * q[1]) + 1e-6f)) * 0.08838834764831845f, rk = 1.0f / sqrtf(wave_sum(k[0] * k[0] + k[1] * k[1]) + 1e-6f);
            const float eg = __expf(gct), eh = __expf(gend - gct);
#pragma unroll
            for (int u = 0; u < 2; ++u) { const int d = lane + 64 * u; const float kn = k[u] * rk, qn = q[u] * rq; const bf16 kb = (bf16)f2bf(kn);
                KN[t * P128 + d] = kb; KNT[d * P64 + t] = kb; QN[t * P128 + d] = (bf16)f2bf(qn); KHT[d * P64 + t] = (bf16)f2bf(kn * eh); VT[d * P64 + t] = (bf16)f2bf(v[u]);
                QPg[t * 128 + kperm(d)] = (bf16)f2bf(qn * eg);
                const float gt = b2f(hg[(size_t)(tok0 + t) * LD_GDN + 1544 + h * 128 + d]);
                E[(size_t)(tok0 + t) * 512 + h * 128 + d] = (bf16)f2bf((u ? ng1 : ng0) * gt * sigmoidf_(gt)); }
        }
    }
    __syncthreads();
#pragma unroll
    for (int i = 0; i < 4; ++i) {
        const int idx = wave * 4 + i, kind = idx >> 4, T = (idx >> 2) & 3, Sx = idx & 3;
        f32x4 acc = {0.f, 0.f, 0.f, 0.f};
        if (Sx <= T) acc = mm16<128>(acc, (kind ? QN : KN) + 16 * T * P128, P128, KN + 16 * Sx * P128, P128, lane);
        const int s = 16 * Sx + n; const float gs = GC[s];
#pragma unroll
        for (int r = 0; r < 4; ++r) { const int t = 16 * T + 4 * g + r; const float dec = __expf(fminf(GC[t] - gs, 0.f));
            acc[r] = kind ? (s <= t ? acc[r] * dec : 0.f) : (s < t ? -BETA[t] * acc[r] * dec : 0.f); }
        if (kind) storeR(ATT, P64, 16 * T, 16 * Sx, acc, lane);
        else { storeR(S, P64, 16 * T, 16 * Sx, acc, lane); storeT(ST, P64, 16 * T, 16 * Sx, acc, lane); }
    }
    __syncthreads();
    for (int e = tid; e < 4096; e += NTHREADS) { const int t = e >> 6, s = e & 63; P[t * P64 + s] = (bf16)f2bf((t == s ? 1.f : 0.f) + b2f(S[t * P64 + s])); }
    __syncthreads();
    {
        LAS bf16* cur = S; LAS bf16* curT = ST; LAS bf16* nxt = S2; LAS bf16* nxtT = S2T;
#pragma unroll 1
        for (int k = 0; k < 5; ++k) {
#pragma unroll
            for (int i = 0; i < 2; ++i) { const int idx = wave * 2 + i, T = idx >> 2, Sx = idx & 3; f32x4 acc = {0.f, 0.f, 0.f, 0.f};
                acc = mm16<64>(acc, cur + 16 * T * P64, P64, curT + 16 * Sx * P64, P64, lane);
                storeR(nxt, P64, 16 * T, 16 * Sx, acc, lane); storeT(nxtT, P64, 16 * T, 16 * Sx, acc, lane); }
            __syncthreads();
            f32x4 pacc[2];
#pragma unroll
            for (int i = 0; i < 2; ++i) { const int idx = wave * 2 + i, T = idx >> 2, Sx = idx & 3;
#pragma unroll
                for (int r = 0; r < 4; ++r) pacc[i][r] = b2f(P[(16 * T + 4 * g + r) * P64 + 16 * Sx + n]);
                pacc[i] = mm16<64>(pacc[i], P + 16 * T * P64, P64, nxtT + 16 * Sx * P64, P64, lane); }
            __syncthreads();
#pragma unroll
            for (int i = 0; i < 2; ++i) { const int idx = wave * 2 + i, T = idx >> 2, Sx = idx & 3; storeR(P, P64, 16 * T, 16 * Sx, pacc[i], lane); }
            __syncthreads();
            LAS bf16* t0 = cur; cur = nxt; nxt = t0; LAS bf16* t1 = curT; curT = nxtT; nxtT = t1;
        }
    }
    for (int e = tid; e < 4096; e += NTHREADS) { const int t = e >> 6, s = e & 63; const float p = b2f(P[t * P64 + s]) * BETA[s]; S[t * P64 + s] = (bf16)f2bf(p * __expf(GC[s])); ST[t * P64 + s] = (bf16)f2bf(p); }
    __syncthreads();
#pragma unroll
    for (int i = 0; i < 8; ++i) {
        const int idx = wave * 8 + i, kind = idx >> 5, T = (idx >> 3) & 3, Dt = idx & 7;
        f32x4 acc = {0.f, 0.f, 0.f, 0.f};
        acc = mm16<64>(acc, (kind ? ST : S) + 16 * T * P64, P64, (kind ? VT : KNT) + 16 * Dt * P64, P64, lane);
        storeT(kind ? UT : WT, P64, 16 * T, 16 * Dt, acc, lane);
    }
    __syncthreads();
    const float egend = __expf(GC[63]);
#pragma unroll
    for (int i = 0; i < 8; ++i) {
        const int idx = wave * 8 + i, kind = idx >> 5, Dt = (idx >> 2) & 7, T = idx & 3;
        f32x4 acc = {0.f, 0.f, 0.f, 0.f};
        acc = mm16<64>(acc, (kind ? UT : WT) + 16 * Dt * P64, P64, ATT + 16 * T * P64, P64, lane);
        const int t = 16 * T + n;
        if (kind) *(u32x2*)(Y + (size_t)(tok0 + t) * 512 + h * 128 + 16 * Dt + 4 * g) = pack4(acc);
        else { bf16* qp = QPg + t * 128 + (Dt >> 1) * 32 + 8 * g + 4 * (Dt & 1); const f32x4 q0 = unpack4(*(const u32x2*)qp); *(u32x2*)qp = pack4(q0 - acc); }
    }
#pragma unroll
    for (int i = 0; i < 16; ++i) {
        const int idx = wave * 16 + i, kind = idx >> 6, A8 = (idx >> 3) & 7, B8 = idx & 7;
        f32x4 acc = {0.f, 0.f, 0.f, 0.f};
        if (kind == 0) {
            acc = mm16<64>(acc, WT + 16 * A8 * P64, P64, KHT + 16 * B8 * P64, P64, lane);
            const int ip = 16 * B8 + n;
#pragma unroll
            for (int r = 0; r < 4; ++r) acc[r] = ((16 * A8 + 4 * g + r) == ip ? egend : 0.f) - acc[r];
            *(u32x2*)(MMg + ip * 128 + (A8 >> 1) * 32 + 8 * g + 4 * (A8 & 1)) = pack4(acc);
        } else {
            acc = mm16<64>(acc, KHT + 16 * A8 * P64, P64, UT + 16 * B8 * P64, P64, lane);
            *(u32x2*)(NNg + (size_t)((B8 * 8 + A8) * 64 + lane) * 4) = pack4(acc);
        }
    }
    __syncthreads();
}
__device__ __forceinline__ void m2_gdn(KArgs a, int b, int h, LAS unsigned char* lds, int tid) {
    const int lane = tid & 63, J = tid >> 6, g = lane >> 4, n = lane & 15;
    unsigned char* R = a->ws + WS_R;
    const bf16* QPb = (const bf16*)(R + GDN_QP); const bf16* MMb = (const bf16*)(R + GDN_MM); const bf16* NNb = (const bf16*)(R + GDN_NN); bf16* Y = (bf16*)(a->ws + WS_O) + (size_t)2 * M * 512;
    constexpr int SLOT = 52224;
    f32x4 H[8];
#pragma unroll
    for (int I = 0; I < 8; ++I) H[I] = (f32x4){0.f, 0.f, 0.f, 0.f};
    v4u pre[6]; u32x2 nn[8], nnn[8], yi[4], yin[4];
#define GDN_GLOAD(c, PRE, NNv, YI) do { const int item_ = (b * 64 + (c)) * 4 + h; \
        _Pragma("unroll") for (int u = 0; u < 6; ++u) { const int ch = tid + 512 * u; PRE[u] = ch < 2048 ? *(const v4u*)(MMb + (size_t)item_ * 16384 + ch * 8) : *(const v4u*)(QPb + (size_t)item_ * 8192 + (ch - 2048) * 8); } \
        _Pragma("unroll") for (int I = 0; I < 8; ++I) NNv[I] = *(const u32x2*)(NNb + (size_t)item_ * 16384 + (size_t)((J * 8 + I) * 64 + lane) * 4); \
        _Pragma("unroll") for (int T = 0; T < 4; ++T) YI[T] = *(const u32x2*)(Y + (size_t)((b * 64 + (c)) * 64 + 16 * T + n) * 512 + h * 128 + 16 * J + 4 * g); } while (0)
#define GDN_LWRITE(slot, PRE) do { LAS unsigned char* base_ = lds + (slot) * SLOT; \
        _Pragma("unroll") for (int u = 0; u < 6; ++u) { const int ch = tid + 512 * u; const int cq = ch < 2048 ? ch : ch - 2048; \
            *(LAS v4u*)(base_ + (ch < 2048 ? 0 : 34816) + (cq >> 4) * (P128 * 2) + (cq & 15) * 16) = PRE[u]; } } while (0)
    GDN_GLOAD(0, pre, nn, yi);
    GDN_LWRITE(0, pre);
    __syncthreads();
#pragma unroll 1
    for (int c = 0; c < 64; ++c) {
        if (c + 1 < 64) GDN_GLOAD(c + 1, pre, nnn, yin);
        const LAS bf16* MMs = (const LAS bf16*)(lds + (c & 1) * SLOT); const LAS bf16* QPs = (const LAS bf16*)(lds + (c & 1) * SLOT + 34816);
        bf16x8 bH[4];
#pragma unroll
        for (int s = 0; s < 4; ++s) bH[s] = frag_of(H[2 * s], H[2 * s + 1]);
#pragma unroll
        for (int T = 0; T < 4; ++T) {
            f32x4 acc = unpack4(yi[T]);
#pragma unroll
            for (int s = 0; s < 4; ++s) acc = mfma16(bH[s], *(const LAS bf16x8*)(QPs + (16 * T + n) * P128 + 32 * s + 8 * g), acc);
            *(u32x2*)(Y + (size_t)((b * 64 + c) * 64 + 16 * T + n) * 512 + h * 128 + 16 * J + 4 * g) = pack4(acc);
        }
#pragma unroll
        for (int I = 0; I < 8; ++I) {
            f32x4 acc = unpack4(nn[I]);
#pragma unroll
            for (int s = 0; s < 4; ++s) acc = mfma16(*(const LAS bf16x8*)(MMs + (16 * I + n) * P128 + 32 * s + 8 * g), bH[s], acc);
            H[I] = acc;
        }
        if (c + 1 < 64) GDN_LWRITE((c + 1) & 1, pre);
        __syncthreads();
#pragma unroll
        for (int I = 0; I < 8; ++I) nn[I] = nnn[I];
#pragma unroll
        for (int T = 0; T < 4; ++T) yi[T] = yin[T];
    }
#undef GDN_GLOAD
#undef GDN_LWRITE
}
constexpr size_t RW_RP = 64 * MiB, RW_MM = 80 * MiB, RW_NN = 96 * MiB, RW_E1 = 112 * MiB, RW_E2 = 128 * MiB, RW_DC = 144 * MiB;
constexpr int P160 = 168;
template <int K> __device__ __forceinline__ f32x4 mm16g(f32x4 acc, const LAS bf16* Ap, int pa, const bf16* Bg, int pbg, int lane) {
    const LAS bf16* a = Ap + (lane & 15) * pa + 8 * (lane >> 4); const bf16* b = Bg + (size_t)(lane & 15) * pbg + 8 * (lane >> 4);
#pragma unroll
    for (int kk = 0; kk < K; kk += 32) acc = mfma16(*(const LAS bf16x8*)(a + kk), *(const bf16x8*)(b + kk), acc);
    return acc;
}
__device__ __forceinline__ void tri_inv(LAS bf16* S, LAS bf16* ST, LAS bf16* S2, LAS bf16* S2T, LAS bf16* P, int wave, int lane, int tid) {
    const int g = lane >> 4, n = lane & 15;
    for (int e = tid; e < 4096; e += NTHREADS) { const int t = e >> 6, s = e & 63; P[t * P64 + s] = (bf16)f2bf((t == s ? 1.f : 0.f) + b2f(S[t * P64 + s])); }
    __syncthreads();
    LAS bf16* cur = S; LAS bf16* curT = ST; LAS bf16* nxt = S2; LAS bf16* nxtT = S2T;
#pragma unroll 1
    for (int k = 0; k < 5; ++k) {
#pragma unroll
        for (int i = 0; i < 2; ++i) { const int idx = wave * 2 + i, T = idx >> 2, Sx = idx & 3; f32x4 acc = {0.f, 0.f, 0.f, 0.f};
            acc = mm16<64>(acc, cur + 16 * T * P64, P64, curT + 16 * Sx * P64, P64, lane);
            storeR(nxt, P64, 16 * T, 16 * Sx, acc, lane); storeT(nxtT, P64, 16 * T, 16 * Sx, acc, lane); }
        __syncthreads();
        f32x4 pacc[2];
#pragma unroll
        for (int i = 0; i < 2; ++i) { const int idx = wave * 2 + i, T = idx >> 2, Sx = idx & 3;
#pragma unroll
            for (int r = 0; r < 4; ++r) pacc[i][r] = b2f(P[(16 * T + 4 * g + r) * P64 + 16 * Sx + n]);
            pacc[i] = mm16<64>(pacc[i], P + 16 * T * P64, P64, nxtT + 16 * Sx * P64, P64, lane); }
        __syncthreads();
#pragma unroll
        for (int i = 0; i < 2; ++i) { const int idx = wave * 2 + i, T = idx >> 2, Sx = idx & 3; storeR(P, P64, 16 * T, 16 * Sx, pacc[i], lane); }
        __syncthreads();
        LAS bf16* t0 = cur; cur = nxt; nxt = t0; LAS bf16* t1 = curT; curT = nxtT; nxtT = t1;
    }
}
__device__ __forceinline__ void m1_rw(KArgs a, int L, int item, LAS unsigned char* lds, int tid) {
    const int lane = tid & 63, wave = tid >> 6, g = lane >> 4, n = lane & 15, h = item & 7, bc = item >> 3, c = bc & 63, tok0 = bc * 64;
    unsigned char* R = a->ws + WS_R; unsigned char* wb = a->ws + WS_W;
    const bf16* hr = (const bf16*)R; bf16* RPg = (bf16*)(R + RW_RP) + (size_t)item * 4096; bf16* MMg = (bf16*)(R + RW_MM) + (size_t)item * 4096; bf16* NNg = (bf16*)(R + RW_NN) + (size_t)item * 4096;
    bf16* E1 = (bf16*)(R + RW_E1); bf16* E2 = (bf16*)(R + RW_E2); bf16* Y = (bf16*)(a->ws + WS_O); float* DCg = (float*)(R + RW_DC) + (size_t)item * 64;
    const float* mu = a->in[8] + L * 1824;
    LAS bf16* ATr = (LAS bf16*)lds; LAS bf16* BTr = ATr + 64 * P64; LAS bf16* KTr = BTr + 64 * P64; LAS bf16* RTr = KTr + 64 * P64;
    LAS bf16* ATt = RTr + 64 * P64; LAS bf16* VTt = ATt + 64 * P64; LAS bf16* BHt = VTt + 64 * P64; LAS bf16* KHt = BHt + 64 * P64;
    LAS bf16* S = KHt + 64 * P64; LAS bf16* ST = S + 64 * P64; LAS bf16* S2 = ST + 64 * P64; LAS bf16* S2T = S2 + 64 * P64; LAS bf16* P = S2T + 64 * P64;
    LAS bf16* AAK = P + 64 * P64; LAS bf16* ARB = AAK + 64 * P64; LAS bf16* ARK = ARB + 64 * P64;
    LAS bf16* WT = ATr; LAS bf16* UT = BTr; LAS bf16* XT = KTr;
    LAS bf16* TW = S; LAS bf16* AL = ST; LAS bf16* GL = S2;
    LAS float* LW = (LAS float*)(lds + 73728 + 39936); LAS float* ASIG = LW + 4096;
    for (int ch = tid; ch < 64 * 36; ch += NTHREADS) {
        const int t = ch / 36, cc = (ch % 36) * 8; const size_t ro = (size_t)(tok0 + t) * LD_RW + 1536 + cc;
        const v4u cw = *(const v4u*)(hr + ro); v4u pw = {0u, 0u, 0u, 0u};
        if (c * 64 + t > 0) pw = *(const v4u*)(hr + ro - LD_RW);
        const unsigned cu[4] = {cw.x, cw.y, cw.z, cw.w}, pu[4] = {pw.x, pw.y, pw.z, pw.w};
#pragma unroll
        for (int e = 0; e < 8; ++e) {
            const float cur = (e & 1) ? __uint_as_float(cu[e >> 1] & 0xffff0000u) : __uint_as_float(cu[e >> 1] << 16), prv = (e & 1) ? __uint_as_float(pu[e >> 1] & 0xffff0000u) : __uint_as_float(pu[e >> 1] << 16);
            const int col = cc + e; const float xs = cur + (prv - cur) * mu[1536 + col];
            if (col < 64) TW[t * P64 + col] = (bf16)f2bf(tanhf_(xs)); else if (col < 128) AL[t * P64 + col - 64] = (bf16)f2bf(xs); else GL[t * P160 + col - 128] = (bf16)f2bf(sigmoidf_(xs));
        }
    }
    __syncthreads();
#pragma unroll
    for (int i = 0; i < 6; ++i) {
        const int idx = wave * 6 + i, kind = idx >> 4, T = (idx >> 2) & 3, Jt = idx & 3;
        f32x4 acc = {0.f, 0.f, 0.f, 0.f};
        if (kind == 0) acc = mm16g<64>(acc, TW + 16 * T * P64, P64, (const bf16*)(wb + WO_RW2T) + (size_t)(h * 64 + 16 * Jt) * 64, 64, lane);
        else if (kind == 1) acc = mm16g<64>(acc, AL + 16 * T * P64, P64, (const bf16*)(wb + WO_RA2T) + (size_t)(h * 64 + 16 * Jt) * 64, 64, lane);
        else acc = mm16g<160>(acc, GL + 16 * T * P160, P160, (const bf16*)(wb + WO_RG2T) + (size_t)(h * 64 + 16 * Jt) * 160, 160, lane);
        const int j = 16 * Jt + n, hj = L * 512 + h * 64 + j;
#pragma unroll
        for (int r = 0; r < 4; ++r) { const int t = 16 * T + 4 * g + r;
            if (kind == 0) { const float w = acc[r] + a->in[9][hj]; LW[t * 64 + j] = -__expf(-softplusf_(-w) - 0.5f); }
            else if (kind == 1) ASIG[t * 64 + j] = sigmoidf_(acc[r] + a->in[11][hj]);
            else E1[(size_t)(tok0 + t) * 512 + h * 64 + j] = (bf16)f2bf(acc[r]); }
    }
    __syncthreads();
    if (tid < 64) { float run = 0.f; for (int t = 0; t < 64; ++t) { run += LW[t * 64 + tid]; LW[t * 64 + tid] = run; } }
    __syncthreads();
    {
        const int hj = L * 512 + h * 64 + lane;
        const float kkj = a->in[14][hj], kaj = a->in[15][hj], rkj = a->in[16][hj], gngj = a->in[17][hj], gnbj = a->in[18][hj];
        const float mur = mu[h * 64 + lane], muk = mu[512 + h * 64 + lane], muv = mu[1024 + h * 64 + lane];
        const float cend = LW[63 * 64 + lane];
        if (wave == 0) DCg[lane] = __expf(cend);
#pragma unroll 1
        for (int tt = 0; tt < 8; ++tt) {
            const int t = wave * 8 + tt; const size_t ro = (size_t)(tok0 + t) * LD_RW + h * 64 + lane; const bool hp = (c * 64 + t) > 0;
            const float rc = b2f(hr[ro]), kc = b2f(hr[ro + 512]), vc = b2f(hr[ro + 1024]);
            const float rp = hp ? b2f(hr[ro - LD_RW]) : 0.f, kp = hp ? b2f(hr[ro + 512 - LD_RW]) : 0.f, vp = hp ? b2f(hr[ro + 1024 - LD_RW]) : 0.f;
            const float r = rc + (rp - rc) * mur, kr = kc + (kp - kc) * muk, v = vc + (vp - vc) * muv;
            const float C = LW[t * 64 + lane], Cm = t > 0 ? LW[(t - 1) * 64 + lane] : 0.f, asig = ASIG[t * 64 + lane];
            const float kkr = kr * kkj, kk = kkr * (1.0f / sqrtf(wave_sum(kkr * kkr) + 1e-6f));
            const float k2 = kr * (1.f + (asig - 1.f) * kaj), av = -kk, bv = kk * asig;
            const float bon = wave_sum(r * k2 * rkj) * v;
            const float eC = __expf(C), eCm = __expf(Cm), eN = __expf(-C), eE = __expf(cend - C);
            const bf16 ab = (bf16)f2bf(av * eCm), rb = (bf16)f2bf(r * eC);
            ATr[t * P64 + lane] = ab; ATt[lane * P64 + t] = ab; BTr[t * P64 + lane] = (bf16)f2bf(bv * eN); KTr[t * P64 + lane] = (bf16)f2bf(k2 * eN); RTr[t * P64 + lane] = rb;
            VTt[lane * P64 + t] = (bf16)f2bf(v); BHt[lane * P64 + t] = (bf16)f2bf(bv * eE); KHt[lane * P64 + t] = (bf16)f2bf(k2 * eE);
            RPg[t * 64 + kperm(lane)] = rb;
            const size_t eo = (size_t)(tok0 + t) * 512 + h * 64 + lane; const float gg = b2f(E1[eo]);
            E1[eo] = (bf16)f2bf(gngj * gg); E2[eo] = (bf16)f2bf((gnbj + bon) * gg);
        }
    }
    __syncthreads();
#pragma unroll
    for (int i = 0; i < 8; ++i) {
        const int idx = wave * 8 + i, kind = idx >> 4, T = (idx >> 2) & 3, Sx = idx & 3;
        f32x4 acc = {0.f, 0.f, 0.f, 0.f};
        if (Sx <= T) acc = mm16<64>(acc, ((kind & 2) ? RTr : ATr) + 16 * T * P64, P64, ((kind & 1) ? KTr : BTr) + 16 * Sx * P64, P64, lane);
        const int s = 16 * Sx + n;
#pragma unroll
        for (int r = 0; r < 4; ++r) { const int t = 16 * T + 4 * g + r; if ((kind & 2) ? (s > t) : (s >= t)) acc[r] = 0.f; }
        if (kind == 0) { storeR(S, P64, 16 * T, 16 * Sx, acc, lane); storeT(ST, P64, 16 * T, 16 * Sx, acc, lane); }
        else storeR(kind == 1 ? AAK : (kind == 2 ? ARB : ARK), P64, 16 * T, 16 * Sx, acc, lane);
    }
    __syncthreads();
    tri_inv(S, ST, S2, S2T, P, wave, lane, tid);
#pragma unroll
    for (int i = 0; i < 4; ++i) {
        const int idx = wave * 4 + i, kind = idx >> 4, T = (idx >> 2) & 3, Dt = idx & 3;
        f32x4 acc = {0.f, 0.f, 0.f, 0.f};
        acc = mm16<64>(acc, (kind ? P : AAK) + 16 * T * P64, P64, (kind ? ATt : VTt) + 16 * Dt * P64, P64, lane);
        storeT(kind ? WT : XT, P64, 16 * T, 16 * Dt, acc, lane);
    }
    __syncthreads();
#pragma unroll
    for (int i = 0; i < 2; ++i) {
        const int idx = wave * 2 + i, T = idx >> 2, Dt = idx & 3;
        f32x4 acc = {0.f, 0.f, 0.f, 0.f};
        acc = mm16<64>(acc, P + 16 * T * P64, P64, XT + 16 * Dt * P64, P64, lane);
        storeT(UT, P64, 16 * T, 16 * Dt, acc, lane);
    }
    __syncthreads();
#pragma unroll
    for (int i = 0; i < 8; ++i) {
        const int idx = wave * 8 + i, kind = idx >> 4, A4 = (idx >> 2) & 3, B4 = idx & 3;
        f32x4 acc = {0.f, 0.f, 0.f, 0.f};
        if (kind == 0) {
            acc = mm16<64>(acc, WT + 16 * A4 * P64, P64, ARB + 16 * B4 * P64, P64, lane);
            bf16* rp = RPg + (16 * B4 + n) * 64 + (A4 >> 1) * 32 + 8 * g + 4 * (A4 & 1); const f32x4 r0 = unpack4(*(const u32x2*)rp); *(u32x2*)rp = pack4(r0 + acc);
        } else if (kind == 1) {
            acc = mm16<64>(acc, UT + 16 * A4 * P64, P64, ARB + 16 * B4 * P64, P64, lane);
            acc = mm16<64>(acc, VTt + 16 * A4 * P64, P64, ARK + 16 * B4 * P64, P64, lane);
            *(u32x2*)(Y + (size_t)(tok0 + 16 * B4 + n) * 512 + h * 64 + 16 * A4 + 4 * g) = pack4(acc);
        } else if (kind == 2) {
            acc = mm16<64>(acc, WT + 16 * A4 * P64, P64, BHt + 16 * B4 * P64, P64, lane);
            const int ip = 16 * B4 + n; const float dc = DCg[ip];
#pragma unroll
            for (int r = 0; r < 4; ++r) if (16 * A4 + 4 * g + r == ip) acc[r] += dc;
            *(u32x2*)(MMg + ip * 64 + (A4 >> 1) * 32 + 8 * g + 4 * (A4 & 1)) = pack4(acc);
        } else {
            acc = mm16<64>(acc, BHt + 16 * A4 * P64, P64, UT + 16 * B4 * P64, P64, lane);
            acc = mm16<64>(acc, KHt + 16 * A4 * P64, P64, VTt + 16 * B4 * P64, P64, lane);
            *(u32x2*)(NNg + (size_t)((B4 * 4 + A4) * 64 + lane) * 4) = pack4(acc);
        }
    }
    __syncthreads();
}
__device__ __forceinline__ void m2_rw(KArgs a, int b, int h, int tid) {
    const int lane = tid & 63, J = tid >> 6, g = lane >> 4, n = lane & 15;
    if (J >= 4) return;
    unsigned char* R = a->ws + WS_R;
    const bf16* RPb = (const bf16*)(R + RW_RP); const bf16* MMb = (const bf16*)(R + RW_MM); const bf16* NNb = (const bf16*)(R + RW_NN); bf16* Y = (bf16*)(a->ws + WS_O);
    f32x4 H[4];
#pragma unroll
    for (int I = 0; I < 4; ++I) H[I] = (f32x4){0.f, 0.f, 0.f, 0.f};
    bf16x8 bq[4][2], bqn[4][2];
#define RW_LOAD(c, BQ) do { const bf16* rp_ = RPb + (size_t)((b * 64 + (c)) * 8 + h) * 4096 + n * 64 + 8 * g; \
        _Pragma("unroll") for (int T = 0; T < 4; ++T) { _Pragma("unroll") for (int s = 0; s < 2; ++s) BQ[T][s] = *(const bf16x8*)(rp_ + T * 1024 + 32 * s); } } while (0)
    RW_LOAD(0, bq);
#pragma unroll 1
    for (int c = 0; c < 64; ++c) {
        const int item = (b * 64 + c) * 8 + h;
        bf16x8 am[4][2]; u32x2 yi[4], nn[4];
        { const bf16* mp_ = MMb + (size_t)item * 4096 + n * 64 + 8 * g; bf16* yp_ = Y + (size_t)((b * 64 + c) * 64 + n) * 512 + h * 64 + 16 * J + 4 * g; const bf16* np_ = NNb + (size_t)item * 4096 + (size_t)(J * 4 * 64 + lane) * 4;
#pragma unroll
          for (int T = 0; T < 4; ++T) { am[T][0] = *(const bf16x8*)(mp_ + T * 1024); am[T][1] = *(const bf16x8*)(mp_ + T * 1024 + 32); yi[T] = *(const u32x2*)(yp_ + (size_t)T * 16 * 512); nn[T] = *(const u32x2*)(np_ + T * 256); } }
        if (c + 1 < 64) RW_LOAD(c + 1, bqn);
        const bf16x8 h0 = frag_of(H[0], H[1]), h1 = frag_of(H[2], H[3]);
#pragma unroll
        for (int T = 0; T < 4; ++T) {
            f32x4 acc = {0.f, 0.f, 0.f, 0.f};
            acc = mfma16(h0, bq[T][0], acc); acc = mfma16(h1, bq[T][1], acc);
            *(u32x2*)(Y + (size_t)((b * 64 + c) * 64 + 16 * T + n) * 512 + h * 64 + 16 * J + 4 * g) = pack4(acc + unpack4(yi[T]));
        }
#pragma unroll
        for (int I = 0; I < 4; ++I) { f32x4 acc = {0.f, 0.f, 0.f, 0.f}; acc = mfma16(am[I][0], h0, acc); acc = mfma16(am[I][1], h1, acc); H[I] = acc + unpack4(nn[I]); }
#pragma unroll
        for (int T = 0; T < 4; ++T) { bq[T][0] = bqn[T][0]; bq[T][1] = bqn[T][1]; }
    }
#undef RW_LOAD
}
__device__ __forceinline__ void m3_rw(bf16* Y, const bf16* E1, const bf16* E2, int gw, int NGW, int lane) {
    for (int m = gw; m < M; m += NGW) {
        const v4u yw = *(const v4u*)(Y + (size_t)m * 512 + lane * 8), e1w = *(const v4u*)(E1 + (size_t)m * 512 + lane * 8), e2w = *(const v4u*)(E2 + (size_t)m * 512 + lane * 8);
        const unsigned yu[4] = {yw.x, yw.y, yw.z, yw.w}, e1u[4] = {e1w.x, e1w.y, e1w.z, e1w.w}, e2u[4] = {e2w.x, e2w.y, e2w.z, e2w.w};
        float y[8], e1[8], e2[8];
#pragma unroll
        for (int i = 0; i < 4; ++i) { y[2 * i] = __uint_as_float(yu[i] << 16); y[2 * i + 1] = __uint_as_float(yu[i] & 0xffff0000u); e1[2 * i] = __uint_as_float(e1u[i] << 16); e1[2 * i + 1] = __uint_as_float(e1u[i] & 0xffff0000u);
            e2[2 * i] = __uint_as_float(e2u[i] << 16); e2[2 * i + 1] = __uint_as_float(e2u[i] & 0xffff0000u); }
        float sm = 0.f;
#pragma unroll
        for (int i = 0; i < 8; ++i) sm += y[i];
        sm += __shfl_xor(sm, 1); sm += __shfl_xor(sm, 2); sm += __shfl_xor(sm, 4);
        const float mean = sm * (1.f / 64.f); float sq = 0.f;
#pragma unroll
        for (int i = 0; i < 8; ++i) { y[i] -= mean; sq += y[i] * y[i]; }
        sq += __shfl_xor(sq, 1); sq += __shfl_xor(sq, 2); sq += __shfl_xor(sq, 4);
        const float rs = 1.0f / sqrtf(sq * (1.f / 64.f) + 64e-5f);
        v4u o; o.x = pk2(y[0] * rs * e1[0] + e2[0], y[1] * rs * e1[1] + e2[1]); o.y = pk2(y[2] * rs * e1[2] + e2[2], y[3] * rs * e1[3] + e2[3]);
        o.z = pk2(y[4] * rs * e1[4] + e2[4], y[5] * rs * e1[5] + e2[5]); o.w = pk2(y[6] * rs * e1[6] + e2[6], y[7] * rs * e1[7] + e2[7]);
        *(v4u*)(Y + (size_t)m * 512 + lane * 8) = o;
    }
}
constexpr int PH_PER_LAYER = 25, N_PHASES = 1 + DEPTH * PH_PER_LAYER;
#ifndef MK_SINGLE
#define MK_SINGLE 0
#endif
#ifndef CHUNK_GLA
#define CHUNK_GLA 1
#endif
#ifndef CHUNK_GDN
#define CHUNK_GDN 1
#endif
#ifndef CHUNK_RW
#define CHUNK_RW 1
#endif
#define XB_TMO      128
#define XB_XCNT(j)  (256  + 64 * (j))
#define XB_XSUB(j)  (1280 + 64 * (j))
#define XB_XGEN(j)  (2304 + 64 * (j))
#define XB_TOP      3328
#define XB_TOPGEN   3392
#define XB_SPIN_CAP (1u << 22)
__device__ __forceinline__ unsigned xb_ld(unsigned* p)              { return __hip_atomic_load(p, __ATOMIC_RELAXED, __HIP_MEMORY_SCOPE_AGENT); }
__device__ __forceinline__ unsigned xb_add(unsigned* p, unsigned v) { return __hip_atomic_fetch_add(p, v, __ATOMIC_RELAXED, __HIP_MEMORY_SCOPE_AGENT); }
__device__ __forceinline__ unsigned xb_xcc_id() { return (unsigned)__builtin_amdgcn_s_getreg((3 << 11) | 20) & 0xFu; }
#define XB_SPIN(cond, bar) do { unsigned _sp = 0; while (cond) { __builtin_amdgcn_s_sleep(1); \
    if ((++_sp & 255u) == 0u) { if (xb_ld(&(bar)[XB_TMO])) break; if (_sp > XB_SPIN_CAP) { atomicAdd(&(bar)[XB_TMO], 1u); break; } } } } while (0)
struct XcdBarrier { unsigned* bar; unsigned x; volatile LAS unsigned* st; };
__device__ __forceinline__ XcdBarrier xcd_barrier_post(unsigned* bar, volatile LAS unsigned* st) {
    XcdBarrier b; b.bar = bar; b.x = xb_xcc_id(); b.st = st;
    if (threadIdx.x == 0) (void)xb_add(&bar[XB_XCNT(b.x)], 1u);
    return b;
}
__device__ __forceinline__ void xcd_barrier_complete(unsigned* bar, unsigned x, unsigned& nloc, unsigned& nx) {
    const unsigned G = gridDim.x * gridDim.y * gridDim.z;
    unsigned sum, cnt, mine, sp = 0u;
    for (;;) {
        sum = 0u; cnt = 0u; mine = 0u;
#pragma unroll
        for (unsigned j = 0; j < 16; ++j) { const unsigned c = xb_ld(&bar[XB_XCNT(j)]); sum += c; cnt += (c > 0u) ? 1u : 0u; mine = (j == x) ? c : mine; }
        if (sum == G) break;
        __builtin_amdgcn_s_sleep(1);
        if ((++sp & 255u) == 0u) { if (xb_ld(&bar[XB_TMO])) break; if (sp > XB_SPIN_CAP) { atomicAdd(&bar[XB_TMO], 1u); break; } }
    }
    nloc = mine > 0u ? mine : 1u; nx = cnt > 0u ? cnt : 1u;
}
__device__ __forceinline__ void xcd_barrier(const XcdBarrier& b) {
    asm volatile("s_waitcnt vmcnt(0)" ::: "memory");
    __syncthreads();
    if (threadIdx.x == 0) {
        unsigned* bar = b.bar;
        __builtin_amdgcn_s_waitcnt(0);
        unsigned nloc = b.st[0], nx = b.st[1];
        if (nloc == 0u) { xcd_barrier_complete(bar, b.x, nloc, nx); b.st[0] = nloc; b.st[1] = nx; }
        const unsigned old = xb_add(&bar[XB_XSUB(b.x)], 1u);
        const unsigned gen = old / nloc;
        if (old + 1u == (gen + 1u) * nloc) {
            __builtin_amdgcn_fence(__ATOMIC_RELEASE, "agent");
            asm volatile("s_waitcnt vmcnt(0)" ::: "memory");
            const unsigned og = xb_add(&bar[XB_TOP], 1u);
            const unsigned tg = og / nx;
            if (og + 1u == (tg + 1u) * nx) xb_add(&bar[XB_TOPGEN], 1u);
            else XB_SPIN(xb_ld(&bar[XB_TOPGEN]) == tg, bar);
            __builtin_amdgcn_fence(__ATOMIC_ACQUIRE, "agent");
            xb_add(&bar[XB_XGEN(b.x)], 1u);
            asm volatile("s_waitcnt vmcnt(0)" ::: "memory");
        } else {
            XB_SPIN(xb_ld(&bar[XB_XGEN(b.x)]) == gen, bar);
            __builtin_amdgcn_fence(__ATOMIC_ACQUIRE, "agent");
            asm volatile("s_waitcnt vmcnt(0)" ::: "memory");
        }
    }
    __syncthreads();
}
template <int PH> __device__ __forceinline__ void run_phase(LAS unsigned char* lds) {
    constexpr int L = PH > 0 ? (PH - 1) / PH_PER_LAYER : 0, q = PH > 0 ? (PH - 1) % PH_PER_LAYER + 1 : 0, s = q >= 20 ? 1 : 0;
    const int tid = threadIdx.x, lane = tid & 63, wave = __builtin_amdgcn_readfirstlane(tid >> 6);
    const int G = gridDim.x, bid = blockIdx.x;
    KArgs ap = (KArgs)__builtin_amdgcn_kernarg_segment_ptr();
    unsigned char* ws = ap->ws; float* X = ap->out;
    const int gw = bid * NWAVES + wave, NGW = G * NWAVES;
    unsigned char* wb = ws + WS_W;
    bf16* XB = (bf16*)(ws + WS_XB);
    bf16* OB = (bf16*)(ws + WS_O);
    (void)lane; (void)gw; (void)NGW; (void)wb; (void)XB; (void)OB; (void)X; (void)s;
        if constexpr (q == 0) {
            convert_weights(ap, 0, lds, wave, lane, gw, NGW);
            for (int m = gw; m < M; m += NGW) row_pass<false>(ap->in[0] + (size_t)m * D, X + (size_t)m * D, XB + (size_t)m * D, nullptr, nullptr, lane);
        } else if constexpr (q == 1 || q == 20) {
            pg8::Gemm g{XB, (const bf16*)(wb + (s ? WO_W13_1 : WO_W13_0)), M, 5632, D}; pg8::StaticOrder S; S.init(M, 5632, G, bid);
            pg8::EpiSwiGLU E{(bf16*)(ws + WS_R), FF};
            pg8::gemm_phase<pg8::EpiSwiGLU, pg8::StaticOrder, true, true>(lds, g, S, E, tid);
        } else if constexpr (q == 2 || q == 21) {
            pg8::Gemm g{(const bf16*)(ws + WS_R), (const bf16*)(wb + (s ? WO_W2_1 : WO_W2_0)), M, D, FF}; pg8::StaticOrder S; S.init(M, D, G, bid);
            pg8::EpiResid E{X, ALPHA, 0.5f};
            pg8::gemm_phase<pg8::EpiResid, pg8::StaticOrder, true, true>(lds, g, S, E, tid);
        } else if constexpr (q == 3 || q == 19 || q == 22 || q == 25) {
            const int li = q == 3 ? 0 : (q == 19 ? 1 : (q == 22 ? 2 : 3));
            const float* lng = ap->in[2] + (size_t)(L * 4 + li) * D; const float* lnb = ap->in[3] + (size_t)(L * 4 + li) * D;
            for (int m = gw; m < M; m += NGW) row_pass<true>(X + (size_t)m * D, X + (size_t)m * D, XB + (size_t)m * D, lng, lnb, lane);
            if (q == 22) {
                const float* ps = ap->in[1] + (size_t)L * M * PLE; bf16* pd = (bf16*)(ws + WS_R);
                for (size_t e = (size_t)(bid * NTHREADS + tid) * 4; e < (size_t)M * PLE; e += (size_t)G * NTHREADS * 4) {
                    const f32x4 v = *(const GAS f32x4*)(ps + e);
                    *(GAS unsigned long long*)(pd + e) = (unsigned long long)pk2(v.x, v.y) | ((unsigned long long)pk2(v.z, v.w) << 32);
                }
            }
            if (q == 25 && L + 1 < DEPTH) convert_weights(ap, L + 1, lds, wave, lane, gw, NGW);
        } else if constexpr (q == 4 || q == 8 || q == 12) {
            const int ld = q == 4 ? LD_RW : (q == 8 ? LD_GLA : LD_GDN); const size_t wo = q == 4 ? WO_WRW : (q == 8 ? WO_WGLA : WO_WGDN);
            pg8::Gemm g{XB, (const bf16*)(wb + wo), M, ld, D}; pg8::StaticOrder S; S.init(M, ld, G, bid);
            pg8::EpiStore<0> E{(bf16*)(ws + WS_R), ld};
            pg8::gemm_phase<pg8::EpiStore<0>, pg8::StaticOrder, true, true>(lds, g, S, E, tid);
        } else if constexpr (q == 5) {
#if CHUNK_RW
            for (int it = bid; it < 2048; it += G) m1_rw(ap, L, it, lds, tid);
#endif
        } else if constexpr (q == 6) {
#if CHUNK_RW
            if (bid < 32) m2_rw(ap, bid >> 3, bid & 7, tid);
#else
            if (bid < 32) mix_rwkv(ap, L, bid >> 3, bid & 7, (LAS float*)lds, tid, (const bf16*)(ws + WS_R), OB);
#endif
        } else if constexpr (q == 7) {
#if CHUNK_RW
            m3_rw(OB, (const bf16*)(ws + WS_R + RW_E1), (const bf16*)(ws + WS_R + RW_E2), gw, NGW, lane);
#endif
        } else if constexpr (q == 9) {
#if CHUNK_GLA
            for (int it = bid; it < 1024; it += G) m1_gla(ap, L, it, lds, tid);
#endif
        } else if constexpr (q == 10) {
#if CHUNK_GLA
            if (bid < 16) m2_gla(ap, bid >> 2, bid & 3, tid);
#else
            if (bid < 16) mix_gla(ap, L, bid >> 2, bid & 3, (LAS float*)lds, tid, (const bf16*)(ws + WS_R), OB + (size_t)M * 512);
#endif
        } else if constexpr (q == 11) {
#if CHUNK_GLA
            m3_rms(OB + (size_t)M * 512, (const bf16*)(ws + WS_R + GLA_E), gw, NGW, lane);
#endif
        } else if constexpr (q == 13) {
#if CHUNK_GDN
            for (int it = bid; it < 1024; it += G) m1_gdn(ap, L, it, lds, tid);
#endif
        } else if constexpr (q == 14) {
#if CHUNK_GDN
            if (bid < 16) m2_gdn(ap, bid >> 2, bid & 3, lds, tid);
#else
            if (bid < 16) mix_gdn(ap, L, bid >> 2, bid & 3, (LAS float*)lds, tid, (const bf16*)(ws + WS_R), OB + (size_t)2 * M * 512);
#endif
        } else if constexpr (q == 15) {
#if CHUNK_GDN
            m3_rms(OB + (size_t)2 * M * 512, (const bf16*)(ws + WS_R + GDN_E), gw, NGW, lane);
#endif
        } else if constexpr (q == 16) {
            pg8::Gemm g{XB, (const bf16*)(wb + WO_WG), M, NGATE, D}; pg8::StaticOrder S; S.init(M, NGATE, G, bid);
            pg8::EpiStore<2> E{(bf16*)(ws + WS_R), NGATE};
            pg8::gemm_phase<pg8::EpiStore<2>, pg8::StaticOrder, true, true>(lds, g, S, E, tid);
        } else if constexpr (q == 17) {
            pg8::Gemm g{(const bf16*)(ws + WS_O), (const bf16*)(wb + WO_WBR), 3 * M, 3 * 1024, 512}; pg8::BranchOrder S; S.init(G, bid);
            pg8::EpiBranch E{(const bf16*)(ws + WS_R), (float*)(ws + WS_R_ACC), XB};
            pg8::gemm_phase<pg8::EpiBranch, pg8::BranchOrder, true, true>(lds, g, S, E, tid);
        } else if constexpr (q == 18) {
            pg8::Gemm g{XB, (const bf16*)(wb + WO_WO), M, D, D}; pg8::StaticOrder S; S.init(M, D, G, bid);
            pg8::EpiResid E{X, ALPHA, 1.0f};
            pg8::gemm_phase<pg8::EpiResid, pg8::StaticOrder, true, true>(lds, g, S, E, tid);
        } else if constexpr (q == 23) {
            int kple = PLE; asm volatile("" : "+s"(kple));
            pg8::Gemm g{(const bf16*)(ws + WS_R), (const bf16*)(wb + WO_WPP), M, D, kple}; pg8::StaticOrder S; S.init(M, D, G, bid);
            pg8::EpiStore<0> E{(bf16*)(ws + WS_R_PP), D};
            pg8::gemm_phase<pg8::EpiStore<0>, pg8::StaticOrder, true, true>(lds, g, S, E, tid);
        } else if constexpr (q == 24) {
            pg8::Gemm g{XB, (const bf16*)(wb + WO_WPG), M, D, D}; pg8::StaticOrder S; S.init(M, D, G, bid);
            pg8::EpiPle E{X, (const bf16*)(ws + WS_R_PP), ALPHA};
            pg8::gemm_phase<pg8::EpiPle, pg8::StaticOrder, true, true>(lds, g, S, E, tid);
        }
}
__global__ void __launch_bounds__(NTHREADS, 2) mk_fwd(Args args) {
    extern __shared__ __attribute__((aligned(16))) unsigned char lds_raw[];
    LAS unsigned char* lds = (LAS unsigned char*)lds_raw;
#if MK_SINGLE
    cg::grid_group grid = cg::this_grid();
    volatile LAS unsigned* xst = (volatile LAS unsigned*)(lds + 147456);
    if (threadIdx.x == 0) { xst[0] = 0u; xst[1] = 0u; }
    __syncthreads();
    const XcdBarrier xb = xcd_barrier_post((unsigned*)args.ws, xst);
#ifdef MK_TIME
#define STAMP(k) if (blockIdx.x == 0 && threadIdx.x == 0) ((unsigned long long*)(args.ws + 32768))[(k)] = __builtin_amdgcn_s_memrealtime();
#else
#define STAMP(k)
#endif
    STAMP(0)
#define PHASE(k) if (args.ph_lo <= (k) && (k) < args.ph_hi) { run_phase<(k)>(lds); if ((k) + 1 < args.ph_hi) { if ((k) == 0) grid.sync(); else xcd_barrier(xb); } STAMP((k) + 1) }
#else
#define PHASE(k) if (args.ph_lo <= (k) && (k) < args.ph_hi) { run_phase<(k)>(lds); }
#endif
    PHASE(0)
    PHASE(1)
    PHASE(2)
    PHASE(3)
    PHASE(4)
    PHASE(5)
    PHASE(6)
    PHASE(7)
    PHASE(8)
    PHASE(9)
    PHASE(10)
    PHASE(11)
    PHASE(12)
    PHASE(13)
    PHASE(14)
    PHASE(15)
    PHASE(16)
    PHASE(17)
    PHASE(18)
    PHASE(19)
    PHASE(20)
    PHASE(21)
    PHASE(22)
    PHASE(23)
    PHASE(24)
    PHASE(25)
    PHASE(26)
    PHASE(27)
    PHASE(28)
    PHASE(29)
    PHASE(30)
    PHASE(31)
    PHASE(32)
    PHASE(33)
    PHASE(34)
    PHASE(35)
    PHASE(36)
    PHASE(37)
    PHASE(38)
    PHASE(39)
    PHASE(40)
    PHASE(41)
    PHASE(42)
    PHASE(43)
    PHASE(44)
    PHASE(45)
    PHASE(46)
    PHASE(47)
    PHASE(48)
    PHASE(49)
    PHASE(50)
#undef PHASE
    static_assert(N_PHASES == 51, "phase slots");
#if MK_SINGLE && defined(MK_TIME)
    if (blockIdx.x == 0 && threadIdx.x == 0) { const unsigned long long* ts = (const unsigned long long*)(args.ws + 32768); asm volatile("s_waitcnt vmcnt(0)" ::: "memory");
        args.out[0] += 0.01f * (float)(ts[MK_TIME_B] - ts[MK_TIME_A]); }
#endif
}

#ifdef MK_DEBUG
__global__ void __launch_bounds__(NTHREADS, 2) dbg_naive(Args args, int which, int L) {
    extern __shared__ __attribute__((aligned(16))) unsigned char lds_raw[];
    KArgs ap = (KArgs)__builtin_amdgcn_kernarg_segment_ptr();
    const int tid = threadIdx.x, bid = blockIdx.x;
    bf16* dst = (bf16*)(args.ws + WS_DBG);
    if (which == 0) mix_rwkv(ap, L, 0, bid, (LAS float*)lds_raw, tid, (const bf16*)(args.ws + WS_R), dst);
    else if (which == 1) mix_gla(ap, L, 0, bid, (LAS float*)lds_raw, tid, (const bf16*)(args.ws + WS_R), dst);
    else mix_gdn(ap, L, 0, bid, (LAS float*)lds_raw, tid, (const bf16*)(args.ws + WS_R), dst);
}
__global__ void dbg_cmp(Args args, int which) {
    const bf16* o = (const bf16*)(args.ws + WS_O) + (size_t)which * M * 512; const bf16* r = (const bf16*)(args.ws + WS_DBG);
    float mx = 0.f;
    for (size_t e = (size_t)blockIdx.x * blockDim.x + threadIdx.x; e < (size_t)SEQ * 512; e += (size_t)gridDim.x * blockDim.x) {
#ifdef MK_DEBUG_TMAX
        if ((int)(e / 512) >= MK_DEBUG_TMAX) continue;
#endif
        mx = fmaxf(mx, fabsf(b2f(o[e]) - b2f(r[e])));
    }
    atomicMax((unsigned*)args.ws + 1 + which, __float_as_uint(mx));
}
__global__ void dbg_inject(Args args) {
    if (threadIdx.x == 0 && blockIdx.x == 0) { const float* d = (const float*)args.ws; args.out[0] += 1.0e4f * d[1 + MK_DEBUG]; }
}
#endif

extern "C" void kernel_launch(void* const* d_in, const int* in_sizes, int n_in, void* d_out, int out_size, void* d_ws, size_t ws_size, hipStream_t stream) {
    static int grid = 0;
    if (grid == 0) {
        if (n_in != 30 || out_size != M * D || ws_size < WS_END) { fprintf(stderr, "kernel_launch: unexpected problem: n_in %d out %d ws %zu\n", n_in, out_size, ws_size); grid = -1; return; }
        int dev = 0, cus = 0, per_cu = 0;
        (void)hipGetDevice(&dev); (void)hipDeviceGetAttribute(&cus, hipDeviceAttributeMultiprocessorCount, dev);
        (void)hipFuncSetAttribute((const void*)mk_fwd, hipFuncAttributeMaxDynamicSharedMemorySize, LDS_BYTES);
#ifdef MK_DEBUG
        (void)hipFuncSetAttribute((const void*)dbg_naive, hipFuncAttributeMaxDynamicSharedMemorySize, LDS_BYTES);
#endif
        (void)hipOccupancyMaxActiveBlocksPerMultiprocessor(&per_cu, (const void*)mk_fwd, NTHREADS, LDS_BYTES);
        (void)hipGetLastError();
        if (per_cu < 1) { fprintf(stderr, "kernel_launch: occupancy query says %d\n", per_cu); per_cu = 1; }
        grid = cus;
        if (grid > 256) grid = 256;
    }
    if (grid < 0) return;
    Args a{};
    for (int i = 0; i < 30; ++i) a.in[i] = (const float*)d_in[i];
    a.out = (float*)d_out; a.ws = (unsigned char*)d_ws;
#if MK_SINGLE
    (void)hipMemsetAsync(d_ws, 0, 65536, stream);
    a.ph_lo = 0; a.ph_hi = N_PHASES;
    void* kargs[] = {&a};
    hipError_t e = hipLaunchCooperativeKernel((const void*)mk_fwd, dim3(grid), dim3(NTHREADS), kargs, LDS_BYTES, stream);
    if (e != hipSuccess) fprintf(stderr, "cooperative launch failed: %s (grid %d)\n", hipGetErrorString(e), grid);
#else
#ifdef MK_DEBUG
    (void)hipMemsetAsync(d_ws, 0, 4096, stream);
#endif
    for (int ph = 0; ph < N_PHASES; ++ph) {
        a.ph_lo = ph; a.ph_hi = ph + 1;
        hipLaunchKernelGGL(mk_fwd, dim3(grid), dim3(NTHREADS), LDS_BYTES, stream, a);
#ifdef MK_DEBUG
        { const int L_ = ph > 0 ? (ph - 1) / PH_PER_LAYER : 0, q_ = ph > 0 ? (ph - 1) % PH_PER_LAYER + 1 : 0;
          const int which = q_ == 7 ? 0 : (q_ == 11 ? 1 : (q_ == 15 ? 2 : -1));
          if (which == MK_DEBUG) { hipLaunchKernelGGL(dbg_naive, dim3(which == 0 ? 8 : 4), dim3(NTHREADS), LDS_BYTES, stream, a, which, L_); hipLaunchKernelGGL(dbg_cmp, dim3(256), dim3(256), 0, stream, a, which); } }
#endif
    }
#ifdef MK_DEBUG
    hipLaunchKernelGGL(dbg_inject, dim3(1), dim3(64), 0, stream, a);
#endif
#endif
}
```

```cpp
#define MK_SINGLE 1
#include <hip/hip_runtime.h>
#include <hip/hip_cooperative_groups.h>
#include <cstdio>
#include <cstdint>
namespace pg8 {
#define PG8_LAS __attribute__((address_space(3)))
typedef unsigned short bf16_t;
typedef short bf16x8 __attribute__((ext_vector_type(8)));
typedef float f32x4 __attribute__((ext_vector_type(4)));
typedef unsigned u32x4 __attribute__((ext_vector_type(4)));
constexpr int BM = 256, BK = 64, HALF = 128, HTB = HALF * BK * 2  , STAGE_BYTES = 8 * HTB, NXCD = 8, WGM = 8;

__host__ __device__ __forceinline__ int lds_byte(int r, int c) { const int st = (r >> 4) * 2 + (c >> 5), rr = r & 15, cc = c & 31, ob = rr * 64 + cc * 2; return st * 1024 + (ob ^ (((ob >> 9) & 1) << 5)); }
__host__ __device__ __forceinline__ void stage_rc(int b, int& R, int& C) { const int st = b / 1024, sb = b % 1024, swz = sb ^ (((sb >> 9) & 1) << 5); R = (st >> 1) * 16 + swz / 64; C = (st & 1) * 32 + (swz % 64) / 2; }
__host__ __device__ __forceinline__ int perm32(int rho) { const int n = rho >> 4, i = rho & 15; return 8 * (i >> 2) + 4 * n + (i & 3); }

struct Unit { int pm, pn; };
struct Gemm { const bf16_t* A; const bf16_t* Bt; int M, N, K; };

struct StaticOrder {
    int nM, nN, nwg, G, c;
    __host__ __device__ void init(int M, int N, int G_, int c_) { nM = M / BM; nN = N / BM; nwg = nM * nN; G = G_; c = c_; }
    __host__ __device__ bool next(int i, Unit& u) const {
        const long L = (long)i * G + c; if (L >= nwg) return false;
        int wgid = (int)L; { const int q = nwg / NXCD, r = nwg % NXCD, xcd = wgid % NXCD, off = wgid / NXCD; wgid = (xcd < r ? xcd * (q + 1) : r * (q + 1) + (xcd - r) * q) + off; }
        const int nig = WGM * nN, gid = wgid / nig, fm = gid * WGM, gsz = (nM - fm) < WGM ? (nM - fm) : WGM;
        u.pm = fm + ((wgid % nig) % gsz); u.pn = (wgid % nig) / gsz; return true;
    }
    __device__ __forceinline__ void a_ready(const Unit&) const {}
    __device__ __forceinline__ void done(const Unit&) const {}
};

__device__ __forceinline__ unsigned cvt_pk_bf16(float lo, float hi) { unsigned r; asm volatile("v_cvt_pk_bf16_f32 %0, %1, %2" : "=v"(r) : "v"(lo), "v"(hi)); return r; }
typedef unsigned u32x2 __attribute__((ext_vector_type(2)));
__device__ __forceinline__ float fsigmoid(float x) { return __builtin_amdgcn_rcpf(1.0f + __builtin_amdgcn_exp2f(-1.44269504f * x)); }
__device__ __forceinline__ unsigned bf16_sw(float f) { const unsigned u = __float_as_uint(f); return (u + 0x7fffu + ((u >> 16) & 1u)) >> 16; }
__device__ __forceinline__ unsigned pk_bf16_sw(float lo, float hi) { return bf16_sw(lo) | (bf16_sw(hi) << 16); }
__device__ __forceinline__ float bf2f(unsigned short u) { return __uint_as_float((unsigned)u << 16); }
__device__ __forceinline__ float bflo(unsigned w) { return __uint_as_float(w << 16); }
__device__ __forceinline__ float bfhi(unsigned w) { return __uint_as_float(w & 0xffff0000u); }

struct EpiSwiGLU {
    static constexpr bool PERM = true, AFTER_DRAIN = false;
    bf16_t* O; int ldc;
    __device__ __forceinline__ void operator()(const f32x4 (&acc)[2][2][4][2], const Unit& u, int wr, int wc, int fr, int fq) const {
        const int row0 = u.pm * BM + wr * 64 + fr, col0 = u.pn * HALF + wc * 32 + 8 * fq;
#pragma unroll
        for (int ai = 0; ai < 2; ++ai)
#pragma unroll
            for (int m = 0; m < 4; ++m) {
                bf16_t* rowp = O + (size_t)(row0 + ai * HALF + m * 16) * ldc + col0;
                const f32x4 g0 = acc[ai][0][m][0], g1 = acc[ai][0][m][1], u0 = acc[ai][1][m][0], u1 = acc[ai][1][m][1];
                float h[8];
#pragma unroll
                for (int e = 0; e < 4; ++e) { h[e] = g0[e] * fsigmoid(g0[e]) * u0[e]; h[4 + e] = g1[e] * fsigmoid(g1[e]) * u1[e]; }
                u32x4 w; w.x = cvt_pk_bf16(h[0], h[1]); w.y = cvt_pk_bf16(h[2], h[3]); w.z = cvt_pk_bf16(h[4], h[5]); w.w = cvt_pk_bf16(h[6], h[7]);
                *(u32x4*)rowp = w;
            }
    }
};
template <int ACT> struct EpiStore {
    static constexpr bool PERM = true, AFTER_DRAIN = false;
    bf16_t* O; int ldc;
    __device__ __forceinline__ void operator()(const f32x4 (&acc)[2][2][4][2], const Unit& u, int wr, int wc, int fr, int fq) const {
        const int row0 = u.pm * BM + wr * 64 + fr, col0 = u.pn * BM + wc * 32 + 8 * fq;
#pragma unroll
        for (int ai = 0; ai < 2; ++ai)
#pragma unroll
            for (int m = 0; m < 4; ++m) {
                bf16_t* rowp = O + (size_t)(row0 + ai * HALF + m * 16) * ldc + col0;
#pragma unroll
                for (int bj = 0; bj < 2; ++bj) {
                    f32x4 v0 = acc[ai][bj][m][0], v1 = acc[ai][bj][m][1];
                    if (ACT == 2) {
#pragma unroll
                        for (int e = 0; e < 4; ++e) { v0[e] = fsigmoid(v0[e]); v1[e] = fsigmoid(v1[e]); }
                    }
                    u32x4 w;
                    if (ACT == 2) { w.x = pk_bf16_sw(v0[0], v0[1]); w.y = pk_bf16_sw(v0[2], v0[3]); w.z = pk_bf16_sw(v1[0], v1[1]); w.w = pk_bf16_sw(v1[2], v1[3]); }
                    else { w.x = cvt_pk_bf16(v0[0], v0[1]); w.y = cvt_pk_bf16(v0[2], v0[3]); w.z = cvt_pk_bf16(v1[0], v1[1]); w.w = cvt_pk_bf16(v1[2], v1[3]); }
                    *(u32x4*)(rowp + bj * HALF) = w;
                }
            }
    }
};
struct EpiResid {
    static constexpr bool PERM = false, AFTER_DRAIN = false;
    float* X; float alpha, s;
    __device__ __forceinline__ void operator()(const f32x4 (&acc)[2][2][4][2], const Unit& u, int wr, int wc, int fr, int fq) const {
        const int col0 = u.pn * BM + wc * 32 + 4 * fq;
#pragma unroll
        for (int ai = 0; ai < 2; ++ai)
#pragma unroll
            for (int m = 0; m < 4; ++m) {
                const int r = u.pm * BM + ai * HALF + wr * 64 + m * 16 + fr; float* p = X + (size_t)r * 1024 + col0;
#pragma unroll
                for (int bj = 0; bj < 2; ++bj)
#pragma unroll
                    for (int n = 0; n < 2; ++n) { f32x4 v = *(const f32x4*)(p + bj * HALF + n * 16); v = v * alpha + acc[ai][bj][m][n] * s; *(f32x4*)(p + bj * HALF + n * 16) = v; }
                asm volatile("" ::: "memory");
            }
    }
};
struct EpiBranch {
    static constexpr bool PERM = false, AFTER_DRAIN = false;
    const bf16_t* G; float* ACC; bf16_t* MG;
    __device__ __forceinline__ void operator()(const f32x4 (&acc)[2][2][4][2], const Unit& u, int wr, int wc, int fr, int fq) const {
        const int b = u.pm >> 6, pm = u.pm & 63, pn = u.pn & 3;
        const int col0 = pn * BM + wc * 32 + 4 * fq;
#pragma unroll
        for (int ai = 0; ai < 2; ++ai)
#pragma unroll
            for (int m = 0; m < 4; ++m) {
                const int r = pm * BM + ai * HALF + wr * 64 + m * 16 + fr;
                float* pa = ACC + (size_t)r * 1024 + col0; const bf16_t* pg = G + (size_t)r * 3072 + b * 1024 + col0; bf16_t* po = MG + (size_t)r * 1024 + col0;
#pragma unroll
                for (int bj = 0; bj < 2; ++bj)
#pragma unroll
                    for (int n = 0; n < 2; ++n) {
                        const int o = bj * HALF + n * 16;
                        const u32x2 gw = *(const u32x2*)(pg + o);
                        f32x4 v = acc[ai][bj][m][n];
                        v[0] *= bflo(gw.x); v[1] *= bfhi(gw.x); v[2] *= bflo(gw.y); v[3] *= bfhi(gw.y);
#ifdef ZERO_BRANCH
                        if (b == ZERO_BRANCH) v = (f32x4){0.f, 0.f, 0.f, 0.f};
#endif
                        if (b > 0) v += *(const f32x4*)(pa + o);
                        if (b < 2) *(f32x4*)(pa + o) = v;
                        else { u32x2 w; w.x = cvt_pk_bf16(v[0], v[1]); w.y = cvt_pk_bf16(v[2], v[3]); *(u32x2*)(po + o) = w; }
                    }
                asm volatile("" ::: "memory");
            }
    }
};
struct EpiPle {
    static constexpr bool PERM = false, AFTER_DRAIN = false;
    float* X; const bf16_t* P; float alpha;
    __device__ __forceinline__ void operator()(const f32x4 (&acc)[2][2][4][2], const Unit& u, int wr, int wc, int fr, int fq) const {
        const int col0 = u.pn * BM + wc * 32 + 4 * fq;
#pragma unroll
        for (int ai = 0; ai < 2; ++ai)
#pragma unroll
            for (int m = 0; m < 4; ++m) {
                const int r = u.pm * BM + ai * HALF + wr * 64 + m * 16 + fr; float* p = X + (size_t)r * 1024 + col0; const bf16_t* pp = P + (size_t)r * 1024 + col0;
#pragma unroll
                for (int bj = 0; bj < 2; ++bj)
#pragma unroll
                    for (int n = 0; n < 2; ++n) {
                        const int o = bj * HALF + n * 16;
                        f32x4 v = *(const f32x4*)(p + o); const u32x2 pw = *(const u32x2*)(pp + o); const f32x4 a = acc[ai][bj][m][n];
                        v[0] = v[0] * alpha + fsigmoid(a[0]) * bflo(pw.x); v[1] = v[1] * alpha + fsigmoid(a[1]) * bfhi(pw.x);
                        v[2] = v[2] * alpha + fsigmoid(a[2]) * bflo(pw.y); v[3] = v[3] * alpha + fsigmoid(a[3]) * bfhi(pw.y);
                        *(f32x4*)(p + o) = v;
                    }
                asm volatile("" ::: "memory");
            }
    }
};
struct BranchOrder {
    StaticOrder so;
    __host__ __device__ void init(int G_, int c_) { so.init(16384, 1024, G_, c_); }
    __host__ __device__ bool next(int i, Unit& u) const { if (i >= 3) return false; Unit t; if (!so.next(0, t)) return false; u.pm = i * 64 + t.pm; u.pn = i * 4 + t.pn; return true; }
    __device__ __forceinline__ void a_ready(const Unit&) const {}
    __device__ __forceinline__ void done(const Unit&) const {}
};

template <class Epi, class Sched, bool ALIGN_EPI = false, bool SP2 = false>
__device__ __forceinline__ void gemm_phase(PG8_LAS unsigned char* lds, const Gemm g, const Sched& S, const Epi& E, const int tid) {
    const int  wid = __builtin_amdgcn_readfirstlane(tid >> 6), lane = tid & 63, wr = wid >> 2, wc = wid & 3, fr = lane & 15, fq = lane >> 4;
    const int K = g.K, nt = K / BK;
    unsigned voffA[2], voffB[2];
#pragma unroll
    for (int i = 0; i < 2; ++i) { int R, C; stage_rc(tid * 16 + i * 8192, R, C); const int Rb = Epi::PERM ? ((R & ~31) + perm32(R & 31)) : R;
        voffA[i] = (unsigned)(R * K + C) * 2u; voffB[i] = (unsigned)(Rb * K + C) * 2u; }
    const size_t kstep = (size_t)(BK * 2);
    const size_t hstep = (size_t)HALF * K * 2;
    const size_t tstep = 2 * hstep;
    const unsigned ldsw = (unsigned)wid * 1024u;
    const int aoff = lds_byte(wr * 64 + fr, fq * 8), boff = lds_byte(wc * 32 + fr, fq * 8);
#define PG8_SA(b, h) (((b) * 2 + (h)) * HTB)
#define PG8_SB(b, h) ((4 + (b) * 2 + (h)) * HTB)
#define PG8_STAGE(bufoff, gbase, voff) do { _Pragma("unroll") for (int _i = 0; _i < 2; ++_i) \
        __builtin_amdgcn_global_load_lds((const unsigned*)((const char*)(gbase) + (voff)[_i]), (PG8_LAS unsigned*)(lds + (bufoff) + ldsw + _i * 8192), 16, 0, 0); } while (0)
#define PG8_LDA(dst, b, h) do { _Pragma("unroll") for (int m = 0; m < 4; ++m) _Pragma("unroll") for (int k = 0; k < 2; ++k) dst[m][k] = *(const PG8_LAS bf16x8*)(lds + PG8_SA(b, h) + aoff + m * 2048 + k * 1024); } while (0)
#define PG8_LDB(dst, b, h) do { _Pragma("unroll") for (int n = 0; n < 2; ++n) _Pragma("unroll") for (int k = 0; k < 2; ++k) dst[n][k] = *(const PG8_LAS bf16x8*)(lds + PG8_SB(b, h) + boff + n * 2048 + k * 1024); } while (0)
#define PG8_MMA(ai, bj, At, Bt) do { __builtin_amdgcn_s_setprio(1); _Pragma("unroll") for (int m = 0; m < 4; ++m) _Pragma("unroll") for (int n = 0; n < 2; ++n) _Pragma("unroll") for (int k = 0; k < 2; ++k) \
        acc[ai][bj][m][n] = __builtin_amdgcn_mfma_f32_16x16x32_bf16(Bt[n][k], At[m][k], acc[ai][bj][m][n], 0, 0, 0); __builtin_amdgcn_s_setprio(0); } while (0)
#define PG8_WAIT_V(n) asm volatile("s_waitcnt vmcnt(" #n ")" ::: "memory")
#define PG8_WAIT_L(n) asm volatile("s_waitcnt lgkmcnt(" #n ")" ::: "memory")
#define PG8_BAR __builtin_amdgcn_s_barrier()
#define PG8_SCHED __builtin_amdgcn_sched_barrier(0)
    Unit cur, nxt; int ui = 0;
    if (!S.next(0, cur)) return;
    f32x4 acc[2][2][4][2];
#pragma unroll
    for (int a = 0; a < 2; ++a)
#pragma unroll
        for (int b = 0; b < 2; ++b)
#pragma unroll
            for (int m = 0; m < 4; ++m)
#pragma unroll
                for (int n = 0; n < 2; ++n) acc[a][b][m][n] = (f32x4){0.f, 0.f, 0.f, 0.f};
    bf16x8 At[4][2], B0[2][2], B1[2][2];
    const char* cA = (const char*)g.A + (size_t)cur.pm * tstep; const char* cB = (const char*)g.Bt + (size_t)cur.pn * tstep;
    S.a_ready(cur);
    if constexpr (SP2) {
        PG8_STAGE(PG8_SB(0, 0), cB, voffB); PG8_STAGE(PG8_SB(0, 1), cB + hstep, voffB); PG8_STAGE(PG8_SA(0, 0), cA, voffA); PG8_STAGE(PG8_SA(0, 1), cA + hstep, voffA);
        if (wr == 1) PG8_BAR;
        PG8_WAIT_V(2); PG8_BAR;
        PG8_STAGE(PG8_SB(1, 0), cB + kstep, voffB); PG8_STAGE(PG8_SA(1, 0), cA + kstep, voffA); PG8_STAGE(PG8_SB(1, 1), cB + hstep + kstep, voffB);
        PG8_WAIT_V(6); PG8_BAR;
    } else {
        PG8_STAGE(PG8_SB(0, 0), cB, voffB); PG8_STAGE(PG8_SA(0, 0), cA, voffA); PG8_STAGE(PG8_SB(0, 1), cB + hstep, voffB); PG8_STAGE(PG8_SA(0, 1), cA + hstep, voffA);
        if (wr == 1) PG8_BAR;
        PG8_WAIT_V(4); PG8_BAR;
        PG8_STAGE(PG8_SB(1, 0), cB + kstep, voffB); PG8_STAGE(PG8_SA(1, 0), cA + kstep, voffA); PG8_STAGE(PG8_SB(1, 1), cB + hstep + kstep, voffB);
        PG8_WAIT_V(6); PG8_BAR;
    }
    for (;;) {
        const bool has_next = S.next(ui + 1, nxt);
        const char* nA = has_next ? (const char*)g.A + (size_t)nxt.pm * tstep : cA; const char* nB = has_next ? (const char*)g.Bt + (size_t)nxt.pn * tstep : cB;
        for (int t = 0; t < nt; t += 2) {
            const bool last = (t == nt - 2);
            const char* a1 = cA + (size_t)(t + 1) * kstep;
            const char* a2 = last ? nA : cA + (size_t)(t + 2) * kstep; const char* b2 = last ? nB : cB + (size_t)(t + 2) * kstep;
            const char* a3 = a2 + kstep; const char* b3 = b2 + kstep;
            if (last && has_next) S.a_ready(nxt);
            if constexpr (SP2) {
            PG8_LDB(B0, 0, 0); PG8_LDB(B1, 0, 1); PG8_SCHED; PG8_LDA(At, 0, 0); PG8_STAGE(PG8_SA(1, 1), a1 + hstep, voffA);
            PG8_WAIT_V(8); PG8_WAIT_L(0); PG8_BAR; PG8_MMA(0, 0, At, B0); PG8_MMA(0, 1, At, B1); PG8_BAR; PG8_SCHED;
            PG8_LDA(At, 0, 1); PG8_STAGE(PG8_SB(0, 0), b2, voffB); PG8_STAGE(PG8_SB(0, 1), b2 + hstep, voffB); PG8_STAGE(PG8_SA(0, 0), a2, voffA);
            PG8_WAIT_V(8); PG8_WAIT_L(0); PG8_BAR; PG8_MMA(1, 0, At, B0); PG8_MMA(1, 1, At, B1); PG8_BAR; PG8_SCHED;
            PG8_LDB(B0, 1, 0); PG8_LDB(B1, 1, 1); PG8_SCHED; PG8_LDA(At, 1, 0); PG8_STAGE(PG8_SA(0, 1), a2 + hstep, voffA);
            PG8_WAIT_V(8); PG8_WAIT_L(0); PG8_BAR; PG8_MMA(0, 0, At, B0); PG8_MMA(0, 1, At, B1); PG8_BAR; PG8_SCHED;
            PG8_LDA(At, 1, 1); PG8_STAGE(PG8_SB(1, 0), b3, voffB); PG8_STAGE(PG8_SB(1, 1), b3 + hstep, voffB); PG8_STAGE(PG8_SA(1, 0), a3, voffA);
            PG8_WAIT_V(8); PG8_WAIT_L(0); PG8_BAR; PG8_MMA(1, 0, At, B0); PG8_MMA(1, 1, At, B1); PG8_BAR; PG8_SCHED;
            } else {
            PG8_LDB(B0, 0, 0); PG8_SCHED; PG8_LDA(At, 0, 0); PG8_STAGE(PG8_SA(1, 1), a1 + hstep, voffA);
            PG8_WAIT_L(8); PG8_BAR; PG8_WAIT_L(0); PG8_MMA(0, 0, At, B0); PG8_BAR; PG8_SCHED;
            PG8_LDB(B1, 0, 1); PG8_STAGE(PG8_SB(0, 0), b2, voffB);
            PG8_BAR; PG8_WAIT_L(0); PG8_MMA(0, 1, At, B1); PG8_BAR;
            PG8_LDA(At, 0, 1); PG8_STAGE(PG8_SA(0, 0), a2, voffA);
            PG8_BAR; PG8_WAIT_L(0); PG8_MMA(1, 0, At, B0); PG8_BAR; PG8_SCHED;
            PG8_STAGE(PG8_SB(0, 1), b2 + hstep, voffB);
            PG8_WAIT_V(6); PG8_BAR; PG8_MMA(1, 1, At, B1); PG8_BAR;
            PG8_LDB(B0, 1, 0); PG8_SCHED; PG8_LDA(At, 1, 0); PG8_STAGE(PG8_SA(0, 1), a2 + hstep, voffA);
            PG8_WAIT_L(8); PG8_BAR; PG8_WAIT_L(0); PG8_MMA(0, 0, At, B0); PG8_BAR; PG8_SCHED;
            PG8_LDB(B1, 1, 1); PG8_STAGE(PG8_SB(1, 0), b3, voffB);
            PG8_BAR; PG8_WAIT_L(0); PG8_MMA(0, 1, At, B1); PG8_BAR;
            PG8_LDA(At, 1, 1); PG8_STAGE(PG8_SA(1, 0), a3, voffA);
            PG8_BAR; PG8_WAIT_L(0); PG8_MMA(1, 0, At, B0); PG8_BAR; PG8_SCHED;
            PG8_STAGE(PG8_SB(1, 1), b3 + hstep, voffB);
            PG8_WAIT_V(6); PG8_BAR; PG8_MMA(1, 1, At, B1); PG8_BAR;
            }
        }
        if constexpr (ALIGN_EPI) { if (wr == 0) PG8_BAR; }
        if constexpr (!Epi::AFTER_DRAIN) { E(acc, cur, wr, wc, fr, fq); S.done(cur); }
        if (!has_next) break;
#pragma unroll
        for (int a = 0; a < 2; ++a)
#pragma unroll
            for (int b = 0; b < 2; ++b)
#pragma unroll
                for (int m = 0; m < 4; ++m)
#pragma unroll
                    for (int n = 0; n < 2; ++n) acc[a][b][m][n] = (f32x4){0.f, 0.f, 0.f, 0.f};
        cur = nxt; cA = nA; cB = nB; ++ui;
        if constexpr (ALIGN_EPI) { if (wr == 1) PG8_BAR; }
    }
    PG8_WAIT_V(0);
    if constexpr (!ALIGN_EPI) { if (wr == 0) PG8_BAR; }
    PG8_BAR;
    if constexpr (Epi::AFTER_DRAIN) { E.fused(acc, cur, wr, wc, fr, fq, lds, wid, lane); S.done(cur); }
#undef PG8_SA
#undef PG8_SB
#undef PG8_STAGE
#undef PG8_LDA
#undef PG8_LDB
#undef PG8_MMA
#undef PG8_WAIT_V
#undef PG8_WAIT_L
#undef PG8_BAR
#undef PG8_SCHED
}
}
namespace cg = cooperative_groups;
constexpr int NWAVES = 8, NTHREADS = 512;
constexpr int BATCH = 4, SEQ = 4096, D = 1024, FF = 2816, M = BATCH * SEQ, DEPTH = 2, PLE = 256;
constexpr int DIN = 8504, NGATE = 3072;
constexpr int N_RW = 1824, N_GLA = 1552, N_GDN = 2056, LD_RW = 2048, LD_GLA = 1792, LD_GDN = 2304;
constexpr int C_GLA = 1824, C_GDN = 3376, C_GATE = 5432;
constexpr float LN_EPS = 1e-5f, ALPHA = 1.41421356237f;
constexpr size_t MiB = 1u << 20;
constexpr size_t WS_CTL = 0;
constexpr size_t SZ_W13 = (size_t)5632 * 1024 * 2, SZ_W2 = (size_t)1024 * 2816 * 2, SZ_WRW = (size_t)LD_RW * 1024 * 2, SZ_WGLA = (size_t)LD_GLA * 1024 * 2, SZ_WGDN = (size_t)LD_GDN * 1024 * 2, SZ_WG = (size_t)NGATE * 1024 * 2,
                 SZ_WBR = (size_t)3 * 1024 * 512 * 2, SZ_WO = (size_t)1024 * 1024 * 2, SZ_WPP = (size_t)1024 * 256 * 2;
constexpr size_t WS_W = 1 * MiB;
constexpr size_t WO_W13_0 = 0, WO_W2_0 = WO_W13_0 + SZ_W13, WO_W13_1 = WO_W2_0 + SZ_W2, WO_W2_1 = WO_W13_1 + SZ_W13, WO_WRW = WO_W2_1 + SZ_W2, WO_WGLA = WO_WRW + SZ_WRW, WO_WGDN = WO_WGLA + SZ_WGLA, WO_WG = WO_WGDN + SZ_WGDN,
                 WO_WBR = WO_WG + SZ_WG, WO_WO = WO_WBR + SZ_WBR, WO_WPG = WO_WO + SZ_WO, WO_WPP = WO_WPG + SZ_WO, WO_RW2T = WO_WPP + SZ_WPP, WO_RA2T = WO_RW2T + 512 * 64 * 2, WO_RG2T = WO_RA2T + 512 * 64 * 2, WO_END = WO_RG2T + 512 * 160 * 2;
static_assert(WO_END <= 59 * MiB, "weights region");
constexpr size_t WS_XB = 60 * MiB;
constexpr size_t WS_R = 92 * MiB;
constexpr size_t WS_R_ACC = WS_R + 96 * MiB, WS_R_PP = WS_R + 8 * MiB;
constexpr size_t WS_O = 268 * MiB;
constexpr size_t WS_DBG = 316 * MiB;
constexpr size_t WS_END = 324 * MiB;
constexpr int LDS_BYTES = 147456 + 64;

#define GAS __attribute__((address_space(1)))
#define LAS __attribute__((address_space(3)))
typedef unsigned short bf16;
typedef unsigned v4u __attribute__((ext_vector_type(4)));
typedef float f32x4 __attribute__((ext_vector_type(4)));
#define LDS_WAIT() asm volatile("s_waitcnt lgkmcnt(0)" ::: "memory")
__device__ __forceinline__ unsigned f2bf(float f) { unsigned u = __builtin_bit_cast(unsigned, f); return (u + 0x7fffu + ((u >> 16) & 1u)) >> 16; }
__device__ __forceinline__ unsigned pk2(float lo, float hi) { return f2bf(lo) | (f2bf(hi) << 16); }
__device__ __forceinline__ float b2f(bf16 u) { return __uint_as_float((unsigned)u << 16); }
__device__ __forceinline__ float wave_sum(float v) {
#pragma unroll
    for (int o = 1; o < 64; o <<= 1) v += __shfl_xor(v, o);
    return v;
}
__device__ __forceinline__ float sigmoidf_(float x) { return 1.0f / (1.0f + __expf(-x)); }
__device__ __forceinline__ float softplusf_(float x) { const float e = __expf(-fabsf(x)); const float l = e < 0.01f ? e * (1.f - e * (0.5f - e * 0.33333334f)) : __logf(1.f + e); return fmaxf(x, 0.f) + l; }
__device__ __forceinline__ float tanhf_(float x) { return 1.f - 2.f / (1.f + __expf(2.f * x)); }

struct Args { const float* in[30]; float* out; unsigned char* ws; int ph_lo, ph_hi; };
typedef const __attribute__((address_space(4))) Args* KArgs;

__device__ __forceinline__ void cvt_item(const float* W, int ld, int c0, int ncols, int K, bf16* WT, int kind, LAS float* scr, int item, int nnb, int lane, int kvalid = 1 << 30) {
    const int kb = item / nnb, nb = item % nnb, k0 = 64 * kb, n0 = 32 * nb;
    const int nn = n0 + (lane & 31); const bool ok = nn < ncols;
#pragma unroll 8
    for (int i = 0; i < 32; ++i) { const int kk = 2 * i + (lane >> 5); scr[kk * 33 + (lane & 31)] = (ok && k0 + kk < kvalid) ? W[(size_t)(k0 + kk) * ld + c0 + nn] : 0.f; }
    LDS_WAIT(); asm volatile("" ::: "memory");
    const int c = lane & 7;
    const int drow0 = (kind == 0) ? n0 : (256 * (n0 >> 7) + (n0 & 127) + (kind == 2 ? 128 : 0));
#pragma unroll
    for (int j = 0; j < 4; ++j) { const int n = (lane >> 3) + 8 * j; const LAS float* s = scr + (8 * c) * 33 + n;
        v4u o; o.x = pk2(s[0 * 33], s[1 * 33]); o.y = pk2(s[2 * 33], s[3 * 33]); o.z = pk2(s[4 * 33], s[5 * 33]); o.w = pk2(s[6 * 33], s[7 * 33]);
        if (k0 + 8 * c < kvalid) *(GAS v4u*)(WT + (size_t)(drow0 + n) * K + k0 + 8 * c) = o; }
    LDS_WAIT(); asm volatile("" ::: "memory");
}
__device__ __forceinline__ void convert_weights(KArgs a, int L, LAS unsigned char* lds, int wave, int lane, int gw, int NGW) {
    LAS float* scr = (LAS float*)(lds + wave * 8704);
    unsigned char* wb = a->ws + WS_W;
    constexpr int I_W1 = 16 * 88, I_W2 = 44 * 32, I_RW = 16 * 64, I_GLA = 16 * 56, I_GDN = 16 * 72, I_WG = 16 * 96, I_BR = 8 * 32, I_O = 16 * 32, I_PP = 4 * 32, I_LR = 16, I_LG = 3 * 16;
    constexpr int NIT = 4 * I_W1 + 2 * I_W2 + I_RW + I_GLA + I_GDN + I_WG + 3 * I_BR + 2 * I_O + I_PP + 2 * I_LR + I_LG;
    for (int it = gw; it < NIT; it += NGW) {
        int r = it;
        if (r < 4 * I_W1) { const int q = r / I_W1, s = q >> 1, w3 = q & 1; r -= q * I_W1;
            cvt_item((w3 ? a->in[5] : a->in[4]) + (size_t)(L * 2 + s) * 1024 * 2816, 2816, 0, 2816, 1024, (bf16*)(wb + (s ? WO_W13_1 : WO_W13_0)), 1 + w3, scr, r, 88, lane); continue; }
        r -= 4 * I_W1;
        if (r < 2 * I_W2) { const int s = r / I_W2; r -= s * I_W2;
            cvt_item(a->in[6] + (size_t)(L * 2 + s) * 2816 * 1024, 1024, 0, 1024, 2816, (bf16*)(wb + (s ? WO_W2_1 : WO_W2_0)), 0, scr, r, 32, lane); continue; }
        r -= 2 * I_W2;
        if (r < I_RW) { cvt_item(a->in[7] + (size_t)L * 1024 * DIN, DIN, 0, N_RW, 1024, (bf16*)(wb + WO_WRW), 0, scr, r, 64, lane); continue; }
        r -= I_RW;
        if (r < I_GLA) { cvt_item(a->in[7] + (size_t)L * 1024 * DIN, DIN, C_GLA, N_GLA, 1024, (bf16*)(wb + WO_WGLA), 0, scr, r, 56, lane); continue; }
        r -= I_GLA;
        if (r < I_GDN) { cvt_item(a->in[7] + (size_t)L * 1024 * DIN, DIN, C_GDN, N_GDN, 1024, (bf16*)(wb + WO_WGDN), 0, scr, r, 72, lane); continue; }
        r -= I_GDN;
        if (r < I_WG) { cvt_item(a->in[7] + (size_t)L * 1024 * DIN, DIN, C_GATE, NGATE, 1024, (bf16*)(wb + WO_WG), 0, scr, r, 96, lane); continue; }
        r -= I_WG;
        if (r < 3 * I_BR) { const int b = r / I_BR; r -= b * I_BR;
            cvt_item(a->in[26] + (size_t)(L * 3 + b) * 512 * 1024, 1024, 0, 1024, 512, (bf16*)(wb + WO_WBR) + (size_t)b * 1024 * 512, 0, scr, r, 32, lane); continue; }
        r -= 3 * I_BR;
        if (r < I_O) { cvt_item(a->in[27] + (size_t)L * 1024 * 1024, 1024, 0, 1024, 1024, (bf16*)(wb + WO_WO), 0, scr, r, 32, lane); continue; }
        r -= I_O;
        if (r < I_O) { cvt_item(a->in[28] + (size_t)L * 1024 * 1024, 1024, 0, 1024, 1024, (bf16*)(wb + WO_WPG), 0, scr, r, 32, lane); continue; }
        r -= I_O;
        if (r < I_PP) { cvt_item(a->in[29] + (size_t)L * 256 * 1024, 1024, 0, 1024, 256, (bf16*)(wb + WO_WPP), 0, scr, r, 32, lane); continue; }
        r -= I_PP;
        if (r < I_LR) { cvt_item(a->in[10] + (size_t)L * 64 * 512, 512, 0, 512, 64, (bf16*)(wb + WO_RW2T), 0, scr, r, 16, lane); continue; }
        r -= I_LR;
        if (r < I_LR) { cvt_item(a->in[12] + (size_t)L * 64 * 512, 512, 0, 512, 64, (bf16*)(wb + WO_RA2T), 0, scr, r, 16, lane); continue; }
        r -= I_LR;
        cvt_item(a->in[13] + (size_t)L * 160 * 512, 512, 0, 512, 160, (bf16*)(wb + WO_RG2T), 0, scr, r, 16, lane, 160);
    }
}
template <bool NORM>
__device__ __forceinline__ void row_pass(const float* src, float* dst, bf16* dstb, const float* g, const float* bta, int lane) {
    const GAS f32x4* xr = (const GAS f32x4*)src + lane;
    f32x4 v[4]; float s = 0.f;
#pragma unroll
    for (int j = 0; j < 4; ++j) { v[j] = xr[64 * j]; s += (v[j].x + v[j].y) + (v[j].z + v[j].w); }
    if (NORM) {
        const float mean = wave_sum(s) * (1.f / D); float s2 = 0.f;
#pragma unroll
        for (int j = 0; j < 4; ++j) { v[j] = v[j] - mean; s2 += (v[j].x * v[j].x + v[j].y * v[j].y) + (v[j].z * v[j].z + v[j].w * v[j].w); }
        const float rstd = 1.f / sqrtf(wave_sum(s2) * (1.f / D) + LN_EPS);
#pragma unroll
        for (int j = 0; j < 4; ++j) { const f32x4 gg = ((const GAS f32x4*)g)[lane + 64 * j], bb = ((const GAS f32x4*)bta)[lane + 64 * j]; v[j] = v[j] * rstd * gg + bb; }
    }
    GAS f32x4* o4 = (GAS f32x4*)dst + lane;
    GAS unsigned long long* o8 = (GAS unsigned long long*)dstb + lane;
#pragma unroll
    for (int j = 0; j < 4; ++j) { o4[64 * j] = v[j]; o8[64 * j] = (unsigned long long)pk2(v[j].x, v[j].y) | ((unsigned long long)pk2(v[j].z, v[j].w) << 32); }
}

constexpr int CH = 16;
__device__ __forceinline__ void mix_rwkv(KArgs a, int L, int b, int h, LAS float* sm, int tid, const bf16* hm, bf16* out) {
    constexpr int LDH = LD_RW, C_RW = 0;
    const int lane = tid & 63, wid = tid >> 6;
    LAS float* w2h = sm; LAS float* a2h = sm + 4096; LAS float* g2h = sm + 8192;
    LAS float* tw = sm + 18432; LAS float* al = tw + 1024; LAS float* gl = al + 1024;
    LAS float* sr = gl + 2560; LAS float* skr = sr + 1024; LAS float* sv = skr + 1024; LAS float* sd = sv + 1024; LAS float* sa = sd + 1024; LAS float* sb = sa + 1024;
    LAS float* sk2 = sb + 1024; LAS float* sg = sk2 + 1024; LAS float* sbon = sg + 1024; LAS float* sy = sbon + 1024;
    const float* mu = a->in[8] + L * 1824;
    for (int e = tid; e < 64 * 64; e += NTHREADS) { const int i = e >> 6, j = e & 63; w2h[e] = a->in[10][(size_t)(L * 64 + i) * 512 + h * 64 + j]; a2h[e] = a->in[12][(size_t)(L * 64 + i) * 512 + h * 64 + j]; }
    for (int e = tid; e < 160 * 64; e += NTHREADS) { const int i = e >> 6, j = e & 63; g2h[e] = a->in[13][(size_t)(L * 160 + i) * 512 + h * 64 + j]; }
    const int hj = L * 512 + h * 64 + lane;
    const float w0j = a->in[9][hj], a0j = a->in[11][hj], kkj = a->in[14][hj], kaj = a->in[15][hj], rkj = a->in[16][hj], gngj = a->in[17][hj], gnbj = a->in[18][hj];
    float S[8];
#pragma unroll
    for (int i = 0; i < 8; ++i) S[i] = 0.f;
    const int vrow = tid >> 3, kg = tid & 7;
    __syncthreads();
#pragma unroll 1
    for (int c = 0; c < SEQ / CH; ++c) {
        const int t0 = c * CH;
        for (int e = tid; e < CH * 480; e += NTHREADS) {
            const int tt = e / 480, cc = e % 480, t = t0 + tt;
            int col; if (cc < 64) col = h * 64 + cc; else if (cc < 128) col = 512 + h * 64 + (cc - 64); else if (cc < 192) col = 1024 + h * 64 + (cc - 128); else col = 1536 + (cc - 192);
            const size_t ro = (size_t)(b * SEQ + t) * LDH + C_RW + col;
            const float cur = b2f(hm[ro]), prev = t > 0 ? b2f(hm[ro - LDH]) : 0.f;
            const float xs = cur + (prev - cur) * mu[col];
            if (cc < 64) sr[tt * 64 + cc] = xs; else if (cc < 128) skr[tt * 64 + cc - 64] = xs; else if (cc < 192) sv[tt * 64 + cc - 128] = xs;
            else if (cc < 256) tw[tt * 64 + cc - 192] = tanhf_(xs); else if (cc < 320) al[tt * 64 + cc - 256] = xs; else gl[tt * 160 + cc - 320] = sigmoidf_(xs);
        }
        __syncthreads();
#pragma unroll
        for (int i2 = 0; i2 < 2; ++i2) {
            const int tt = wid + 8 * i2;
            float w = w0j, av = a0j, g = 0.f;
#pragma unroll 4
            for (int i = 0; i < 64; ++i) { w += tw[tt * 64 + i] * w2h[i * 64 + lane]; av += al[tt * 64 + i] * a2h[i * 64 + lane]; }
#pragma unroll 4
            for (int i = 0; i < 160; ++i) g += gl[tt * 160 + i] * g2h[i * 64 + lane];
            const float wl = -softplusf_(-w) - 0.5f, dec = __expf(-__expf(wl)), asig = sigmoidf_(av);
            const float kraw = skr[tt * 64 + lane], kkr = kraw * kkj;
            const float kk = kkr * (1.0f / sqrtf(wave_sum(kkr * kkr) + 1e-6f));
            const float k2 = kraw * (1.f + (asig - 1.f) * kaj);
            const float rk = wave_sum(sr[tt * 64 + lane] * k2 * rkj);
            sd[tt * 64 + lane] = dec; sa[tt * 64 + lane] = -kk; sb[tt * 64 + lane] = kk * asig; sk2[tt * 64 + lane] = k2; sg[tt * 64 + lane] = g; sbon[tt * 64 + lane] = rk * sv[tt * 64 + lane];
        }
        __syncthreads();
#pragma unroll 1
        for (int tt = 0; tt < CH; ++tt) {
            const int o = tt * 64 + kg * 8;
            float x = 0.f;
#pragma unroll
            for (int i = 0; i < 8; ++i) x += S[i] * sa[o + i];
            x += __shfl_xor(x, 1); x += __shfl_xor(x, 2); x += __shfl_xor(x, 4);
            const float vv = sv[tt * 64 + vrow];
            float y = 0.f;
#pragma unroll
            for (int i = 0; i < 8; ++i) { S[i] = S[i] * sd[o + i] + x * sb[o + i] + vv * sk2[o + i]; y += S[i] * sr[o + i]; }
            y += __shfl_xor(y, 1); y += __shfl_xor(y, 2); y += __shfl_xor(y, 4);
            if (kg == 0) sy[tt * 64 + vrow] = y;
        }
        __syncthreads();
#pragma unroll
        for (int i2 = 0; i2 < 2; ++i2) {
            const int tt = wid + 8 * i2;
            const float y = sy[tt * 64 + lane], mean = wave_sum(y) * (1.f / 64.f), dv = y - mean, var = wave_sum(dv * dv) * (1.f / 64.f);
            const float yn = dv * (1.0f / sqrtf(var + 64e-5f)) * gngj + gnbj;
            const float o = (yn + sbon[tt * 64 + lane]) * sg[tt * 64 + lane];
            out[(size_t)(b * SEQ + t0 + tt) * 512 + h * 64 + lane] = (bf16)f2bf(o);
        }
        __syncthreads();
    }
}
__device__ __forceinline__ void mix_gla(KArgs a, int L, int b, int h, LAS float* sm, int tid, const bf16* hm, bf16* out) {
    constexpr int LDH = LD_GLA, C_GLA = 0;
    const int lane = tid & 63, wid = tid >> 6;
    LAS float* gkw = sm; LAS float* sq = sm + 1024; LAS float* sk = sq + 1024; LAS float* sdec = sk + 1024; LAS float* sv = sdec + 1024; LAS float* sgt = sv + 2048; LAS float* so = sgt + 2048; LAS float* gkl = so + 2048;
    for (int e = tid; e < 16 * 64; e += NTHREADS) { const int i = e >> 6, j = e & 63; gkw[e] = a->in[19][(size_t)(L * 16 + i) * 256 + h * 64 + j]; }
    const float gkbj = a->in[20][L * 256 + h * 64 + lane];
    const float ng0 = a->in[21][L * 128 + lane], ng1 = a->in[21][L * 128 + 64 + lane];
    float S[16];
#pragma unroll
    for (int i = 0; i < 16; ++i) S[i] = 0.f;
    const int vc = tid >> 2, kg = tid & 3;
    __syncthreads();
#pragma unroll 1
    for (int c = 0; c < SEQ / CH; ++c) {
        const int t0 = c * CH;
        for (int e = tid; e < CH * 400; e += NTHREADS) {
            const int tt = e / 400, cc = e % 400;
            int col; if (cc < 64) col = h * 64 + cc; else if (cc < 128) col = 256 + h * 64 + (cc - 64); else if (cc < 256) col = 512 + h * 128 + (cc - 128); else if (cc < 272) col = 1024 + (cc - 256); else col = 1040 + h * 128 + (cc - 272);
            const float x = b2f(hm[(size_t)(b * SEQ + t0 + tt) * LDH + C_GLA + col]);
            if (cc < 64) sq[tt * 64 + cc] = x; else if (cc < 128) sk[tt * 64 + cc - 64] = x; else if (cc < 256) sv[tt * 128 + cc - 128] = x; else if (cc < 272) gkl[tt * 16 + cc - 256] = x; else sgt[tt * 128 + cc - 272] = x;
        }
        __syncthreads();
#pragma unroll
        for (int i2 = 0; i2 < 2; ++i2) {
            const int tt = wid + 8 * i2;
            float z = gkbj;
#pragma unroll
            for (int i = 0; i < 16; ++i) z += gkl[tt * 16 + i] * gkw[i * 64 + lane];
            sdec[tt * 64 + lane] = __expf(-softplusf_(-z) * (1.f / 16.f));
        }
        __syncthreads();
#pragma unroll 1
        for (int tt = 0; tt < CH; ++tt) {
            const int o = tt * 64 + kg * 16; const float vv = sv[tt * 128 + vc];
            float y = 0.f;
#pragma unroll
            for (int i = 0; i < 16; ++i) { S[i] = S[i] * sdec[o + i] + sk[o + i] * vv; y += S[i] * sq[o + i]; }
            y += __shfl_xor(y, 1); y += __shfl_xor(y, 2);
            if (kg == 0) so[tt * 128 + vc] = y * 0.125f;
        }
        __syncthreads();
#pragma unroll
        for (int i2 = 0; i2 < 2; ++i2) {
            const int tt = wid + 8 * i2;
            const float o0 = so[tt * 128 + lane], o1 = so[tt * 128 + 64 + lane];
            const float rs = 1.0f / sqrtf(wave_sum(o0 * o0 + o1 * o1) * (1.f / 128.f) + 1e-6f);
            const float g0 = sgt[tt * 128 + lane], g1 = sgt[tt * 128 + 64 + lane];
            bf16* op = out + (size_t)(b * SEQ + t0 + tt) * 512 + h * 128;
            op[lane] = (bf16)f2bf(o0 * rs * ng0 * g0 * sigmoidf_(g0)); op[64 + lane] = (bf16)f2bf(o1 * rs * ng1 * g1 * sigmoidf_(g1));
        }
        __syncthreads();
    }
}
__device__ __forceinline__ void mix_gdn(KArgs a, int L, int b, int h, LAS float* sm, int tid, const bf16* hm, bf16* out) {
    constexpr int LDH = LD_GDN, C_GDN = 0;
    const int lane = tid & 63, wid = tid >> 6;
    LAS float* raw = sm;
    LAS float* sq = sm + 7296; LAS float* sk = sq + 2048; LAS float* sv = sk + 2048; LAS float* sgt = sv + 2048; LAS float* so = sgt + 2048; LAS float* sal = so + 2048; LAS float* sbe = sal + 16;
    const float* cw = a->in[22] + (size_t)L * 4 * 1536;
    const float Ah = __expf(a->in[23][L * 4 + h]), dtb = a->in[24][L * 4 + h];
    const float ng0 = a->in[25][L * 128 + lane], ng1 = a->in[25][L * 128 + 64 + lane];
    float S[32];
#pragma unroll
    for (int i = 0; i < 32; ++i) S[i] = 0.f;
    const int vc = tid >> 2, kg = tid & 3;
#pragma unroll 1
    for (int c = 0; c < SEQ / CH; ++c) {
        const int t0 = c * CH;
        for (int e = tid; e < 19 * 384; e += NTHREADS) {
            const int rr = e / 384, cc = e % 384, t = t0 - 3 + rr;
            const int col = (cc < 128) ? (h * 128 + cc) : (cc < 256 ? 512 + h * 128 + (cc - 128) : 1024 + h * 128 + (cc - 256));
            raw[e] = t >= 0 ? b2f(hm[(size_t)(b * SEQ + t) * LDH + C_GDN + col]) : 0.f;
        }
        for (int e = tid; e < CH * 128; e += NTHREADS) { const int tt = e >> 7, cc = e & 127; sgt[e] = b2f(hm[(size_t)(b * SEQ + t0 + tt) * LDH + C_GDN + 1544 + h * 128 + cc]); }
        if (tid < CH) {
            const size_t ro = (size_t)(b * SEQ + t0 + tid) * LDH + C_GDN;
            const float ai = b2f(hm[ro + 1536 + h]), bi = b2f(hm[ro + 1540 + h]);
            sal[tid] = __expf(-Ah * softplusf_(ai + dtb)); sbe[tid] = sigmoidf_(bi);
        }
        __syncthreads();
        for (int e = tid; e < CH * 384; e += NTHREADS) {
            const int tt = e / 384, cc = e % 384;
            const int ch = (cc < 128) ? (h * 128 + cc) : (cc < 256 ? 512 + h * 128 + (cc - 128) : 1024 + h * 128 + (cc - 256));
            float s = 0.f;
#pragma unroll
            for (int i = 0; i < 4; ++i) s += cw[i * 1536 + ch] * raw[(tt + i) * 384 + cc];
            s = s * sigmoidf_(s);
            if (cc < 128) sq[tt * 128 + cc] = s; else if (cc < 256) sk[tt * 128 + cc - 128] = s; else sv[tt * 128 + cc - 256] = s;
        }
        __syncthreads();
#pragma unroll
        for (int i2 = 0; i2 < 2; ++i2) {
            const int tt = wid + 8 * i2;
            const float q0 = sq[tt * 128 + lane], q1 = sq[tt * 128 + 64 + lane], k0 = sk[tt * 128 + lane], k1 = sk[tt * 128 + 64 + lane];
            const float rq = (1.0f / sqrtf(wave_sum(q0 * q0 + q1 * q1) + 1e-6f)) * 0.08838834764831845f, rk = 1.0f / sqrtf(wave_sum(k0 * k0 + k1 * k1) + 1e-6f);
            sq[tt * 128 + lane] = q0 * rq; sq[tt * 128 + 64 + lane] = q1 * rq; sk[tt * 128 + lane] = k0 * rk; sk[tt * 128 + 64 + lane] = k1 * rk;
        }
        __syncthreads();
#pragma unroll 1
        for (int tt = 0; tt < CH; ++tt) {
            const int o = tt * 128 + kg * 32; const float al = sal[tt], be = sbe[tt];
            float p = 0.f;
#pragma unroll
            for (int i = 0; i < 32; ++i) { S[i] *= al; p += S[i] * sk[o + i]; }
            p += __shfl_xor(p, 1); p += __shfl_xor(p, 2);
            const float vn = be * (sv[tt * 128 + vc] - p);
            float y = 0.f;
#pragma unroll
            for (int i = 0; i < 32; ++i) { S[i] += sk[o + i] * vn; y += S[i] * sq[o + i]; }
            y += __shfl_xor(y, 1); y += __shfl_xor(y, 2);
            if (kg == 0) so[tt * 128 + vc] = y;
        }
        __syncthreads();
#pragma unroll
        for (int i2 = 0; i2 < 2; ++i2) {
            const int tt = wid + 8 * i2;
            const float o0 = so[tt * 128 + lane], o1 = so[tt * 128 + 64 + lane];
            const float rs = 1.0f / sqrtf(wave_sum(o0 * o0 + o1 * o1) * (1.f / 128.f) + 1e-6f);
            const float g0 = sgt[tt * 128 + lane], g1 = sgt[tt * 128 + 64 + lane];
            bf16* op = out + (size_t)(b * SEQ + t0 + tt) * 512 + h * 128;
            op[lane] = (bf16)f2bf(o0 * rs * ng0 * g0 * sigmoidf_(g0)); op[64 + lane] = (bf16)f2bf(o1 * rs * ng1 * g1 * sigmoidf_(g1));
        }
        __syncthreads();
    }
}

typedef short bf16x8 __attribute__((ext_vector_type(8)));
typedef unsigned u32x2 __attribute__((ext_vector_type(2)));
__device__ __forceinline__ f32x4 mfma16(bf16x8 a, bf16x8 b, f32x4 c) { return __builtin_amdgcn_mfma_f32_16x16x32_bf16(a, b, c, 0, 0, 0); }
template <int K> __device__ __forceinline__ f32x4 mm16(f32x4 acc, const LAS bf16* Ap, int pa, const LAS bf16* Bp, int pb, int lane) {
    const LAS bf16* a = Ap + (lane & 15) * pa + 8 * (lane >> 4); const LAS bf16* b = Bp + (lane & 15) * pb + 8 * (lane >> 4);
#pragma unroll
    for (int kk = 0; kk < K; kk += 32) acc = mfma16(*(const LAS bf16x8*)(a + kk), *(const LAS bf16x8*)(b + kk), acc);
    return acc;
}
__device__ __forceinline__ u32x2 pack4(f32x4 v) { u32x2 w; w.x = pk2(v[0], v[1]); w.y = pk2(v[2], v[3]); return w; }
__device__ __forceinline__ f32x4 unpack4(u32x2 w) { f32x4 v; v[0] = __uint_as_float(w.x << 16); v[1] = __uint_as_float(w.x & 0xffff0000u); v[2] = __uint_as_float(w.y << 16); v[3] = __uint_as_float(w.y & 0xffff0000u); return v; }
__device__ __forceinline__ void storeT(LAS bf16* Out, int po, int m0, int n0, f32x4 acc, int lane) { *(LAS u32x2*)(Out + (n0 + (lane & 15)) * po + m0 + 4 * (lane >> 4)) = pack4(acc); }
__device__ __forceinline__ void storeR(LAS bf16* Out, int po, int m0, int n0, f32x4 acc, int lane) {
#pragma unroll
    for (int r = 0; r < 4; ++r) Out[(m0 + 4 * (lane >> 4) + r) * po + n0 + (lane & 15)] = (bf16)f2bf(acc[r]);
}
__device__ __forceinline__ int kperm(int d) { return (d & ~31) | (((d >> 2) & 3) << 3) | (((d >> 4) & 1) << 2) | (d & 3); }
__device__ __forceinline__ bf16x8 frag_of(f32x4 lo, f32x4 hi) {
    u32x2 a = pack4(lo), b = pack4(hi); v4u w; w.x = a.x; w.y = a.y; w.z = b.x; w.w = b.y; return __builtin_bit_cast(bf16x8, w);
}

constexpr size_t GLA_QP = 56 * MiB, GLA_NN = 64 * MiB, GLA_E = 80 * MiB, GLA_DEC = 96 * MiB;
constexpr int P64 = 72;
__device__ __forceinline__ void m1_gla(KArgs a, int L, int item, LAS unsigned char* lds, int tid) {
    const int lane = tid & 63, wave = tid >> 6, h = item & 3, tok0 = (item >> 2) * 64;
    unsigned char* R = a->ws + WS_R;
    const bf16* hg = (const bf16*)R; bf16* QP = (bf16*)(R + GLA_QP) + (size_t)item * 4096; bf16* NN = (bf16*)(R + GLA_NN) + (size_t)item * 8192;
    bf16* E = (bf16*)(R + GLA_E); float* DEC = (float*)(R + GLA_DEC) + item * 64; bf16* Y = (bf16*)(a->ws + WS_O) + (size_t)M * 512;
    LAS float* LA = (LAS float*)lds;
    LAS bf16* QS = (LAS bf16*)(lds + 16384); LAS bf16* KS = QS + 64 * P64; LAS bf16* KHT = KS + 64 * P64; LAS bf16* VT = KHT + 64 * P64; LAS bf16* ATT = VT + 128 * P64;
    LAS float* GKL = (LAS float*)(lds + 16384 + (64 * 4 + 128) * P64 * 2);
    for (int e = tid; e < 1024; e += NTHREADS) GKL[e] = b2f(hg[(size_t)(tok0 + (e >> 4)) * LD_GLA + 1024 + (e & 15)]);
    __syncthreads();
    {
        const int t = tid >> 3, d0 = (tid & 7) * 8; float z[8];
#pragma unroll
        for (int j = 0; j < 8; ++j) z[j] = a->in[20][L * 256 + h * 64 + d0 + j];
        for (int i = 0; i < 16; ++i) { const float g = GKL[t * 16 + i]; const float* w = a->in[19] + (size_t)(L * 16 + i) * 256 + h * 64 + d0;
#pragma unroll
            for (int j = 0; j < 8; ++j) z[j] += g * w[j]; }
#pragma unroll
        for (int j = 0; j < 8; ++j) LA[t * 64 + d0 + j] = -softplusf_(-z[j]) * (1.f / 16.f);
    }
    __syncthreads();
    if (tid < 64) { float run = 0.f; for (int t = 0; t < 64; ++t) { run += LA[t * 64 + tid]; LA[t * 64 + tid] = run; } }
    __syncthreads();
    for (int e = tid; e < 4096; e += NTHREADS) {
        const int t = e >> 6, d = e & 63; const float bb = LA[e], be = LA[63 * 64 + d];
        const size_t ro = (size_t)(tok0 + t) * LD_GLA + h * 64 + d;
        const float q = b2f(hg[ro]) * 0.125f * __expf(bb), k = b2f(hg[ro + 256]);
        const bf16 qb = (bf16)f2bf(q);
        QS[t * P64 + d] = qb; QP[t * 64 + kperm(d)] = qb;
        KS[t * P64 + d] = (bf16)f2bf(k * __expf(-bb)); KHT[d * P64 + t] = (bf16)f2bf(k * __expf(be - bb));
        if (t == 63) DEC[d] = __expf(be);
    }
    for (int e = tid; e < 8192; e += NTHREADS) {
        const int t = e >> 7, j = e & 127; const size_t ro = (size_t)(tok0 + t) * LD_GLA + h * 128 + j;
        VT[j * P64 + t] = hg[ro + 512];
        const float gt = b2f(hg[ro + 1040]);
        E[(size_t)(tok0 + t) * 512 + h * 128 + j] = (bf16)f2bf(a->in[21][L * 128 + j] * gt * sigmoidf_(gt));
    }
    __syncthreads();
#pragma unroll
    for (int i = 0; i < 2; ++i) {
        const int idx = wave * 2 + i, T = idx >> 2, S = idx & 3;
        f32x4 acc = {0.f, 0.f, 0.f, 0.f};
        if (S <= T) acc = mm16<64>(acc, QS + 16 * T * P64, P64, KS + 16 * S * P64, P64, lane);
#pragma unroll
        for (int r = 0; r < 4; ++r) if (16 * S + (lane & 15) > 16 * T + 4 * (lane >> 4) + r) acc[r] = 0.f;
        storeR(ATT, P64, 16 * T, 16 * S, acc, lane);
    }
    __syncthreads();
#pragma unroll
    for (int i = 0; i < 4; ++i) {
        const int idx = wave * 4 + i, Jt = idx >> 2, T = idx & 3;
        f32x4 acc = {0.f, 0.f, 0.f, 0.f};
        acc = mm16<64>(acc, VT + 16 * Jt * P64, P64, ATT + 16 * T * P64, P64, lane);
        *(u32x2*)(Y + (size_t)(tok0 + 16 * T + (lane & 15)) * 512 + h * 128 + 16 * Jt + 4 * (lane >> 4)) = pack4(acc);
    }
#pragma unroll
    for (int i = 0; i < 4; ++i) {
        const int idx = wave * 4 + i, J = idx >> 2, I = idx & 3;
        f32x4 acc = {0.f, 0.f, 0.f, 0.f};
        acc = mm16<64>(acc, KHT + 16 * I * P64, P64, VT + 16 * J * P64, P64, lane);
        *(u32x2*)(NN + (size_t)((J * 4 + I) * 64 + lane) * 4) = pack4(acc);
    }
    __syncthreads();
}
__device__ __forceinline__ void m2_gla(KArgs a, int b, int h, int tid) {
    const int lane = tid & 63, J = tid >> 6, g = lane >> 4, n = lane & 15;
    unsigned char* R = a->ws + WS_R;
    const bf16* QPb = (const bf16*)(R + GLA_QP); const bf16* NNb = (const bf16*)(R + GLA_NN); const float* DECb = (const float*)(R + GLA_DEC); bf16* Y = (bf16*)(a->ws + WS_O) + (size_t)M * 512;
    f32x4 H[4];
#pragma unroll
    for (int I = 0; I < 4; ++I) H[I] = (f32x4){0.f, 0.f, 0.f, 0.f};
    bf16x8 bq[4][2], bqn[4][2]; u32x2 yi[4], yin[4], nn[4], nnn[4]; f32x4 dc[4], dcn[4];
#define GLA_LOAD(c, BQ, YI, NNv, DC) do { const int item_ = ((b * 64 + (c)) * 4 + h); const bf16* qp_ = QPb + (size_t)item_ * 4096; \
        _Pragma("unroll") for (int T = 0; T < 4; ++T) { _Pragma("unroll") for (int s = 0; s < 2; ++s) BQ[T][s] = *(const bf16x8*)(qp_ + (16 * T + n) * 64 + 32 * s + 8 * g); \
            YI[T] = *(const u32x2*)(Y + (size_t)((b * 64 + (c)) * 64 + 16 * T + n) * 512 + h * 128 + 16 * J + 4 * g); } \
        _Pragma("unroll") for (int I = 0; I < 4; ++I) { NNv[I] = *(const u32x2*)(NNb + (size_t)item_ * 8192 + (size_t)((J * 4 + I) * 64 + lane) * 4); DC[I] = *(const f32x4*)(DECb + item_ * 64 + 16 * I + 4 * g); } } while (0)
    GLA_LOAD(0, bq, yi, nn, dc);
#pragma unroll 1
    for (int c = 0; c < 64; ++c) {
        if (c + 1 < 64) GLA_LOAD(c + 1, bqn, yin, nnn, dcn);
        const bf16x8 a0 = frag_of(H[0], H[1]), a1 = frag_of(H[2], H[3]);
#pragma unroll
        for (int T = 0; T < 4; ++T) {
            f32x4 acc = unpack4(yi[T]);
            acc = mfma16(a0, bq[T][0], acc); acc = mfma16(a1, bq[T][1], acc);
            *(u32x2*)(Y + (size_t)((b * 64 + c) * 64 + 16 * T + n) * 512 + h * 128 + 16 * J + 4 * g) = pack4(acc);
        }
#pragma unroll
        for (int I = 0; I < 4; ++I) H[I] = H[I] * dc[I] + unpack4(nn[I]);
#pragma unroll
        for (int T = 0; T < 4; ++T) { bq[T][0] = bqn[T][0]; bq[T][1] = bqn[T][1]; yi[T] = yin[T]; nn[T] = nnn[T]; dc[T] = dcn[T]; }
    }
#undef GLA_LOAD
}
__device__ __forceinline__ void m3_rms(bf16* Y, const bf16* E, int gw, int NGW, int lane) {
    for (int m = gw; m < M; m += NGW) {
        const v4u yw = *(const v4u*)(Y + (size_t)m * 512 + lane * 8), ew = *(const v4u*)(E + (size_t)m * 512 + lane * 8);
        float y[8], e[8];
        y[0] = __uint_as_float(yw.x << 16); y[1] = __uint_as_float(yw.x & 0xffff0000u); y[2] = __uint_as_float(yw.y << 16); y[3] = __uint_as_float(yw.y & 0xffff0000u);
        y[4] = __uint_as_float(yw.z << 16); y[5] = __uint_as_float(yw.z & 0xffff0000u); y[6] = __uint_as_float(yw.w << 16); y[7] = __uint_as_float(yw.w & 0xffff0000u);
        e[0] = __uint_as_float(ew.x << 16); e[1] = __uint_as_float(ew.x & 0xffff0000u); e[2] = __uint_as_float(ew.y << 16); e[3] = __uint_as_float(ew.y & 0xffff0000u);
        e[4] = __uint_as_float(ew.z << 16); e[5] = __uint_as_float(ew.z & 0xffff0000u); e[6] = __uint_as_float(ew.w << 16); e[7] = __uint_as_float(ew.w & 0xffff0000u);
        float ss = 0.f;
#pragma unroll
        for (int i = 0; i < 8; ++i) ss += y[i] * y[i];
        ss += __shfl_xor(ss, 1); ss += __shfl_xor(ss, 2); ss += __shfl_xor(ss, 4); ss += __shfl_xor(ss, 8);
        const float rs = 1.0f / sqrtf(ss * (1.f / 128.f) + 1e-6f);
        v4u o; o.x = pk2(y[0] * rs * e[0], y[1] * rs * e[1]); o.y = pk2(y[2] * rs * e[2], y[3] * rs * e[3]); o.z = pk2(y[4] * rs * e[4], y[5] * rs * e[5]); o.w = pk2(y[6] * rs * e[6], y[7] * rs * e[7]);
        *(v4u*)(Y + (size_t)m * 512 + lane * 8) = o;
    }
}
constexpr size_t GDN_QP = 72 * MiB, GDN_MM = 88 * MiB, GDN_NN = 120 * MiB, GDN_E = 152 * MiB;
constexpr int P128 = 136;
__device__ __forceinline__ void m1_gdn(KArgs a, int L, int item, LAS unsigned char* lds, int tid) {
    const int lane = tid & 63, wave = tid >> 6, g = lane >> 4, n = lane & 15, h = item & 3, bc = item >> 2, c = bc & 63, tok0 = bc * 64;
    unsigned char* R = a->ws + WS_R;
    const bf16* hg = (const bf16*)R; bf16* QPg = (bf16*)(R + GDN_QP) + (size_t)item * 8192; bf16* MMg = (bf16*)(R + GDN_MM) + (size_t)item * 16384; bf16* NNg = (bf16*)(R + GDN_NN) + (size_t)item * 16384;
    bf16* E = (bf16*)(R + GDN_E); bf16* Y = (bf16*)(a->ws + WS_O) + (size_t)2 * M * 512;
    LAS bf16* KN = (LAS bf16*)lds; LAS bf16* QN = (LAS bf16*)(lds + 17408); LAS bf16* KNT = (LAS bf16*)(lds + 34816); LAS bf16* VT = (LAS bf16*)(lds + 53248); LAS bf16* KHT = (LAS bf16*)(lds + 71680);
    LAS bf16* S = (LAS bf16*)(lds + 90112); LAS bf16* ST = (LAS bf16*)(lds + 99328); LAS bf16* ATT = (LAS bf16*)(lds + 108544); LAS bf16* S2 = (LAS bf16*)(lds + 117760); LAS bf16* S2T = (LAS bf16*)(lds + 126976);
    LAS bf16* P = (LAS bf16*)(lds + 136192); LAS float* GC = (LAS float*)(lds + 145408); LAS float* BETA = GC + 64;
    LAS bf16* RAW = S;
    LAS bf16* WT = KN; LAS bf16* UT = S2;
    for (int ch = tid; ch < 67 * 48; ch += NTHREADS) {
        const int rr = ch / 48, cc = (ch % 48) * 8;
        const int sc = cc < 128 ? h * 128 + cc : (cc < 256 ? 512 + h * 128 + (cc - 128) : 1024 + h * 128 + (cc - 256));
        v4u val = {0u, 0u, 0u, 0u};
        if (c * 64 - 3 + rr >= 0) val = *(const v4u*)(hg + (size_t)(tok0 - 3 + rr) * LD_GDN + sc);
        *(LAS v4u*)(RAW + rr * 384 + cc) = val;
    }
    if (tid < 64) {
        const size_t ro = (size_t)(tok0 + tid) * LD_GDN;
        const float ai = b2f(hg[ro + 1536 + h]), bi = b2f(hg[ro + 1540 + h]);
        float v = -__expf(a->in[23][L * 4 + h]) * softplusf_(ai + a->in[24][L * 4 + h]);
#pragma unroll
        for (int off = 1; off < 64; off <<= 1) { const float u = __shfl_up(v, off); if (lane >= off) v += u; }
        GC[tid] = v; BETA[tid] = sigmoidf_(bi);
    }
    __syncthreads();
    {
        const float gend = GC[63]; const float* cw = a->in[22] + (size_t)L * 4 * 1536;
        float cwq[2][4], cwk[2][4], cwv[2][4];
#pragma unroll
        for (int u = 0; u < 2; ++u)
#pragma unroll
            for (int i = 0; i < 4; ++i) { const int d = lane + 64 * u; cwq[u][i] = cw[i * 1536 + h * 128 + d]; cwk[u][i] = cw[i * 1536 + 512 + h * 128 + d]; cwv[u][i] = cw[i * 1536 + 1024 + h * 128 + d]; }
        const float ng0 = a->in[25][L * 128 + lane], ng1 = a->in[25][L * 128 + 64 + lane];
#pragma unroll 1
        for (int tt = 0; tt < 8; ++tt) {
            const int t = wave * 8 + tt; const float gct = GC[t];
            float q[2], k[2], v[2];
#pragma unroll
            for (int u = 0; u < 2; ++u) { const int d = lane + 64 * u; float sq = 0.f, sk = 0.f, sv = 0.f;
#pragma unroll
                for (int i = 0; i < 4; ++i) { const LAS bf16* rp = RAW + (t + i) * 384 + d; sq += cwq[u][i] * b2f(rp[0]); sk += cwk[u][i] * b2f(rp[128]); sv += cwv[u][i] * b2f(rp[256]); }
                q[u] = sq * sigmoidf_(sq); k[u] = sk * sigmoidf_(sk); v[u] = sv * sigmoidf_(sv); }
            const float rq = (1.0f / sqrtf(wave_sum(q[0] * q[0] + q[1] * q[1]) + 1e-6f)) * 0.08838834764831845f, rk = 1.0f / sqrtf(wave_sum(k[0] * k[0] + k[1] * k[1]) + 1e-6f);
            const float eg = __expf(gct), eh = __expf(gend - gct);
#pragma unroll
            for (int u = 0; u < 2; ++u) { const int d = lane + 64 * u; const float kn = k[u] * rk, qn = q[u] * rq; const bf16 kb = (bf16)f2bf(kn);
                KN[t * P128 + d] = kb; KNT[d * P64 + t] = kb; QN[t * P128 + d] = (bf16)f2bf(qn); KHT[d * P64 + t] = (bf16)f2bf(kn * eh); VT[d * P64 + t] = (bf16)f2bf(v[u]);
                QPg[t * 128 + kperm(d)] = (bf16)f2bf(qn * eg);
                const float gt = b2f(hg[(size_t)(tok0 + t) * LD_GDN + 1544 + h * 128 + d]);
                E[(size_t)(tok0 + t) * 512 + h * 128 + d] = (bf16)f2bf((u ? ng1 : ng0) * gt * sigmoidf_(gt)); }
        }
    }
    __syncthreads();
#pragma unroll
    for (int i = 0; i < 4; ++i) {
        const int idx = wave * 4 + i, kind = idx >> 4, T = (idx >> 2) & 3, Sx = idx & 3;
        f32x4 acc = {0.f, 0.f, 0.f, 0.f};
        if (Sx <= T) acc = mm16<128>(acc, (kind ? QN : KN) + 16 * T * P128, P128, KN + 16 * Sx * P128, P128, lane);
        const int s = 16 * Sx + n; const float gs = GC[s];
#pragma unroll
        for (int r = 0; r < 4; ++r) { const int t = 16 * T + 4 * g + r; const float dec = __expf(fminf(GC[t] - gs, 0.f));
            acc[r] = kind ? (s <= t ? acc[r] * dec : 0.f) : (s < t ? -BETA[t] * acc[r] * dec : 0.f); }
        if (kind) storeR(ATT, P64, 16 * T, 16 * Sx, acc, lane);
        else { storeR(S, P64, 16 * T, 16 * Sx, acc, lane); storeT(ST, P64, 16 * T, 16 * Sx, acc, lane); }
    }
    __syncthreads();
    for (int e = tid; e < 4096; e += NTHREADS) { const int t = e >> 6, s = e & 63; P[t * P64 + s] = (bf16)f2bf((t == s ? 1.f : 0.f) + b2f(S[t * P64 + s])); }
    __syncthreads();
    {
        LAS bf16* cur = S; LAS bf16* curT = ST; LAS bf16* nxt = S2; LAS bf16* nxtT = S2T;
#pragma unroll 1
        for (int k = 0; k < 5; ++k) {
#pragma unroll
            for (int i = 0; i < 2; ++i) { const int idx = wave * 2 + i, T = idx >> 2, Sx = idx & 3; f32x4 acc = {0.f, 0.f, 0.f, 0.f};
                acc = mm16<64>(acc, cur + 16 * T * P64, P64, curT + 16 * Sx * P64, P64, lane);
                storeR(nxt, P64, 16 * T, 16 * Sx, acc, lane); storeT(nxtT, P64, 16 * T, 16 * Sx, acc, lane); }
            __syncthreads();
            f32x4 pacc[2];
#pragma unroll
            for (int i = 0; i < 2; ++i) { const int idx = wave * 2 + i, T = idx >> 2, Sx = idx & 3;
#pragma unroll
                for (int r = 0; r < 4; ++r) pacc[i][r] = b2f(P[(16 * T + 4 * g + r) * P64 + 16 * Sx + n]);
                pacc[i] = mm16<64>(pacc[i], P + 16 * T * P64, P64, nxtT + 16 * Sx * P64, P64, lane); }
            __syncthreads();
#pragma unroll
            for (int i = 0; i < 2; ++i) { const int idx = wave * 2 + i, T = idx >> 2, Sx = idx & 3; storeR(P, P64, 16 * T, 16 * Sx, pacc[i], lane); }
            __syncthreads();
            LAS bf16* t0 = cur; cur = nxt; nxt = t0; LAS bf16* t1 = curT; curT = nxtT; nxtT = t1;
        }
    }
    for (int e = tid; e < 4096; e += NTHREADS) { const int t = e >> 6, s = e & 63; const float p = b2f(P[t * P64 + s]) * BETA[s]; S[t * P64 + s] = (bf16)f2bf(p * __expf(GC[s])); ST[t * P64 + s] = (bf16)f2bf(p); }
    __syncthreads();
#pragma unroll
    for (int i = 0; i < 8; ++i) {
        const int idx = wave * 8 + i, kind = idx >> 5, T = (idx >> 3) & 3, Dt = idx & 7;
        f32x4 acc = {0.f, 0.f, 0.f, 0.f};
        acc = mm16<64>(acc, (kind ? ST : S) + 16 * T * P64, P64, (kind ? VT : KNT) + 16 * Dt * P64, P64, lane);
        storeT(kind ? UT : WT, P64, 16 * T, 16 * Dt, acc, lane);
    }
    __syncthreads();
    const float egend = __expf(GC[63]);
#pragma unroll
    for (int i = 0; i < 8; ++i) {
        const int idx = wave * 8 + i, kind = idx >> 5, Dt = (idx >> 2) & 7, T = idx & 3;
        f32x4 acc = {0.f, 0.f, 0.f, 0.f};
        acc = mm16<64>(acc, (kind ? UT : WT) + 16 * Dt * P64, P64, ATT + 16 * T * P64, P64, lane);
        const int t = 16 * T + n;
        if (kind) *(u32x2*)(Y + (size_t)(tok0 + t) * 512 + h * 128 + 16 * Dt + 4 * g) = pack4(acc);
        else { bf16* qp = QPg + t * 128 + (Dt >> 1) * 32 + 8 * g + 4 * (Dt & 1); const f32x4 q0 = unpack4(*(const u32x2*)qp); *(u32x2*)qp = pack4(q0 - acc); }
    }
#pragma unroll
    for (int i = 0; i < 16; ++i) {
        const int idx = wave * 16 + i, kind = idx >> 6, A8 = (idx >> 3) & 7, B8 = idx & 7;
        f32x4 acc = {0.f, 0.f, 0.f, 0.f};
        if (kind == 0) {
            acc = mm16<64>(acc, WT + 16 * A8 * P64, P64, KHT + 16 * B8 * P64, P64, lane);
            const int ip = 16 * B8 + n;
#pragma unroll
            for (int r = 0; r < 4; ++r) acc[r] = ((16 * A8 + 4 * g + r) == ip ? egend : 0.f) - acc[r];
            *(u32x2*)(MMg + ip * 128 + (A8 >> 1) * 32 + 8 * g + 4 * (A8 & 1)) = pack4(acc);
        } else {
            acc = mm16<64>(acc, KHT + 16 * A8 * P64, P64, UT + 16 * B8 * P64, P64, lane);
            *(u32x2*)(NNg + (size_t)((B8 * 8 + A8) * 64 + lane) * 4) = pack4(acc);
        }
    }
    __syncthreads();
}
__device__ __forceinline__ void m2_gdn(KArgs a, int b, int h, LAS unsigned char* lds, int tid) {
    const int lane = tid & 63, J = tid >> 6, g = lane >> 4, n = lane & 15;
    unsigned char* R = a->ws + WS_R;
    const bf16* QPb = (const bf16*)(R + GDN_QP); const bf16* MMb = (const bf16*)(R + GDN_MM); const bf16* NNb = (const bf16*)(R + GDN_NN); bf16* Y = (bf16*)(a->ws + WS_O) + (size_t)2 * M * 512;
    constexpr int SLOT = 52224;
    f32x4 H[8];
#pragma unroll
    for (int I = 0; I < 8; ++I) H[I] = (f32x4){0.f, 0.f, 0.f, 0.f};
    v4u pre[6]; u32x2 nn[8], nnn[8], yi[4], yin[4];
#define GDN_GLOAD(c, PRE, NNv, YI) do { const int item_ = (b * 64 + (c)) * 4 + h; \
        _Pragma("unroll") for (int u = 0; u < 6; ++u) { const int ch = tid + 512 * u; PRE[u] = ch < 2048 ? *(const v4u*)(MMb + (size_t)item_ * 16384 + ch * 8) : *(const v4u*)(QPb + (size_t)item_ * 8192 + (ch - 2048) * 8); } \
        _Pragma("unroll") for (int I = 0; I < 8; ++I) NNv[I] = *(const u32x2*)(NNb + (size_t)item_ * 16384 + (size_t)((J * 8 + I) * 64 + lane) * 4); \
        _Pragma("unroll") for (int T = 0; T < 4; ++T) YI[T] = *(const u32x2*)(Y + (size_t)((b * 64 + (c)) * 64 + 16 * T + n) * 512 + h * 128 + 16 * J + 4 * g); } while (0)
#define GDN_LWRITE(slot, PRE) do { LAS unsigned char* base_ = lds + (slot) * SLOT; \
        _Pragma("unroll") for (int u = 0; u < 6; ++u) { const int ch = tid + 512 * u; const int cq = ch < 2048 ? ch : ch - 2048; \
            *(LAS v4u*)(base_ + (ch < 2048 ? 0 : 34816) + (cq >> 4) * (P128 * 2) + (cq & 15) * 16) = PRE[u]; } } while (0)
    GDN_GLOAD(0, pre, nn, yi);
    GDN_LWRITE(0, pre);
    __syncthreads();
#pragma unroll 1
    for (int c = 0; c < 64; ++c) {
        if (c + 1 < 64) GDN_GLOAD(c + 1, pre, nnn, yin);
        const LAS bf16* MMs = (const LAS bf16*)(lds + (c & 1) * SLOT); const LAS bf16* QPs = (const LAS bf16*)(lds + (c & 1) * SLOT + 34816);
        bf16x8 bH[4];
#pragma unroll
        for (int s = 0; s < 4; ++s) bH[s] = frag_of(H[2 * s], H[2 * s + 1]);
#pragma unroll
        for (int T = 0; T < 4; ++T) {
            f32x4 acc = unpack4(yi[T]);
#pragma unroll
            for (int s = 0; s < 4; ++s) acc = mfma16(bH[s], *(const LAS bf16x8*)(QPs + (16 * T + n) * P128 + 32 * s + 8 * g), acc);
            *(u32x2*)(Y + (size_t)((b * 64 + c) * 64 + 16 * T + n) * 512 + h * 128 + 16 * J + 4 * g) = pack4(acc);
        }
#pragma unroll
        for (int I = 0; I < 8; ++I) {
            f32x4 acc = unpack4(nn[I]);
#pragma unroll
            for (int s = 0; s < 4; ++s) acc = mfma16(*(const LAS bf16x8*)(MMs + (16 * I + n) * P128 + 32 * s + 8 * g), bH[s], acc);
            H[I] = acc;
        }
        if (c + 1 < 64) GDN_LWRITE((c + 1) & 1, pre);
        __syncthreads();
#pragma unroll
        for (int I = 0; I < 8; ++I) nn[I] = nnn[I];
#pragma unroll
        for (int T = 0; T < 4; ++T) yi[T] = yin[T];
    }
#undef GDN_GLOAD
#undef GDN_LWRITE
}
constexpr size_t RW_RP = 64 * MiB, RW_MM = 80 * MiB, RW_NN = 96 * MiB, RW_E1 = 112 * MiB, RW_E2 = 128 * MiB, RW_DC = 144 * MiB;
constexpr int P160 = 168;
template <int K> __device__ __forceinline__ f32x4 mm16g(f32x4 acc, const LAS bf16* Ap, int pa, const bf16* Bg, int pbg, int lane) {
    const LAS bf16* a = Ap + (lane & 15) * pa + 8 * (lane >> 4); const bf16* b = Bg + (size_t)(lane & 15) * pbg + 8 * (lane >> 4);
#pragma unroll
    for (int kk = 0; kk < K; kk += 32) acc = mfma16(*(const LAS bf16x8*)(a + kk), *(const bf16x8*)(b + kk), acc);
    return acc;
}
__device__ __forceinline__ void tri_inv(LAS bf16* S, LAS bf16* ST, LAS bf16* S2, LAS bf16* S2T, LAS bf16* P, int wave, int lane, int tid) {
    const int g = lane >> 4, n = lane & 15;
    for (int e = tid; e < 4096; e += NTHREADS) { const int t = e >> 6, s = e & 63; P[t * P64 + s] = (bf16)f2bf((t == s ? 1.f : 0.f) + b2f(S[t * P64 + s])); }
    __syncthreads();
    LAS bf16* cur = S; LAS bf16* curT = ST; LAS bf16* nxt = S2; LAS bf16* nxtT = S2T;
#pragma unroll 1
    for (int k = 0; k < 5; ++k) {
#pragma unroll
        for (int i = 0; i < 2; ++i) { const int idx = wave * 2 + i, T = idx >> 2, Sx = idx & 3; f32x4 acc = {0.f, 0.f, 0.f, 0.f};
            acc = mm16<64>(acc, cur + 16 * T * P64, P64, curT + 16 * Sx * P64, P64, lane);
            storeR(nxt, P64, 16 * T, 16 * Sx, acc, lane); storeT(nxtT, P64, 16 * T, 16 * Sx, acc, lane); }
        __syncthreads();
        f32x4 pacc[2];
#pragma unroll
        for (int i = 0; i < 2; ++i) { const int idx = wave * 2 + i, T = idx >> 2, Sx = idx & 3;
#pragma unroll
            for (int r = 0; r < 4; ++r) pacc[i][r] = b2f(P[(16 * T + 4 * g + r) * P64 + 16 * Sx + n]);
            pacc[i] = mm16<64>(pacc[i], P + 16 * T * P64, P64, nxtT + 16 * Sx * P64, P64, lane); }
        __syncthreads();
#pragma unroll
        for (int i = 0; i < 2; ++i) { const int idx = wave * 2 + i, T = idx >> 2, Sx = idx & 3; storeR(P, P64, 16 * T, 16 * Sx, pacc[i], lane); }
        __syncthreads();
        LAS bf16* t0 = cur; cur = nxt; nxt = t0; LAS bf16* t1 = curT; curT = nxtT; nxtT = t1;
    }
}
__device__ __forceinline__ void m1_rw(KArgs a, int L, int item, LAS unsigned char* lds, int tid) {
    const int lane = tid & 63, wave = tid >> 6, g = lane >> 4, n = lane & 15, h = item & 7, bc = item >> 3, c = bc & 63, tok0 = bc * 64;
    unsigned char* R = a->ws + WS_R; unsigned char* wb = a->ws + WS_W;
    const bf16* hr = (const bf16*)R; bf16* RPg = (bf16*)(R + RW_RP) + (size_t)item * 4096; bf16* MMg = (bf16*)(R + RW_MM) + (size_t)item * 4096; bf16* NNg = (bf16*)(R + RW_NN) + (size_t)item * 4096;
    bf16* E1 = (bf16*)(R + RW_E1); bf16* E2 = (bf16*)(R + RW_E2); bf16* Y = (bf16*)(a->ws + WS_O); float* DCg = (float*)(R + RW_DC) + (size_t)item * 64;
    const float* mu = a->in[8] + L * 1824;
    LAS bf16* ATr = (LAS bf16*)lds; LAS bf16* BTr = ATr + 64 * P64; LAS bf16* KTr = BTr + 64 * P64; LAS bf16* RTr = KTr + 64 * P64;
    LAS bf16* ATt = RTr + 64 * P64; LAS bf16* VTt = ATt + 64 * P64; LAS bf16* BHt = VTt + 64 * P64; LAS bf16* KHt = BHt + 64 * P64;
    LAS bf16* S = KHt + 64 * P64; LAS bf16* ST = S + 64 * P64; LAS bf16* S2 = ST + 64 * P64; LAS bf16* S2T = S2 + 64 * P64; LAS bf16* P = S2T + 64 * P64;
    LAS bf16* AAK = P + 64 * P64; LAS bf16* ARB = AAK + 64 * P64; LAS bf16* ARK = ARB + 64 * P64;
    LAS bf16* WT = ATr; LAS bf16* UT = BTr; LAS bf16* XT = KTr;
    LAS bf16* TW = S; LAS bf16* AL = ST; LAS bf16* GL = S2;
    LAS float* LW = (LAS float*)(lds + 73728 + 39936); LAS float* ASIG = LW + 4096;
    for (int ch = tid; ch < 64 * 36; ch += NTHREADS) {
        const int t = ch / 36, cc = (ch % 36) * 8; const size_t ro = (size_t)(tok0 + t) * LD_RW + 1536 + cc;
        const v4u cw = *(const v4u*)(hr + ro); v4u pw = {0u, 0u, 0u, 0u};
        if (c * 64 + t > 0) pw = *(const v4u*)(hr + ro - LD_RW);
        const unsigned cu[4] = {cw.x, cw.y, cw.z, cw.w}, pu[4] = {pw.x, pw.y, pw.z, pw.w};
#pragma unroll
        for (int e = 0; e < 8; ++e) {
            const float cur = (e & 1) ? __uint_as_float(cu[e >> 1] & 0xffff0000u) : __uint_as_float(cu[e >> 1] << 16), prv = (e & 1) ? __uint_as_float(pu[e >> 1] & 0xffff0000u) : __uint_as_float(pu[e >> 1] << 16);
            const int col = cc + e; const float xs = cur + (prv - cur) * mu[1536 + col];
            if (col < 64) TW[t * P64 + col] = (bf16)f2bf(tanhf_(xs)); else if (col < 128) AL[t * P64 + col - 64] = (bf16)f2bf(xs); else GL[t * P160 + col - 128] = (bf16)f2bf(sigmoidf_(xs));
        }
    }
    __syncthreads();
#pragma unroll
    for (int i = 0; i < 6; ++i) {
        const int idx = wave * 6 + i, kind = idx >> 4, T = (idx >> 2) & 3, Jt = idx & 3;
        f32x4 acc = {0.f, 0.f, 0.f, 0.f};
        if (kind == 0) acc = mm16g<64>(acc, TW + 16 * T * P64, P64, (const bf16*)(wb + WO_RW2T) + (size_t)(h * 64 + 16 * Jt) * 64, 64, lane);
        else if (kind == 1) acc = mm16g<64>(acc, AL + 16 * T * P64, P64, (const bf16*)(wb + WO_RA2T) + (size_t)(h * 64 + 16 * Jt) * 64, 64, lane);
        else acc = mm16g<160>(acc, GL + 16 * T * P160, P160, (const bf16*)(wb + WO_RG2T) + (size_t)(h * 64 + 16 * Jt) * 160, 160, lane);
        const int j = 16 * Jt + n, hj = L * 512 + h * 64 + j;
#pragma unroll
        for (int r = 0; r < 4; ++r) { const int t = 16 * T + 4 * g + r;
            if (kind == 0) { const float w = acc[r] + a->in[9][hj]; LW[t * 64 + j] = -__expf(-softplusf_(-w) - 0.5f); }
            else if (kind == 1) ASIG[t * 64 + j] = sigmoidf_(acc[r] + a->in[11][hj]);
            else E1[(size_t)(tok0 + t) * 512 + h * 64 + j] = (bf16)f2bf(acc[r]); }
    }
    __syncthreads();
    if (tid < 64) { float run = 0.f; for (int t = 0; t < 64; ++t) { run += LW[t * 64 + tid]; LW[t * 64 + tid] = run; } }
    __syncthreads();
    {
        const int hj = L * 512 + h * 64 + lane;
        const float kkj = a->in[14][hj], kaj = a->in[15][hj], rkj = a->in[16][hj], gngj = a->in[17][hj], gnbj = a->in[18][hj];
        const float mur = mu[h * 64 + lane], muk = mu[512 + h * 64 + lane], muv = mu[1024 + h * 64 + lane];
        const float cend = LW[63 * 64 + lane];
        if (wave == 0) DCg[lane] = __expf(cend);
#pragma unroll 1
        for (int tt = 0; tt < 8; ++tt) {
            const int t = wave * 8 + tt; const size_t ro = (size_t)(tok0 + t) * LD_RW + h * 64 + lane; const bool hp = (c * 64 + t) > 0;
            const float rc = b2f(hr[ro]), kc = b2f(hr[ro + 512]), vc = b2f(hr[ro + 1024]);
            const float rp = hp ? b2f(hr[ro - LD_RW]) : 0.f, kp = hp ? b2f(hr[ro + 512 - LD_RW]) : 0.f, vp = hp ? b2f(hr[ro + 1024 - LD_RW]) : 0.f;
            const float r = rc + (rp - rc) * mur, kr = kc + (kp - kc) * muk, v = vc + (vp - vc) * muv;
            const float C = LW[t * 64 + lane], Cm = t > 0 ? LW[(t - 1) * 64 + lane] : 0.f, asig = ASIG[t * 64 + lane];
            const float kkr = kr * kkj, kk = kkr * (1.0f / sqrtf(wave_sum(kkr * kkr) + 1e-6f));
            const float k2 = kr * (1.f + (asig - 1.f) * kaj), av = -kk, bv = kk * asig;
            const float bon = wave_sum(r * k2 * rkj) * v;
            const float eC = __expf(C), eCm = __expf(Cm), eN = __expf(-C), eE = __expf(cend - C);
            const bf16 ab = (bf16)f2bf(av * eCm), rb = (bf16)f2bf(r * eC);
            ATr[t * P64 + lane] = ab; ATt[lane * P64 + t] = ab; BTr[t * P64 + lane] = (bf16)f2bf(bv * eN); KTr[t * P64 + lane] = (bf16)f2bf(k2 * eN); RTr[t * P64 + lane] = rb;
            VTt[lane * P64 + t] = (bf16)f2bf(v); BHt[lane * P64 + t] = (bf16)f2bf(bv * eE); KHt[lane * P64 + t] = (bf16)f2bf(k2 * eE);
            RPg[t * 64 + kperm(lane)] = rb;
            const size_t eo = (size_t)(tok0 + t) * 512 + h * 64 + lane; const float gg = b2f(E1[eo]);
            E1[eo] = (bf16)f2bf(gngj * gg); E2[eo] = (bf16)f2bf((gnbj + bon) * gg);
        }
    }
    __syncthreads();
#pragma unroll
    for (int i = 0; i < 8; ++i) {
        const int idx = wave * 8 + i, kind = idx >> 4, T = (idx >> 2) & 3, Sx = idx & 3;
        f32x4 acc = {0.f, 0.f, 0.f, 0.f};
        if (Sx <= T) acc = mm16<64>(acc, ((kind & 2) ? RTr : ATr) + 16 * T * P64, P64, ((kind & 1) ? KTr : BTr) + 16 * Sx * P64, P64, lane);
        const int s = 16 * Sx + n;
#pragma unroll
        for (int r = 0; r < 4; ++r) { const int t = 16 * T + 4 * g + r; if ((kind & 2) ? (s > t) : (s >= t)) acc[r] = 0.f; }
        if (kind == 0) { storeR(S, P64, 16 * T, 16 * Sx, acc, lane); storeT(ST, P64, 16 * T, 16 * Sx, acc, lane); }
        else storeR(kind == 1 ? AAK : (kind == 2 ? ARB : ARK), P64, 16 * T, 16 * Sx, acc, lane);
    }
    __syncthreads();
    tri_inv(S, ST, S2, S2T, P, wave, lane, tid);
#pragma unroll
    for (int i = 0; i < 4; ++i) {
        const int idx = wave * 4 + i, kind = idx >> 4, T = (idx >> 2) & 3, Dt = idx & 3;
        f32x4 acc = {0.f, 0.f, 0.f, 0.f};
        acc = mm16<64>(acc, (kind ? P : AAK) + 16 * T * P64, P64, (kind ? ATt : VTt) + 16 * Dt * P64, P64, lane);
        storeT(kind ? WT : XT, P64, 16 * T, 16 * Dt, acc, lane);
    }
    __syncthreads();
#pragma unroll
    for (int i = 0; i < 2; ++i) {
        const int idx = wave * 2 + i, T = idx >> 2, Dt = idx & 3;
        f32x4 acc = {0.f, 0.f, 0.f, 0.f};
        acc = mm16<64>(acc, P + 16 * T * P64, P64, XT + 16 * Dt * P64, P64, lane);
        storeT(UT, P64, 16 * T, 16 * Dt, acc, lane);
    }
    __syncthreads();
#pragma unroll
    for (int i = 0; i < 8; ++i) {
        const int idx = wave * 8 + i, kind = idx >> 4, A4 = (idx >> 2) & 3, B4 = idx & 3;
        f32x4 acc = {0.f, 0.f, 0.f, 0.f};
        if (kind == 0) {
            acc = mm16<64>(acc, WT + 16 * A4 * P64, P64, ARB + 16 * B4 * P64, P64, lane);
            bf16* rp = RPg + (16 * B4 + n) * 64 + (A4 >> 1) * 32 + 8 * g + 4 * (A4 & 1); const f32x4 r0 = unpack4(*(const u32x2*)rp); *(u32x2*)rp = pack4(r0 + acc);
        } else if (kind == 1) {
            acc = mm16<64>(acc, UT + 16 * A4 * P64, P64, ARB + 16 * B4 * P64, P64, lane);
            acc = mm16<64>(acc, VTt + 16 * A4 * P64, P64, ARK + 16 * B4 * P64, P64, lane);
            *(u32x2*)(Y + (size_t)(tok0 + 16 * B4 + n) * 512 + h * 64 + 16 * A4 + 4 * g) = pack4(acc);
        } else if (kind == 2) {
            acc = mm16<64>(acc, WT + 16 * A4 * P64, P64, BHt + 16 * B4 * P64, P64, lane);
            const int ip = 16 * B4 + n; const float dc = DCg[ip];
#pragma unroll
            for (int r = 0; r < 4; ++r) if (16 * A4 + 4 * g + r == ip) acc[r] += dc;
            *(u32x2*)(MMg + ip * 64 + (A4 >> 1) * 32 + 8 * g + 4 * (A4 & 1)) = pack4(acc);
        } else {
            acc = mm16<64>(acc, BHt + 16 * A4 * P64, P64, UT + 16 * B4 * P64, P64, lane);
            acc = mm16<64>(acc, KHt + 16 * A4 * P64, P64, VTt + 16 * B4 * P64, P64, lane);
            *(u32x2*)(NNg + (size_t)((B4 * 4 + A4) * 64 + lane) * 4) = pack4(acc);
        }
    }
    __syncthreads();
}
__device__ __forceinline__ void m2_rw(KArgs a, int b, int h, int tid) {
    const int lane = tid & 63, J = tid >> 6, g = lane >> 4, n = lane & 15;
    if (J >= 4) return;
    unsigned char* R = a->ws + WS_R;
    const bf16* RPb = (const bf16*)(R + RW_RP); const bf16* MMb = (const bf16*)(R + RW_MM); const bf16* NNb = (const bf16*)(R + RW_NN); bf16* Y = (bf16*)(a->ws + WS_O);
    f32x4 H[4];
#pragma unroll
    for (int I = 0; I < 4; ++I) H[I] = (f32x4){0.f, 0.f, 0.f, 0.f};
    bf16x8 bq[4][2], bqn[4][2];
#define RW_LOAD(c, BQ) do { const bf16* rp_ = RPb + (size_t)((b * 64 + (c)) * 8 + h) * 4096 + n * 64 + 8 * g; \
        _Pragma("unroll") for (int T = 0; T < 4; ++T) { _Pragma("unroll") for (int s = 0; s < 2; ++s) BQ[T][s] = *(const bf16x8*)(rp_ + T * 1024 + 32 * s); } } while (0)
    RW_LOAD(0, bq);
#pragma unroll 1
    for (int c = 0; c < 64; ++c) {
        const int item = (b * 64 + c) * 8 + h;
        bf16x8 am[4][2]; u32x2 yi[4], nn[4];
        { const bf16* mp_ = MMb + (size_t)item * 4096 + n * 64 + 8 * g; bf16* yp_ = Y + (size_t)((b * 64 + c) * 64 + n) * 512 + h * 64 + 16 * J + 4 * g; const bf16* np_ = NNb + (size_t)item * 4096 + (size_t)(J * 4 * 64 + lane) * 4;
#pragma unroll
          for (int T = 0; T < 4; ++T) { am[T][0] = *(const bf16x8*)(mp_ + T * 1024); am[T][1] = *(const bf16x8*)(mp_ + T * 1024 + 32); yi[T] = *(const u32x2*)(yp_ + (size_t)T * 16 * 512); nn[T] = *(const u32x2*)(np_ + T * 256); } }
        if (c + 1 < 64) RW_LOAD(c + 1, bqn);
        const bf16x8 h0 = frag_of(H[0], H[1]), h1 = frag_of(H[2], H[3]);
#pragma unroll
        for (int T = 0; T < 4; ++T) {
            f32x4 acc = {0.f, 0.f, 0.f, 0.f};
            acc = mfma16(h0, bq[T][0], acc); acc = mfma16(h1, bq[T][1], acc);
            *(u32x2*)(Y + (size_t)((b * 64 + c) * 64 + 16 * T + n) * 512 + h * 64 + 16 * J + 4 * g) = pack4(acc + unpack4(yi[T]));
        }
#pragma unroll
        for (int I = 0; I < 4; ++I) { f32x4 acc = {0.f, 0.f, 0.f, 0.f}; acc = mfma16(am[I][0], h0, acc); acc = mfma16(am[I][1], h1, acc); H[I] = acc + unpack4(nn[I]); }
#pragma unroll
        for (int T = 0; T < 4; ++T) { bq[T][0] = bqn[T][0]; bq[T][1] = bqn[T][1]; }
    }
#undef RW_LOAD
}
__device__ __forceinline__ void m3_rw(bf16* Y, const bf16* E1, const bf16* E2, int gw, int NGW, int lane) {
    for (int m = gw; m < M; m += NGW) {
        const v4u yw = *(const v4u*)(Y + (size_t)m * 512 + lane * 8), e1w = *(const v4u*)(E1 + (size_t)m * 512 + lane * 8), e2w = *(const v4u*)(E2 + (size_t)m * 512 + lane * 8);
        const unsigned yu[4] = {yw.x, yw.y, yw.z, yw.w}, e1u[4] = {e1w.x, e1w.y, e1w.z, e1w.w}, e2u[4] = {e2w.x, e2w.y, e2w.z, e2w.w};
        float y[8], e1[8], e2[8];
#pragma unroll
        for (int i = 0; i < 4; ++i) { y[2 * i] = __uint_as_float(yu[i] << 16); y[2 * i + 1] = __uint_as_float(yu[i] & 0xffff0000u); e1[2 * i] = __uint_as_float(e1u[i] << 16); e1[2 * i + 1] = __uint_as_float(e1u[i] & 0xffff0000u);
            e2[2 * i] = __uint_as_float(e2u[i] << 16); e2[2 * i + 1] = __uint_as_float(e2u[i] & 0xffff0000u); }
        float sm = 0.f;
#pragma unroll
        for (int i = 0; i < 8; ++i) sm += y[i];
        sm += __shfl_xor(sm, 1); sm += __shfl_xor(sm, 2); sm += __shfl_xor(sm, 4);
        const float mean = sm * (1.f / 64.f); float sq = 0.f;
#pragma unroll
        for (int i = 0; i < 8; ++i) { y[i] -= mean; sq += y[i] * y[i]; }
        sq += __shfl_xor(sq, 1); sq += __shfl_xor(sq, 2); sq += __shfl_xor(sq, 4);
        const float rs = 1.0f / sqrtf(sq * (1.f / 64.f) + 64e-5f);
        v4u o; o.x = pk2(y[0] * rs * e1[0] + e2[0], y[1] * rs * e1[1] + e2[1]); o.y = pk2(y[2] * rs * e1[2] + e2[2], y[3] * rs * e1[3] + e2[3]);
        o.z = pk2(y[4] * rs * e1[4] + e2[4], y[5] * rs * e1[5] + e2[5]); o.w = pk2(y[6] * rs * e1[6] + e2[6], y[7] * rs * e1[7] + e2[7]);
        *(v4u*)(Y + (size_t)m * 512 + lane * 8) = o;
    }
}
constexpr size_t RW_HS = 0, GLA_HS = 0, GDN_HS = 0;
__device__ __forceinline__ void scan_rw(KArgs a, int b, int h, int tid) {
    const int lane = tid & 63, J = tid >> 6, g = lane >> 4, n = lane & 15;
    if (J >= 4) return;
    unsigned char* R = a->ws + WS_R;
    const bf16* MMb = (const bf16*)(R + RW_MM); const bf16* NNb = (const bf16*)(R + RW_NN); bf16* HSb = (bf16*)(R + RW_HS);
    f32x4 H[4];
#pragma unroll
    for (int I = 0; I < 4; ++I) H[I] = (f32x4){0.f, 0.f, 0.f, 0.f};
    bf16x8 am[4][4][2]; u32x2 nn[4][4];
#define SRW_LOAD(c, u) do { const int item_ = (b * 64 + (c)) * 8 + h; const bf16* mp_ = MMb + (size_t)item_ * 4096 + n * 64 + 8 * g; const bf16* np_ = NNb + (size_t)item_ * 4096 + (size_t)(J * 4 * 64 + lane) * 4; \
        _Pragma("unroll") for (int T = 0; T < 4; ++T) { am[u][T][0] = *(const bf16x8*)(mp_ + T * 1024); am[u][T][1] = *(const bf16x8*)(mp_ + T * 1024 + 32); nn[u][T] = *(const u32x2*)(np_ + T * 256); } } while (0)
    SRW_LOAD(0, 0); SRW_LOAD(1, 1); SRW_LOAD(2, 2);
#pragma unroll 1
    for (int c4 = 0; c4 < 64; c4 += 4) {
#pragma unroll
        for (int u = 0; u < 4; ++u) {
            const int c = c4 + u;
            if (c + 3 < 64) SRW_LOAD(c + 3, (u + 3) & 3);
            const bf16x8 h0 = frag_of(H[0], H[1]), h1 = frag_of(H[2], H[3]);
            bf16* hs = HSb + (size_t)((b * 64 + c) * 8 + h) * 4096 + (16 * J + n) * 64 + 8 * g;
            *(bf16x8*)hs = h0; *(bf16x8*)(hs + 32) = h1;
#pragma unroll
            for (int I = 0; I < 4; ++I) { f32x4 acc = unpack4(nn[u][I]); acc = mfma16(am[u][I][0], h0, acc); acc = mfma16(am[u][I][1], h1, acc); H[I] = acc; }
        }
    }
#undef SRW_LOAD
}
__device__ __forceinline__ void scan_gla(KArgs a, int b, int h, int tid) {
    const int lane = tid & 63, J = tid >> 6, g = lane >> 4, n = lane & 15;
    unsigned char* R = a->ws + WS_R;
    const bf16* NNb = (const bf16*)(R + GLA_NN); const float* DECb = (const float*)(R + GLA_DEC); bf16* HSb = (bf16*)(R + GLA_HS);
    f32x4 H[4];
#pragma unroll
    for (int I = 0; I < 4; ++I) H[I] = (f32x4){0.f, 0.f, 0.f, 0.f};
    f32x4 dc[4][4]; u32x2 nn[4][4];
#define SGL_LOAD(c, u) do { const int item_ = (b * 64 + (c)) * 4 + h; \
        _Pragma("unroll") for (int I = 0; I < 4; ++I) { nn[u][I] = *(const u32x2*)(NNb + (size_t)item_ * 8192 + (size_t)((J * 4 + I) * 64 + lane) * 4); dc[u][I] = *(const f32x4*)(DECb + item_ * 64 + 16 * I + 4 * g); } } while (0)
    SGL_LOAD(0, 0); SGL_LOAD(1, 1); SGL_LOAD(2, 2);
#pragma unroll 1
    for (int c4 = 0; c4 < 64; c4 += 4) {
#pragma unroll
        for (int u = 0; u < 4; ++u) {
            const int c = c4 + u;
            if (c + 3 < 64) SGL_LOAD(c + 3, (u + 3) & 3);
            bf16* hs = HSb + (size_t)((b * 64 + c) * 4 + h) * 8192 + (16 * J + n) * 64 + 8 * g;
            *(bf16x8*)hs = frag_of(H[0], H[1]); *(bf16x8*)(hs + 32) = frag_of(H[2], H[3]);
#pragma unroll
            for (int I = 0; I < 4; ++I) H[I] = H[I] * dc[u][I] + unpack4(nn[u][I]);
        }
    }
#undef SGL_LOAD
}
__device__ __forceinline__ void scan_gdn(KArgs a, int b, int h, LAS unsigned char* lds, int tid) {
    const int lane = tid & 63, J = tid >> 6, g = lane >> 4, n = lane & 15;
    unsigned char* R = a->ws + WS_R;
    const bf16* MMb = (const bf16*)(R + GDN_MM); const bf16* NNb = (const bf16*)(R + GDN_NN); bf16* HSb = (bf16*)(R + GDN_HS);
    constexpr int SLOT = 128 * P128 * 2;
    f32x4 H[8];
#pragma unroll
    for (int I = 0; I < 8; ++I) H[I] = (f32x4){0.f, 0.f, 0.f, 0.f};
    v4u pre[2][4]; u32x2 nn[4][8];
#define SGD_MLOAD(c, v) do { const bf16* mp_ = MMb + (size_t)((b * 64 + (c)) * 4 + h) * 16384; _Pragma("unroll") for (int q_ = 0; q_ < 4; ++q_) pre[v][q_] = *(const v4u*)(mp_ + (size_t)(tid + 512 * q_) * 8); } while (0)
#define SGD_MWRITE(slot, v) do { LAS unsigned char* base_ = lds + (slot) * SLOT; _Pragma("unroll") for (int q_ = 0; q_ < 4; ++q_) { const int ch = tid + 512 * q_; *(LAS v4u*)(base_ + (ch >> 4) * (P128 * 2) + (ch & 15) * 16) = pre[v][q_]; } } while (0)
#define SGD_NLOAD(c, u) do { const bf16* np_ = NNb + (size_t)((b * 64 + (c)) * 4 + h) * 16384 + (size_t)(J * 8 * 64 + lane) * 4; _Pragma("unroll") for (int I = 0; I < 8; ++I) nn[u][I] = *(const u32x2*)(np_ + I * 256); } while (0)
    SGD_MLOAD(0, 0); SGD_MLOAD(1, 1); SGD_NLOAD(0, 0); SGD_NLOAD(1, 1); SGD_NLOAD(2, 2);
    SGD_MWRITE(0, 0);
    __syncthreads();
#pragma unroll 1
    for (int c4 = 0; c4 < 64; c4 += 4) {
#pragma unroll
        for (int u = 0; u < 4; ++u) {
            const int c = c4 + u;
            if (c + 2 < 64) SGD_MLOAD(c + 2, u & 1);
            if (c + 3 < 64) SGD_NLOAD(c + 3, (u + 3) & 3);
            const LAS bf16* MMs = (const LAS bf16*)(lds + (c & 1) * SLOT);
            bf16x8 bH[4];
#pragma unroll
            for (int s = 0; s < 4; ++s) bH[s] = frag_of(H[2 * s], H[2 * s + 1]);
            bf16* hs = HSb + (size_t)((b * 64 + c) * 4 + h) * 16384 + (16 * J + n) * 128 + 8 * g;
#pragma unroll
            for (int s = 0; s < 4; ++s) *(bf16x8*)(hs + 32 * s) = bH[s];
#pragma unroll
            for (int I = 0; I < 8; ++I) {
                f32x4 acc = unpack4(nn[u][I]);
#pragma unroll
                for (int s = 0; s < 4; ++s) acc = mfma16(*(const LAS bf16x8*)(MMs + (16 * I + n) * P128 + 32 * s + 8 * g), bH[s], acc);
                H[I] = acc;
            }
            if (c + 1 < 64) SGD_MWRITE((c + 1) & 1, (u + 1) & 1);
            __syncthreads();
        }
    }
#undef SGD_MLOAD
#undef SGD_MWRITE
#undef SGD_NLOAD
}
template <int KIND> __device__ __forceinline__ void yout(KArgs a, int gw, int NGW, int lane) {
    constexpr int NH = KIND == 0 ? 8 : 4, CH_ = KIND == 0 ? 64 : 128, NJ = CH_ / 16, KK = KIND == 2 ? 128 : 64, NS = KK / 32;
    const int g = lane >> 4, n = lane & 15;
    unsigned char* R = a->ws + WS_R;
    const bf16* HSb = (const bf16*)(R + (KIND == 0 ? RW_HS : (KIND == 1 ? GLA_HS : GDN_HS)));
    const bf16* QPb = (const bf16*)(R + (KIND == 0 ? RW_RP : (KIND == 1 ? GLA_QP : GDN_QP)));
    const bf16* E1 = (const bf16*)(R + (KIND == 0 ? RW_E1 : (KIND == 1 ? GLA_E : GDN_E))); const bf16* E2 = (const bf16*)(R + RW_E2);
    bf16* Y = (bf16*)(a->ws + WS_O) + (size_t)KIND * M * 512;
    const int njobs = (M / 64) * NH * 4;
    for (int job = gw; job < njobs; job += NGW) {
        const int item = job >> 2, T = job & 3, h = item % NH, bc = item / NH;
        const bf16* qp = QPb + (size_t)item * (64 * KK) + (16 * T + n) * KK + 8 * g;
        const bf16* hs = HSb + (size_t)item * (CH_ * KK) + n * KK + 8 * g;
        const size_t yo = (size_t)(bc * 64 + 16 * T + n) * 512 + h * CH_ + 4 * g;
        bf16x8 bq[NS];
#pragma unroll
        for (int s = 0; s < NS; ++s) bq[s] = *(const bf16x8*)(qp + 32 * s);
        f32x4 acc[NJ];
#pragma unroll
        for (int jt = 0; jt < NJ; ++jt) {
            acc[jt] = unpack4(*(const u32x2*)(Y + yo + 16 * jt));
#pragma unroll
            for (int s = 0; s < NS; ++s) acc[jt] = mfma16(*(const bf16x8*)(hs + (size_t)jt * 16 * KK + 32 * s), bq[s], acc[jt]);
        }
        float s1 = 0.f;
        if (KIND == 0) {
#pragma unroll
            for (int jt = 0; jt < NJ; ++jt) s1 += (acc[jt][0] + acc[jt][1]) + (acc[jt][2] + acc[jt][3]);
            s1 += __shfl_xor(s1, 16); s1 += __shfl_xor(s1, 32);
            s1 *= (1.f / CH_);
        }
        float s2 = 0.f;
#pragma unroll
        for (int jt = 0; jt < NJ; ++jt) { acc[jt] = acc[jt] - s1; s2 += (acc[jt][0] * acc[jt][0] + acc[jt][1] * acc[jt][1]) + (acc[jt][2] * acc[jt][2] + acc[jt][3] * acc[jt][3]); }
        s2 += __shfl_xor(s2, 16); s2 += __shfl_xor(s2, 32);
        const float rs = 1.0f / sqrtf(s2 * (1.f / CH_) + (KIND == 0 ? 64e-5f : 1e-6f));
#pragma unroll
        for (int jt = 0; jt < NJ; ++jt) {
            f32x4 o = acc[jt] * rs * unpack4(*(const u32x2*)(E1 + yo + 16 * jt));
            if (KIND == 0) o = o + unpack4(*(const u32x2*)(E2 + yo + 16 * jt));
            *(u32x2*)(Y + yo + 16 * jt) = pack4(o);
        }
    }
}
constexpr int PH_PER_LAYER = 25, N_PHASES = 1 + DEPTH * PH_PER_LAYER;
#ifndef MK_SINGLE
#define MK_SINGLE 0
#endif
#ifndef CHUNK_GLA
#define CHUNK_GLA 1
#endif
#ifndef CHUNK_GDN
#define CHUNK_GDN 1
#endif
#ifndef CHUNK_RW
#define CHUNK_RW 1
#endif
#define XB_TMO      128
#define XB_XCNT(j)  (256  + 64 * (j))
#define XB_XSUB(j)  (1280 + 64 * (j))
#define XB_XGEN(j)  (2304 + 64 * (j))
#define XB_TOP      3328
#define XB_TOPGEN   3392
#define XB_SPIN_CAP (1u << 22)
__device__ __forceinline__ unsigned xb_ld(unsigned* p)              { return __hip_atomic_load(p, __ATOMIC_RELAXED, __HIP_MEMORY_SCOPE_AGENT); }
__device__ __forceinline__ unsigned xb_add(unsigned* p, unsigned v) { return __hip_atomic_fetch_add(p, v, __ATOMIC_RELAXED, __HIP_MEMORY_SCOPE_AGENT); }
__device__ __forceinline__ unsigned xb_xcc_id() { return (unsigned)__builtin_amdgcn_s_getreg((3 << 11) | 20) & 0xFu; }
#define XB_SPIN(cond, bar) do { unsigned _sp = 0; while (cond) { __builtin_amdgcn_s_sleep(1); \
    if ((++_sp & 255u) == 0u) { if (xb_ld(&(bar)[XB_TMO])) break; if (_sp > XB_SPIN_CAP) { atomicAdd(&(bar)[XB_TMO], 1u); break; } } } } while (0)
struct XcdBarrier { unsigned* bar; unsigned x; volatile LAS unsigned* st; };
__device__ __forceinline__ XcdBarrier xcd_barrier_post(unsigned* bar, volatile LAS unsigned* st) {
    XcdBarrier b; b.bar = bar; b.x = xb_xcc_id(); b.st = st;
    if (threadIdx.x == 0) (void)xb_add(&bar[XB_XCNT(b.x)], 1u);
    return b;
}
__device__ __forceinline__ void xcd_barrier_complete(unsigned* bar, unsigned x, unsigned& nloc, unsigned& nx) {
    const unsigned G = gridDim.x * gridDim.y * gridDim.z;
    unsigned sum, cnt, mine, sp = 0u;
    for (;;) {
        sum = 0u; cnt = 0u; mine = 0u;
#pragma unroll
        for (unsigned j = 0; j < 16; ++j) { const unsigned c = xb_ld(&bar[XB_XCNT(j)]); sum += c; cnt += (c > 0u) ? 1u : 0u; mine = (j == x) ? c : mine; }
        if (sum == G) break;
        __builtin_amdgcn_s_sleep(1);
        if ((++sp & 255u) == 0u) { if (xb_ld(&bar[XB_TMO])) break; if (sp > XB_SPIN_CAP) { atomicAdd(&bar[XB_TMO], 1u); break; } }
    }
    nloc = mine > 0u ? mine : 1u; nx = cnt > 0u ? cnt : 1u;
}
__device__ __forceinline__ void xcd_barrier(const XcdBarrier& b) {
    asm volatile("s_waitcnt vmcnt(0)" ::: "memory");
    __syncthreads();
    if (threadIdx.x == 0) {
        unsigned* bar = b.bar;
        __builtin_amdgcn_s_waitcnt(0);
        unsigned nloc = b.st[0], nx = b.st[1];
        if (nloc == 0u) { xcd_barrier_complete(bar, b.x, nloc, nx); b.st[0] = nloc; b.st[1] = nx; }
        const unsigned old = xb_add(&bar[XB_XSUB(b.x)], 1u);
        const unsigned gen = old / nloc;
        if (old + 1u == (gen + 1u) * nloc) {
            __builtin_amdgcn_fence(__ATOMIC_RELEASE, "agent");
            asm volatile("s_waitcnt vmcnt(0)" ::: "memory");
            const unsigned og = xb_add(&bar[XB_TOP], 1u);
            const unsigned tg = og / nx;
            if (og + 1u == (tg + 1u) * nx) xb_add(&bar[XB_TOPGEN], 1u);
            else XB_SPIN(xb_ld(&bar[XB_TOPGEN]) == tg, bar);
            __builtin_amdgcn_fence(__ATOMIC_ACQUIRE, "agent");
            xb_add(&bar[XB_XGEN(b.x)], 1u);
            asm volatile("s_waitcnt vmcnt(0)" ::: "memory");
        } else {
            XB_SPIN(xb_ld(&bar[XB_XGEN(b.x)]) == gen, bar);
            __builtin_amdgcn_fence(__ATOMIC_ACQUIRE, "agent");
            asm volatile("s_waitcnt vmcnt(0)" ::: "memory");
        }
    }
    __syncthreads();
}
template <int PH> __device__ __forceinline__ void run_phase(LAS unsigned char* lds) {
    constexpr int L = PH > 0 ? (PH - 1) / PH_PER_LAYER : 0, q = PH > 0 ? (PH - 1) % PH_PER_LAYER + 1 : 0, s = q >= 20 ? 1 : 0;
    const int tid = threadIdx.x, lane = tid & 63, wave = __builtin_amdgcn_readfirstlane(tid >> 6);
    const int G = gridDim.x, bid = blockIdx.x;
    KArgs ap = (KArgs)__builtin_amdgcn_kernarg_segment_ptr();
    unsigned char* ws = ap->ws; float* X = ap->out;
    const int gw = bid * NWAVES + wave, NGW = G * NWAVES;
    unsigned char* wb = ws + WS_W;
    bf16* XB = (bf16*)(ws + WS_XB);
    bf16* OB = (bf16*)(ws + WS_O);
    (void)lane; (void)gw; (void)NGW; (void)wb; (void)XB; (void)OB; (void)X; (void)s;
        if constexpr (q == 0) {
            convert_weights(ap, 0, lds, wave, lane, gw, NGW);
            for (int m = gw; m < M; m += NGW) row_pass<false>(ap->in[0] + (size_t)m * D, X + (size_t)m * D, XB + (size_t)m * D, nullptr, nullptr, lane);
        } else if constexpr (q == 1 || q == 20) {
            pg8::Gemm g{XB, (const bf16*)(wb + (s ? WO_W13_1 : WO_W13_0)), M, 5632, D}; pg8::StaticOrder S; S.init(M, 5632, G, bid);
            pg8::EpiSwiGLU E{(bf16*)(ws + WS_R), FF};
            pg8::gemm_phase<pg8::EpiSwiGLU, pg8::StaticOrder, true, true>(lds, g, S, E, tid);
        } else if constexpr (q == 2 || q == 21) {
            pg8::Gemm g{(const bf16*)(ws + WS_R), (const bf16*)(wb + (s ? WO_W2_1 : WO_W2_0)), M, D, FF}; pg8::StaticOrder S; S.init(M, D, G, bid);
            pg8::EpiResid E{X, ALPHA, 0.5f};
            pg8::gemm_phase<pg8::EpiResid, pg8::StaticOrder, true, true>(lds, g, S, E, tid);
        } else if constexpr (q == 3 || q == 19 || q == 22 || q == 25) {
            const int li = q == 3 ? 0 : (q == 19 ? 1 : (q == 22 ? 2 : 3));
            const float* lng = ap->in[2] + (size_t)(L * 4 + li) * D; const float* lnb = ap->in[3] + (size_t)(L * 4 + li) * D;
            for (int m = gw; m < M; m += NGW) row_pass<true>(X + (size_t)m * D, X + (size_t)m * D, XB + (size_t)m * D, lng, lnb, lane);
            if (q == 22) {
                const float* ps = ap->in[1] + (size_t)L * M * PLE; bf16* pd = (bf16*)(ws + WS_R);
                for (size_t e = (size_t)(bid * NTHREADS + tid) * 4; e < (size_t)M * PLE; e += (size_t)G * NTHREADS * 4) {
                    const f32x4 v = *(const GAS f32x4*)(ps + e);
                    *(GAS unsigned long long*)(pd + e) = (unsigned long long)pk2(v.x, v.y) | ((unsigned long long)pk2(v.z, v.w) << 32);
                }
            }
            if (q == 25 && L + 1 < DEPTH) convert_weights(ap, L + 1, lds, wave, lane, gw, NGW);
        } else if constexpr (q == 4 || q == 8 || q == 12) {
            const int ld = q == 4 ? LD_RW : (q == 8 ? LD_GLA : LD_GDN); const size_t wo = q == 4 ? WO_WRW : (q == 8 ? WO_WGLA : WO_WGDN);
            pg8::Gemm g{XB, (const bf16*)(wb + wo), M, ld, D}; pg8::StaticOrder S; S.init(M, ld, G, bid);
            pg8::EpiStore<0> E{(bf16*)(ws + WS_R), ld};
            pg8::gemm_phase<pg8::EpiStore<0>, pg8::StaticOrder, true, true>(lds, g, S, E, tid);
        } else if constexpr (q == 5) {
#if CHUNK_RW
            for (int it = bid; it < 2048; it += G) m1_rw(ap, L, it, lds, tid);
#endif
        } else if constexpr (q == 6) {
#if CHUNK_RW
            if (bid < 32) scan_rw(ap, bid >> 3, bid & 7, tid);
#else
            if (bid < 32) mix_rwkv(ap, L, bid >> 3, bid & 7, (LAS float*)lds, tid, (const bf16*)(ws + WS_R), OB);
#endif
        } else if constexpr (q == 7) {
#if CHUNK_RW
            yout<0>(ap, gw, NGW, lane);
#endif
        } else if constexpr (q == 9) {
#if CHUNK_GLA
            for (int it = bid; it < 1024; it += G) m1_gla(ap, L, it, lds, tid);
#endif
        } else if constexpr (q == 10) {
#if CHUNK_GLA
            if (bid < 16) scan_gla(ap, bid >> 2, bid & 3, tid);
#else
            if (bid < 16) mix_gla(ap, L, bid >> 2, bid & 3, (LAS float*)lds, tid, (const bf16*)(ws + WS_R), OB + (size_t)M * 512);
#endif
        } else if constexpr (q == 11) {
#if CHUNK_GLA
            yout<1>(ap, gw, NGW, lane);
#endif
        } else if constexpr (q == 13) {
#if CHUNK_GDN
            for (int it = bid; it < 1024; it += G) m1_gdn(ap, L, it, lds, tid);
#endif
        } else if constexpr (q == 14) {
#if CHUNK_GDN
            if (bid < 16) scan_gdn(ap, bid >> 2, bid & 3, lds, tid);
#else
            if (bid < 16) mix_gdn(ap, L, bid >> 2, bid & 3, (LAS float*)lds, tid, (const bf16*)(ws + WS_R), OB + (size_t)2 * M * 512);
#endif
        } else if constexpr (q == 15) {
#if CHUNK_GDN
            yout<2>(ap, gw, NGW, lane);
#endif
        } else if constexpr (q == 16) {
            pg8::Gemm g{XB, (const bf16*)(wb + WO_WG), M, NGATE, D}; pg8::StaticOrder S; S.init(M, NGATE, G, bid);
            pg8::EpiStore<2> E{(bf16*)(ws + WS_R), NGATE};
            pg8::gemm_phase<pg8::EpiStore<2>, pg8::StaticOrder, true, true>(lds, g, S, E, tid);
        } else if constexpr (q == 17) {
            pg8::Gemm g{(const bf16*)(ws + WS_O), (const bf16*)(wb + WO_WBR), 3 * M, 3 * 1024, 512}; pg8::BranchOrder S; S.init(G, bid);
            pg8::EpiBranch E{(const bf16*)(ws + WS_R), (float*)(ws + WS_R_ACC), XB};
            pg8::gemm_phase<pg8::EpiBranch, pg8::BranchOrder, true, true>(lds, g, S, E, tid);
        } else if constexpr (q == 18) {
            pg8::Gemm g{XB, (const bf16*)(wb + WO_WO), M, D, D}; pg8::StaticOrder S; S.init(M, D, G, bid);
            pg8::EpiResid E{X, ALPHA, 1.0f};
            pg8::gemm_phase<pg8::EpiResid, pg8::StaticOrder, true, true>(lds, g, S, E, tid);
        } else if constexpr (q == 23) {
            int kple = PLE; asm volatile("" : "+s"(kple));
            pg8::Gemm g{(const bf16*)(ws + WS_R), (const bf16*)(wb + WO_WPP), M, D, kple}; pg8::StaticOrder S; S.init(M, D, G, bid);
            pg8::EpiStore<0> E{(bf16*)(ws + WS_R_PP), D};
            pg8::gemm_phase<pg8::EpiStore<0>, pg8::StaticOrder, true, true>(lds, g, S, E, tid);
        } else if constexpr (q == 24) {
            pg8::Gemm g{XB, (const bf16*)(wb + WO_WPG), M, D, D}; pg8::StaticOrder S; S.init(M, D, G, bid);
            pg8::EpiPle E{X, (const bf16*)(ws + WS_R_PP), ALPHA};
            pg8::gemm_phase<pg8::EpiPle, pg8::StaticOrder, true, true>(lds, g, S, E, tid);
        }
}
__global__ void __launch_bounds__(NTHREADS, 2) mk_fwd(Args args) {
    extern __shared__ __attribute__((aligned(16))) unsigned char lds_raw[];
    LAS unsigned char* lds = (LAS unsigned char*)lds_raw;
#if MK_SINGLE
    cg::grid_group grid = cg::this_grid();
    volatile LAS unsigned* xst = (volatile LAS unsigned*)(lds + 147456);
    if (threadIdx.x == 0) { xst[0] = 0u; xst[1] = 0u; }
    __syncthreads();
    const XcdBarrier xb = xcd_barrier_post((unsigned*)args.ws, xst);
#ifdef MK_TIME
#define STAMP(k) if (blockIdx.x == 0 && threadIdx.x == 0) ((unsigned long long*)(args.ws + 32768))[(k)] = __builtin_amdgcn_s_memrealtime();
#else
#define STAMP(k)
#endif
    STAMP(0)
#define PHASE(k) if (args.ph_lo <= (k) && (k) < args.ph_hi) { run_phase<(k)>(lds); if ((k) + 1 < args.ph_hi) { if ((k) == 0) grid.sync(); else xcd_barrier(xb); } STAMP((k) + 1) }
#else
#define PHASE(k) if (args.ph_lo <= (k) && (k) < args.ph_hi) { run_phase<(k)>(lds); }
#endif
    PHASE(0)
    PHASE(1)
    PHASE(2)
    PHASE(3)
    PHASE(4)
    PHASE(5)
    PHASE(6)
    PHASE(7)
    PHASE(8)
    PHASE(9)
    PHASE(10)
    PHASE(11)
    PHASE(12)
    PHASE(13)
    PHASE(14)
    PHASE(15)
    PHASE(16)
    PHASE(17)
    PHASE(18)
    PHASE(19)
    PHASE(20)
    PHASE(21)
    PHASE(22)
    PHASE(23)
    PHASE(24)
    PHASE(25)
    PHASE(26)
    PHASE(27)
    PHASE(28)
    PHASE(29)
    PHASE(30)
    PHASE(31)
    PHASE(32)
    PHASE(33)
    PHASE(34)
    PHASE(35)
    PHASE(36)
    PHASE(37)
    PHASE(38)
    PHASE(39)
    PHASE(40)
    PHASE(41)
    PHASE(42)
    PHASE(43)
    PHASE(44)
    PHASE(45)
    PHASE(46)
    PHASE(47)
    PHASE(48)
    PHASE(49)
    PHASE(50)
#undef PHASE
    static_assert(N_PHASES == 51, "phase slots");
#if MK_SINGLE && defined(MK_TIME)
    if (blockIdx.x == 0 && threadIdx.x == 0) { const unsigned long long* ts = (const unsigned long long*)(args.ws + 32768); asm volatile("s_waitcnt vmcnt(0)" ::: "memory");
        const float us_ = 0.01f * (float)(ts[MK_TIME_B] - ts[MK_TIME_A]); const float st_ = exp2f(floorf(log2f(fmaxf(us_, 1.f)))) * 0.25f; args.out[0] += roundf(us_ / st_) * st_; }
#endif
}

#ifdef MK_DEBUG
__global__ void __launch_bounds__(NTHREADS, 2) dbg_naive(Args args, int which, int L) {
    extern __shared__ __attribute__((aligned(16))) unsigned char lds_raw[];
    KArgs ap = (KArgs)__builtin_amdgcn_kernarg_segment_ptr();
    const int tid = threadIdx.x, bid = blockIdx.x;
    bf16* dst = (bf16*)(args.ws + WS_DBG);
    if (which == 0) mix_rwkv(ap, L, 0, bid, (LAS float*)lds_raw, tid, (const bf16*)(args.ws + WS_R), dst);
    else if (which == 1) mix_gla(ap, L, 0, bid, (LAS float*)lds_raw, tid, (const bf16*)(args.ws + WS_R), dst);
    else mix_gdn(ap, L, 0, bid, (LAS float*)lds_raw, tid, (const bf16*)(args.ws + WS_R), dst);
}
__global__ void dbg_cmp(Args args, int which) {
    const bf16* o = (const bf16*)(args.ws + WS_O) + (size_t)which * M * 512; const bf16* r = (const bf16*)(args.ws + WS_DBG);
    float mx = 0.f;
    for (size_t e = (size_t)blockIdx.x * blockDim.x + threadIdx.x; e < (size_t)SEQ * 512; e += (size_t)gridDim.x * blockDim.x) {
#ifdef MK_DEBUG_TMAX
        if ((int)(e / 512) >= MK_DEBUG_TMAX) continue;
#endif
        mx = fmaxf(mx, fabsf(b2f(o[e]) - b2f(r[e])));
    }
    atomicMax((unsigned*)args.ws + 1 + which, __float_as_uint(mx));
}
__global__ void dbg_inject(Args args) {
    if (threadIdx.x == 0 && blockIdx.x == 0) { const float* d = (const float*)args.ws; args.out[0] += 1.0e4f * d[1 + MK_DEBUG]; }
}
#endif

extern "C" void kernel_launch(void* const* d_in, const int* in_sizes, int n_in, void* d_out, int out_size, void* d_ws, size_t ws_size, hipStream_t stream) {
    static int grid = 0;
    if (grid == 0) {
        if (n_in != 30 || out_size != M * D || ws_size < WS_END) { fprintf(stderr, "kernel_launch: unexpected problem: n_in %d out %d ws %zu\n", n_in, out_size, ws_size); grid = -1; return; }
        int dev = 0, cus = 0, per_cu = 0;
        (void)hipGetDevice(&dev); (void)hipDeviceGetAttribute(&cus, hipDeviceAttributeMultiprocessorCount, dev);
        (void)hipFuncSetAttribute((const void*)mk_fwd, hipFuncAttributeMaxDynamicSharedMemorySize, LDS_BYTES);
#ifdef MK_DEBUG
        (void)hipFuncSetAttribute((const void*)dbg_naive, hipFuncAttributeMaxDynamicSharedMemorySize, LDS_BYTES);
#endif
        (void)hipOccupancyMaxActiveBlocksPerMultiprocessor(&per_cu, (const void*)mk_fwd, NTHREADS, LDS_BYTES);
        (void)hipGetLastError();
        if (per_cu < 1) { fprintf(stderr, "kernel_launch: occupancy query says %d\n", per_cu); per_cu = 1; }
        grid = cus;
        if (grid > 256) grid = 256;
    }
    if (grid < 0) return;
    Args a{};
    for (int i = 0; i < 30; ++i) a.in[i] = (const float*)d_in[i];
    a.out = (float*)d_out; a.ws = (unsigned char*)d_ws;
#if MK_SINGLE
    (void)hipMemsetAsync(d_ws, 0, 65536, stream);
    a.ph_lo = 0; a.ph_hi = N_PHASES;
    void* kargs[] = {&a};
    hipError_t e = hipLaunchCooperativeKernel((const void*)mk_fwd, dim3(grid), dim3(NTHREADS), kargs, LDS_BYTES, stream);
    if (e != hipSuccess) fprintf(stderr, "cooperative launch failed: %s (grid %d)\n", hipGetErrorString(e), grid);
#else
#ifdef MK_DEBUG
    (void)hipMemsetAsync(d_ws, 0, 4096, stream);
#endif
    for (int ph = 0; ph < N_PHASES; ++ph) {
        a.ph_lo = ph; a.ph_hi = ph + 1;
        hipLaunchKernelGGL(mk_fwd, dim3(grid), dim3(NTHREADS), LDS_BYTES, stream, a);
#ifdef MK_DEBUG
        { const int L_ = ph > 0 ? (ph - 1) / PH_PER_LAYER : 0, q_ = ph > 0 ? (ph - 1) % PH_PER_LAYER + 1 : 0;
          const int which = q_ == 7 ? 0 : (q_ == 11 ? 1 : (q_ == 15 ? 2 : -1));
          if (which == MK_DEBUG) { hipLaunchKernelGGL(dbg_naive, dim3(which == 0 ? 8 : 4), dim3(NTHREADS), LDS_BYTES, stream, a, which, L_); hipLaunchKernelGGL(dbg_cmp, dim3(256), dim3(256), 0, stream, a, which); } }
#endif
    }
#ifdef MK_DEBUG
    hipLaunchKernelGGL(dbg_inject, dim3(1), dim3(64), 0, stream, a);
#endif
#endif
}
```

```cpp
#define MK_SINGLE 1
#include <hip/hip_runtime.h>
#include <hip/hip_cooperative_groups.h>
#include <cstdio>
#include <cstdint>
namespace pg8 {
#define PG8_LAS __attribute__((address_space(3)))
typedef unsigned short bf16_t;
typedef short bf16x8 __attribute__((ext_vector_type(8)));
typedef float f32x4 __attribute__((ext_vector_type(4)));
typedef unsigned u32x4 __attribute__((ext_vector_type(4)));
constexpr int BM = 256, BK = 64, HALF = 128, HTB = HALF * BK * 2  , STAGE_BYTES = 8 * HTB, NXCD = 8, WGM = 8;

__host__ __device__ __forceinline__ int lds_byte(int r, int c) { const int st = (r >> 4) * 2 + (c >> 5), rr = r & 15, cc = c & 31, ob = rr * 64 + cc * 2; return st * 1024 + (ob ^ (((ob >> 9) & 1) << 5)); }
__host__ __device__ __forceinline__ void stage_rc(int b, int& R, int& C) { const int st = b / 1024, sb = b % 1024, swz = sb ^ (((sb >> 9) & 1) << 5); R = (st >> 1) * 16 + swz / 64; C = (st & 1) * 32 + (swz % 64) / 2; }
__host__ __device__ __forceinline__ int perm32(int rho) { const int n = rho >> 4, i = rho & 15; return 8 * (i >> 2) + 4 * n + (i & 3); }

struct Unit { int pm, pn; };
struct Gemm { const bf16_t* A; const bf16_t* Bt; int M, N, K; };

struct StaticOrder {
    int nM, nN, nwg, G, c;
    __host__ __device__ void init(int M, int N, int G_, int c_) { nM = M / BM; nN = N / BM; nwg = nM * nN; G = G_; c = c_; }
    __host__ __device__ bool next(int i, Unit& u) const {
        const long L = (long)i * G + c; if (L >= nwg) return false;
        int wgid = (int)L; { const int q = nwg / NXCD, r = nwg % NXCD, xcd = wgid % NXCD, off = wgid / NXCD; wgid = (xcd < r ? xcd * (q + 1) : r * (q + 1) + (xcd - r) * q) + off; }
        const int nig = WGM * nN, gid = wgid / nig, fm = gid * WGM, gsz = (nM - fm) < WGM ? (nM - fm) : WGM;
        u.pm = fm + ((wgid % nig) % gsz); u.pn = (wgid % nig) / gsz; return true;
    }
    __device__ __forceinline__ void a_ready(const Unit&) const {}
    __device__ __forceinline__ void done(const Unit&) const {}
};

__device__ __forceinline__ unsigned cvt_pk_bf16(float lo, float hi) { unsigned r; asm volatile("v_cvt_pk_bf16_f32 %0, %1, %2" : "=v"(r) : "v"(lo), "v"(hi)); return r; }
typedef unsigned u32x2 __attribute__((ext_vector_type(2)));
__device__ __forceinline__ float fsigmoid(float x) { return __builtin_amdgcn_rcpf(1.0f + __builtin_amdgcn_exp2f(-1.44269504f * x)); }
__device__ __forceinline__ unsigned bf16_sw(float f) { const unsigned u = __float_as_uint(f); return (u + 0x7fffu + ((u >> 16) & 1u)) >> 16; }
__device__ __forceinline__ unsigned pk_bf16_sw(float lo, float hi) { return bf16_sw(lo) | (bf16_sw(hi) << 16); }
__device__ __forceinline__ float bf2f(unsigned short u) { return __uint_as_float((unsigned)u << 16); }
__device__ __forceinline__ float bflo(unsigned w) { return __uint_as_float(w << 16); }
__device__ __forceinline__ float bfhi(unsigned w) { return __uint_as_float(w & 0xffff0000u); }

struct EpiSwiGLU {
    static constexpr bool PERM = true, AFTER_DRAIN = false;
    bf16_t* O; int ldc;
    __device__ __forceinline__ void operator()(const f32x4 (&acc)[2][2][4][2], const Unit& u, int wr, int wc, int fr, int fq) const {
        const int row0 = u.pm * BM + wr * 64 + fr, col0 = u.pn * HALF + wc * 32 + 8 * fq;
#pragma unroll
        for (int ai = 0; ai < 2; ++ai)
#pragma unroll
            for (int m = 0; m < 4; ++m) {
                bf16_t* rowp = O + (size_t)(row0 + ai * HALF + m * 16) * ldc + col0;
                const f32x4 g0 = acc[ai][0][m][0], g1 = acc[ai][0][m][1], u0 = acc[ai][1][m][0], u1 = acc[ai][1][m][1];
                float h[8];
#pragma unroll
                for (int e = 0; e < 4; ++e) { h[e] = g0[e] * fsigmoid(g0[e]) * u0[e]; h[4 + e] = g1[e] * fsigmoid(g1[e]) * u1[e]; }
                u32x4 w; w.x = cvt_pk_bf16(h[0], h[1]); w.y = cvt_pk_bf16(h[2], h[3]); w.z = cvt_pk_bf16(h[4], h[5]); w.w = cvt_pk_bf16(h[6], h[7]);
                *(u32x4*)rowp = w;
            }
    }
};
template <int ACT> struct EpiStore {
    static constexpr bool PERM = true, AFTER_DRAIN = false;
    bf16_t* O; int ldc; size_t split_stride = 0;
    __device__ __forceinline__ void operator()(const f32x4 (&acc)[2][2][4][2], const Unit& u, int wr, int wc, int fr, int fq) const {
        int colt = u.pn * BM; bf16_t* Ob = O;
        if (split_stride) { const int t = colt >> 10; Ob += (size_t)t * split_stride; colt &= 1023; }
        bf16_t* O = Ob;
        const int row0 = u.pm * BM + wr * 64 + fr, col0 = colt + wc * 32 + 8 * fq;
#pragma unroll
        for (int ai = 0; ai < 2; ++ai)
#pragma unroll
            for (int m = 0; m < 4; ++m) {
                bf16_t* rowp = O + (size_t)(row0 + ai * HALF + m * 16) * ldc + col0;
#pragma unroll
                for (int bj = 0; bj < 2; ++bj) {
                    f32x4 v0 = acc[ai][bj][m][0], v1 = acc[ai][bj][m][1];
                    if (ACT == 2) {
#pragma unroll
                        for (int e = 0; e < 4; ++e) { v0[e] = fsigmoid(v0[e]); v1[e] = fsigmoid(v1[e]); }
                    }
                    u32x4 w;
                    if (ACT == 2) { w.x = pk_bf16_sw(v0[0], v0[1]); w.y = pk_bf16_sw(v0[2], v0[3]); w.z = pk_bf16_sw(v1[0], v1[1]); w.w = pk_bf16_sw(v1[2], v1[3]); }
                    else { w.x = cvt_pk_bf16(v0[0], v0[1]); w.y = cvt_pk_bf16(v0[2], v0[3]); w.z = cvt_pk_bf16(v1[0], v1[1]); w.w = cvt_pk_bf16(v1[2], v1[3]); }
                    *(u32x4*)(rowp + bj * HALF) = w;
                }
            }
    }
};
struct EpiResid {
    static constexpr bool PERM = false, AFTER_DRAIN = false;
    float* X; float alpha, s;
    __device__ __forceinline__ void operator()(const f32x4 (&acc)[2][2][4][2], const Unit& u, int wr, int wc, int fr, int fq) const {
        const int col0 = u.pn * BM + wc * 32 + 4 * fq;
#pragma unroll
        for (int ai = 0; ai < 2; ++ai)
#pragma unroll
            for (int m = 0; m < 4; ++m) {
                const int r = u.pm * BM + ai * HALF + wr * 64 + m * 16 + fr; float* p = X + (size_t)r * 1024 + col0;
#pragma unroll
                for (int bj = 0; bj < 2; ++bj)
#pragma unroll
                    for (int n = 0; n < 2; ++n) { f32x4 v = *(const f32x4*)(p + bj * HALF + n * 16); v = v * alpha + acc[ai][bj][m][n] * s; *(f32x4*)(p + bj * HALF + n * 16) = v; }
                asm volatile("" ::: "memory");
            }
    }
};
struct EpiBranch {
    static constexpr bool PERM = false, AFTER_DRAIN = false;
    const bf16_t* G0; size_t off1, off2; bf16_t* MG;
    __device__ __forceinline__ void operator()(const f32x4 (&acc)[2][2][4][2], const Unit& u, int wr, int wc, int fr, int fq) const {
        const int b = u.pm >> 6, pm = u.pm & 63, pn = u.pn & 3;
        const int col0 = pn * BM + wc * 32 + 4 * fq;
        const bf16_t* G = G0 + (b == 0 ? (size_t)0 : (b == 1 ? off1 : off2));
#pragma unroll
        for (int ai = 0; ai < 2; ++ai)
#pragma unroll
            for (int m = 0; m < 4; ++m) {
                const int r = pm * BM + ai * HALF + wr * 64 + m * 16 + fr;
                const bf16_t* pg = G + (size_t)r * 1024 + col0; bf16_t* po = MG + (size_t)r * 1024 + col0;
#pragma unroll
                for (int bj = 0; bj < 2; ++bj)
#pragma unroll
                    for (int n = 0; n < 2; ++n) {
                        const int o = bj * HALF + n * 16;
                        const u32x2 gw = *(const u32x2*)(pg + o);
                        f32x4 v = acc[ai][bj][m][n];
                        v[0] *= bflo(gw.x); v[1] *= bfhi(gw.x); v[2] *= bflo(gw.y); v[3] *= bfhi(gw.y);
                        if (b > 0) { const u32x2 pw = *(const u32x2*)(po + o); v[0] += bflo(pw.x); v[1] += bfhi(pw.x); v[2] += bflo(pw.y); v[3] += bfhi(pw.y); }
                        u32x2 w; w.x = cvt_pk_bf16(v[0], v[1]); w.y = cvt_pk_bf16(v[2], v[3]); *(u32x2*)(po + o) = w;
                    }
                asm volatile("" ::: "memory");
            }
    }
};
struct EpiPle {
    static constexpr bool PERM = false, AFTER_DRAIN = false;
    float* X; const bf16_t* P; float alpha;
    __device__ __forceinline__ void operator()(const f32x4 (&acc)[2][2][4][2], const Unit& u, int wr, int wc, int fr, int fq) const {
        const int col0 = u.pn * BM + wc * 32 + 4 * fq;
#pragma unroll
        for (int ai = 0; ai < 2; ++ai)
#pragma unroll
            for (int m = 0; m < 4; ++m) {
                const int r = u.pm * BM + ai * HALF + wr * 64 + m * 16 + fr; float* p = X + (size_t)r * 1024 + col0; const bf16_t* pp = P + (size_t)r * 1024 + col0;
#pragma unroll
                for (int bj = 0; bj < 2; ++bj)
#pragma unroll
                    for (int n = 0; n < 2; ++n) {
                        const int o = bj * HALF + n * 16;
                        f32x4 v = *(const f32x4*)(p + o); const u32x2 pw = *(const u32x2*)(pp + o); const f32x4 a = acc[ai][bj][m][n];
                        v[0] = v[0] * alpha + fsigmoid(a[0]) * bflo(pw.x); v[1] = v[1] * alpha + fsigmoid(a[1]) * bfhi(pw.x);
                        v[2] = v[2] * alpha + fsigmoid(a[2]) * bflo(pw.y); v[3] = v[3] * alpha + fsigmoid(a[3]) * bfhi(pw.y);
                        *(f32x4*)(p + o) = v;
                    }
                asm volatile("" ::: "memory");
            }
    }
};
struct BranchOrder {
    StaticOrder so;
    __host__ __device__ void init(int G_, int c_) { so.init(16384, 1024, G_, c_); }
    __host__ __device__ bool next(int i, Unit& u) const { if (i >= 3) return false; Unit t; if (!so.next(0, t)) return false; u.pm = i * 64 + t.pm; u.pn = i * 4 + t.pn; return true; }
    __device__ __forceinline__ void a_ready(const Unit&) const {}
    __device__ __forceinline__ void done(const Unit&) const {}
};

template <class Epi, class Sched, bool ALIGN_EPI = false, bool SP2 = false>
__device__ __forceinline__ void gemm_phase(PG8_LAS unsigned char* lds, const Gemm g, const Sched& S, const Epi& E, const int tid) {
    const int  wid = __builtin_amdgcn_readfirstlane(tid >> 6), lane = tid & 63, wr = wid >> 2, wc = wid & 3, fr = lane & 15, fq = lane >> 4;
    const int K = g.K, nt = K / BK;
    unsigned voffA[2], voffB[2];
#pragma unroll
    for (int i = 0; i < 2; ++i) { int R, C; stage_rc(tid * 16 + i * 8192, R, C); const int Rb = Epi::PERM ? ((R & ~31) + perm32(R & 31)) : R;
        voffA[i] = (unsigned)(R * K + C) * 2u; voffB[i] = (unsigned)(Rb * K + C) * 2u; }
    const size_t kstep = (size_t)(BK * 2);
    const size_t hstep = (size_t)HALF * K * 2;
    const size_t tstep = 2 * hstep;
    const unsigned ldsw = (unsigned)wid * 1024u;
    const int aoff = lds_byte(wr * 64 + fr, fq * 8), boff = lds_byte(wc * 32 + fr, fq * 8);
#define PG8_SA(b, h) (((b) * 2 + (h)) * HTB)
#define PG8_SB(b, h) ((4 + (b) * 2 + (h)) * HTB)
#define PG8_STAGE(bufoff, gbase, voff) do { _Pragma("unroll") for (int _i = 0; _i < 2; ++_i) \
        __builtin_amdgcn_global_load_lds((const unsigned*)((const char*)(gbase) + (voff)[_i]), (PG8_LAS unsigned*)(lds + (bufoff) + ldsw + _i * 8192), 16, 0, 0); } while (0)
#define PG8_LDA(dst, b, h) do { _Pragma("unroll") for (int m = 0; m < 4; ++m) _Pragma("unroll") for (int k = 0; k < 2; ++k) dst[m][k] = *(const PG8_LAS bf16x8*)(lds + PG8_SA(b, h) + aoff + m * 2048 + k * 1024); } while (0)
#define PG8_LDB(dst, b, h) do { _Pragma("unroll") for (int n = 0; n < 2; ++n) _Pragma("unroll") for (int k = 0; k < 2; ++k) dst[n][k] = *(const PG8_LAS bf16x8*)(lds + PG8_SB(b, h) + boff + n * 2048 + k * 1024); } while (0)
#define PG8_MMA(ai, bj, At, Bt) do { __builtin_amdgcn_s_setprio(1); _Pragma("unroll") for (int m = 0; m < 4; ++m) _Pragma("unroll") for (int n = 0; n < 2; ++n) _Pragma("unroll") for (int k = 0; k < 2; ++k) \
        acc[ai][bj][m][n] = __builtin_amdgcn_mfma_f32_16x16x32_bf16(Bt[n][k], At[m][k], acc[ai][bj][m][n], 0, 0, 0); __builtin_amdgcn_s_setprio(0); } while (0)
#define PG8_WAIT_V(n) asm volatile("s_waitcnt vmcnt(" #n ")" ::: "memory")
#define PG8_WAIT_L(n) asm volatile("s_waitcnt lgkmcnt(" #n ")" ::: "memory")
#define PG8_BAR __builtin_amdgcn_s_barrier()
#define PG8_SCHED __builtin_amdgcn_sched_barrier(0)
    Unit cur, nxt; int ui = 0;
    if (!S.next(0, cur)) return;
    f32x4 acc[2][2][4][2];
#pragma unroll
    for (int a = 0; a < 2; ++a)
#pragma unroll
        for (int b = 0; b < 2; ++b)
#pragma unroll
            for (int m = 0; m < 4; ++m)
#pragma unroll
                for (int n = 0; n < 2; ++n) acc[a][b][m][n] = (f32x4){0.f, 0.f, 0.f, 0.f};
    bf16x8 At[4][2], B0[2][2], B1[2][2];
    const char* cA = (const char*)g.A + (size_t)cur.pm * tstep; const char* cB = (const char*)g.Bt + (size_t)cur.pn * tstep;
    S.a_ready(cur);
    if constexpr (SP2) {
        PG8_STAGE(PG8_SB(0, 0), cB, voffB); PG8_STAGE(PG8_SB(0, 1), cB + hstep, voffB); PG8_STAGE(PG8_SA(0, 0), cA, voffA); PG8_STAGE(PG8_SA(0, 1), cA + hstep, voffA);
        if (wr == 1) PG8_BAR;
        PG8_WAIT_V(2); PG8_BAR;
        PG8_STAGE(PG8_SB(1, 0), cB + kstep, voffB); PG8_STAGE(PG8_SA(1, 0), cA + kstep, voffA); PG8_STAGE(PG8_SB(1, 1), cB + hstep + kstep, voffB);
        PG8_WAIT_V(6); PG8_BAR;
    } else {
        PG8_STAGE(PG8_SB(0, 0), cB, voffB); PG8_STAGE(PG8_SA(0, 0), cA, voffA); PG8_STAGE(PG8_SB(0, 1), cB + hstep, voffB); PG8_STAGE(PG8_SA(0, 1), cA + hstep, voffA);
        if (wr == 1) PG8_BAR;
        PG8_WAIT_V(4); PG8_BAR;
        PG8_STAGE(PG8_SB(1, 0), cB + kstep, voffB); PG8_STAGE(PG8_SA(1, 0), cA + kstep, voffA); PG8_STAGE(PG8_SB(1, 1), cB + hstep + kstep, voffB);
        PG8_WAIT_V(6); PG8_BAR;
    }
    for (;;) {
        const bool has_next = S.next(ui + 1, nxt);
        const char* nA = has_next ? (const char*)g.A + (size_t)nxt.pm * tstep : cA; const char* nB = has_next ? (const char*)g.Bt + (size_t)nxt.pn * tstep : cB;
        for (int t = 0; t < nt; t += 2) {
            const bool last = (t == nt - 2);
            const char* a1 = cA + (size_t)(t + 1) * kstep;
            const char* a2 = last ? nA : cA + (size_t)(t + 2) * kstep; const char* b2 = last ? nB : cB + (size_t)(t + 2) * kstep;
            const char* a3 = a2 + kstep; const char* b3 = b2 + kstep;
            if (last && has_next) S.a_ready(nxt);
            if constexpr (SP2) {
            PG8_LDB(B0, 0, 0); PG8_LDB(B1, 0, 1); PG8_SCHED; PG8_LDA(At, 0, 0); PG8_STAGE(PG8_SA(1, 1), a1 + hstep, voffA);
            PG8_WAIT_V(8); PG8_WAIT_L(0); PG8_BAR; PG8_MMA(0, 0, At, B0); PG8_MMA(0, 1, At, B1); PG8_BAR; PG8_SCHED;
            PG8_LDA(At, 0, 1); PG8_STAGE(PG8_SB(0, 0), b2, voffB); PG8_STAGE(PG8_SB(0, 1), b2 + hstep, voffB); PG8_STAGE(PG8_SA(0, 0), a2, voffA);
            PG8_WAIT_V(8); PG8_WAIT_L(0); PG8_BAR; PG8_MMA(1, 0, At, B0); PG8_MMA(1, 1, At, B1); PG8_BAR; PG8_SCHED;
            PG8_LDB(B0, 1, 0); PG8_LDB(B1, 1, 1); PG8_SCHED; PG8_LDA(At, 1, 0); PG8_STAGE(PG8_SA(0, 1), a2 + hstep, voffA);
            PG8_WAIT_V(8); PG8_WAIT_L(0); PG8_BAR; PG8_MMA(0, 0, At, B0); PG8_MMA(0, 1, At, B1); PG8_BAR; PG8_SCHED;
            PG8_LDA(At, 1, 1); PG8_STAGE(PG8_SB(1, 0), b3, voffB); PG8_STAGE(PG8_SB(1, 1), b3 + hstep, voffB); PG8_STAGE(PG8_SA(1, 0), a3, voffA);
            PG8_WAIT_V(8); PG8_WAIT_L(0); PG8_BAR; PG8_MMA(1, 0, At, B0); PG8_MMA(1, 1, At, B1); PG8_BAR; PG8_SCHED;
            } else {
            PG8_LDB(B0, 0, 0); PG8_SCHED; PG8_LDA(At, 0, 0); PG8_STAGE(PG8_SA(1, 1), a1 + hstep, voffA);
            PG8_WAIT_L(8); PG8_BAR; PG8_WAIT_L(0); PG8_MMA(0, 0, At, B0); PG8_BAR; PG8_SCHED;
            PG8_LDB(B1, 0, 1); PG8_STAGE(PG8_SB(0, 0), b2, voffB);
            PG8_BAR; PG8_WAIT_L(0); PG8_MMA(0, 1, At, B1); PG8_BAR;
            PG8_LDA(At, 0, 1); PG8_STAGE(PG8_SA(0, 0), a2, voffA);
            PG8_BAR; PG8_WAIT_L(0); PG8_MMA(1, 0, At, B0); PG8_BAR; PG8_SCHED;
            PG8_STAGE(PG8_SB(0, 1), b2 + hstep, voffB);
            PG8_WAIT_V(6); PG8_BAR; PG8_MMA(1, 1, At, B1); PG8_BAR;
            PG8_LDB(B0, 1, 0); PG8_SCHED; PG8_LDA(At, 1, 0); PG8_STAGE(PG8_SA(0, 1), a2 + hstep, voffA);
            PG8_WAIT_L(8); PG8_BAR; PG8_WAIT_L(0); PG8_MMA(0, 0, At, B0); PG8_BAR; PG8_SCHED;
            PG8_LDB(B1, 1, 1); PG8_STAGE(PG8_SB(1, 0), b3, voffB);
            PG8_BAR; PG8_WAIT_L(0); PG8_MMA(0, 1, At, B1); PG8_BAR;
            PG8_LDA(At, 1, 1); PG8_STAGE(PG8_SA(1, 0), a3, voffA);
            PG8_BAR; PG8_WAIT_L(0); PG8_MMA(1, 0, At, B0); PG8_BAR; PG8_SCHED;
            PG8_STAGE(PG8_SB(1, 1), b3 + hstep, voffB);
            PG8_WAIT_V(6); PG8_BAR; PG8_MMA(1, 1, At, B1); PG8_BAR;
            }
        }
        if constexpr (ALIGN_EPI) { if (wr == 0) PG8_BAR; }
        if constexpr (!Epi::AFTER_DRAIN) { E(acc, cur, wr, wc, fr, fq); S.done(cur); }
        if (!has_next) break;
#pragma unroll
        for (int a = 0; a < 2; ++a)
#pragma unroll
            for (int b = 0; b < 2; ++b)
#pragma unroll
                for (int m = 0; m < 4; ++m)
#pragma unroll
                    for (int n = 0; n < 2; ++n) acc[a][b][m][n] = (f32x4){0.f, 0.f, 0.f, 0.f};
        cur = nxt; cA = nA; cB = nB; ++ui;
        if constexpr (ALIGN_EPI) { if (wr == 1) PG8_BAR; }
    }
    PG8_WAIT_V(0);
    if constexpr (!ALIGN_EPI) { if (wr == 0) PG8_BAR; }
    PG8_BAR;
    if constexpr (Epi::AFTER_DRAIN) { E.fused(acc, cur, wr, wc, fr, fq, lds, wid, lane); S.done(cur); }
#undef PG8_SA
#undef PG8_SB
#undef PG8_STAGE
#undef PG8_LDA
#undef PG8_LDB
#undef PG8_MMA
#undef PG8_WAIT_V
#undef PG8_WAIT_L
#undef PG8_BAR
#undef PG8_SCHED
}
}
namespace cg = cooperative_groups;
constexpr int NWAVES = 8, NTHREADS = 512;
constexpr int BATCH = 4, SEQ = 4096, D = 1024, FF = 2816, M = BATCH * SEQ, DEPTH = 2, PLE = 256;
constexpr int DIN = 8504, NGATE = 3072;
constexpr int N_RW = 1824, N_GLA = 1552, N_GDN = 2056, LD_RW = 2048, LD_GLA = 1792, LD_GDN = 2304;
constexpr int C_GLA = 1824, C_GDN = 3376, C_GATE = 5432;
constexpr float LN_EPS = 1e-5f, ALPHA = 1.41421356237f;
constexpr size_t MiB = 1u << 20;
constexpr size_t WS_CTL = 0;
constexpr size_t SZ_W13 = (size_t)5632 * 1024 * 2, SZ_W2 = (size_t)1024 * 2816 * 2, SZ_WRW = (size_t)LD_RW * 1024 * 2, SZ_WGLA = (size_t)LD_GLA * 1024 * 2, SZ_WGDN = (size_t)LD_GDN * 1024 * 2, SZ_WG = (size_t)NGATE * 1024 * 2,
                 SZ_WBR = (size_t)3 * 1024 * 512 * 2, SZ_WO = (size_t)1024 * 1024 * 2, SZ_WPP = (size_t)1024 * 256 * 2;
constexpr size_t WS_W = 1 * MiB;
constexpr size_t WO_W13_0 = 0, WO_W2_0 = WO_W13_0 + SZ_W13, WO_W13_1 = WO_W2_0 + SZ_W2, WO_W2_1 = WO_W13_1 + SZ_W13, WO_WRW = WO_W2_1 + SZ_W2, WO_WGLA = WO_WRW + SZ_WRW, WO_WGDN = WO_WGLA + SZ_WGLA, WO_WG = WO_WGDN + SZ_WGDN,
                 WO_WBR = WO_WG + SZ_WG, WO_WO = WO_WBR + SZ_WBR, WO_WPG = WO_WO + SZ_WO, WO_WPP = WO_WPG + SZ_WO, WO_RW2T = WO_WPP + SZ_WPP, WO_RA2T = WO_RW2T + 512 * 64 * 2, WO_RG2T = WO_RA2T + 512 * 64 * 2, WO_END = WO_RG2T + 512 * 160 * 2;
static_assert(WO_END <= 59 * MiB, "weights region");
constexpr size_t WS_XB = 60 * MiB;
constexpr size_t WS_R = 92 * MiB;
constexpr size_t WS_R_ACC = WS_R + 96 * MiB, WS_R_PP = WS_R + 8 * MiB;
constexpr size_t WS_O = 268 * MiB;
constexpr size_t WS_DBG = 316 * MiB;
constexpr size_t WS_END = 324 * MiB;
constexpr int LDS_BYTES = 147456 + 64;

#define GAS __attribute__((address_space(1)))
#define LAS __attribute__((address_space(3)))
typedef unsigned short bf16;
typedef unsigned v4u __attribute__((ext_vector_type(4)));
typedef float f32x4 __attribute__((ext_vector_type(4)));
#define LDS_WAIT() asm volatile("s_waitcnt lgkmcnt(0)" ::: "memory")
__device__ __forceinline__ unsigned f2bf(float f) { unsigned u = __builtin_bit_cast(unsigned, f); return (u + 0x7fffu + ((u >> 16) & 1u)) >> 16; }
__device__ __forceinline__ unsigned pk2(float lo, float hi) { return f2bf(lo) | (f2bf(hi) << 16); }
__device__ __forceinline__ float b2f(bf16 u) { return __uint_as_float((unsigned)u << 16); }
__device__ __forceinline__ float wave_sum(float v) {
#pragma unroll
    for (int o = 1; o < 64; o <<= 1) v += __shfl_xor(v, o);
    return v;
}
__device__ __forceinline__ float sigmoidf_(float x) { return 1.0f / (1.0f + __expf(-x)); }
__device__ __forceinline__ float softplusf_(float x) { const float e = __expf(-fabsf(x)); const float l = e < 0.01f ? e * (1.f - e * (0.5f - e * 0.33333334f)) : __logf(1.f + e); return fmaxf(x, 0.f) + l; }
__device__ __forceinline__ float tanhf_(float x) { return 1.f - 2.f / (1.f + __expf(2.f * x)); }

struct Args { const float* in[30]; float* out; unsigned char* ws; int ph_lo, ph_hi; };
typedef const __attribute__((address_space(4))) Args* KArgs;

__device__ __forceinline__ void cvt_item(const float* W, int ld, int c0, int ncols, int K, bf16* WT, int kind, LAS float* scr, int item, int nnb, int lane, int kvalid = 1 << 30) {
    const int kb = item / nnb, nb = item % nnb, k0 = 64 * kb, n0 = 32 * nb;
    const int nn = n0 + (lane & 31); const bool ok = nn < ncols;
#pragma unroll 8
    for (int i = 0; i < 32; ++i) { const int kk = 2 * i + (lane >> 5); scr[kk * 33 + (lane & 31)] = (ok && k0 + kk < kvalid) ? W[(size_t)(k0 + kk) * ld + c0 + nn] : 0.f; }
    LDS_WAIT(); asm volatile("" ::: "memory");
    const int c = lane & 7;
    const int drow0 = (kind == 0) ? n0 : (256 * (n0 >> 7) + (n0 & 127) + (kind == 2 ? 128 : 0));
#pragma unroll
    for (int j = 0; j < 4; ++j) { const int n = (lane >> 3) + 8 * j; const LAS float* s = scr + (8 * c) * 33 + n;
        v4u o; o.x = pk2(s[0 * 33], s[1 * 33]); o.y = pk2(s[2 * 33], s[3 * 33]); o.z = pk2(s[4 * 33], s[5 * 33]); o.w = pk2(s[6 * 33], s[7 * 33]);
        if (k0 + 8 * c < kvalid) *(GAS v4u*)(WT + (size_t)(drow0 + n) * K + k0 + 8 * c) = o; }
    LDS_WAIT(); asm volatile("" ::: "memory");
}
__device__ __forceinline__ void convert_weights(KArgs a, int L, LAS unsigned char* lds, int wave, int lane, int gw, int NGW) {
    LAS float* scr = (LAS float*)(lds + wave * 8704);
    unsigned char* wb = a->ws + WS_W;
    constexpr int I_W1 = 16 * 88, I_W2 = 44 * 32, I_RW = 16 * 64, I_GLA = 16 * 56, I_GDN = 16 * 72, I_WG = 16 * 96, I_BR = 8 * 32, I_O = 16 * 32, I_PP = 4 * 32, I_LR = 16, I_LG = 3 * 16;
    constexpr int NIT = 4 * I_W1 + 2 * I_W2 + I_RW + I_GLA + I_GDN + I_WG + 3 * I_BR + 2 * I_O + I_PP + 2 * I_LR + I_LG;
    for (int it = gw; it < NIT; it += NGW) {
        int r = it;
        if (r < 4 * I_W1) { const int q = r / I_W1, s = q >> 1, w3 = q & 1; r -= q * I_W1;
            cvt_item((w3 ? a->in[5] : a->in[4]) + (size_t)(L * 2 + s) * 1024 * 2816, 2816, 0, 2816, 1024, (bf16*)(wb + (s ? WO_W13_1 : WO_W13_0)), 1 + w3, scr, r, 88, lane); continue; }
        r -= 4 * I_W1;
        if (r < 2 * I_W2) { const int s = r / I_W2; r -= s * I_W2;
            cvt_item(a->in[6] + (size_t)(L * 2 + s) * 2816 * 1024, 1024, 0, 1024, 2816, (bf16*)(wb + (s ? WO_W2_1 : WO_W2_0)), 0, scr, r, 32, lane); continue; }
        r -= 2 * I_W2;
        if (r < I_RW) { cvt_item(a->in[7] + (size_t)L * 1024 * DIN, DIN, 0, N_RW, 1024, (bf16*)(wb + WO_WRW), 0, scr, r, 64, lane); continue; }
        r -= I_RW;
        if (r < I_GLA) { cvt_item(a->in[7] + (size_t)L * 1024 * DIN, DIN, C_GLA, N_GLA, 1024, (bf16*)(wb + WO_WGLA), 0, scr, r, 56, lane); continue; }
        r -= I_GLA;
        if (r < I_GDN) { cvt_item(a->in[7] + (size_t)L * 1024 * DIN, DIN, C_GDN, N_GDN, 1024, (bf16*)(wb + WO_WGDN), 0, scr, r, 72, lane); continue; }
        r -= I_GDN;
        if (r < I_WG) { cvt_item(a->in[7] + (size_t)L * 1024 * DIN, DIN, C_GATE, NGATE, 1024, (bf16*)(wb + WO_WG), 0, scr, r, 96, lane); continue; }
        r -= I_WG;
        if (r < 3 * I_BR) { const int b = r / I_BR; r -= b * I_BR;
            cvt_item(a->in[26] + (size_t)(L * 3 + b) * 512 * 1024, 1024, 0, 1024, 512, (bf16*)(wb + WO_WBR) + (size_t)b * 1024 * 512, 0, scr, r, 32, lane); continue; }
        r -= 3 * I_BR;
        if (r < I_O) { cvt_item(a->in[27] + (size_t)L * 1024 * 1024, 1024, 0, 1024, 1024, (bf16*)(wb + WO_WO), 0, scr, r, 32, lane); continue; }
        r -= I_O;
        if (r < I_O) { cvt_item(a->in[28] + (size_t)L * 1024 * 1024, 1024, 0, 1024, 1024, (bf16*)(wb + WO_WPG), 0, scr, r, 32, lane); continue; }
        r -= I_O;
        if (r < I_PP) { cvt_item(a->in[29] + (size_t)L * 256 * 1024, 1024, 0, 1024, 256, (bf16*)(wb + WO_WPP), 0, scr, r, 32, lane); continue; }
        r -= I_PP;
        if (r < I_LR) { cvt_item(a->in[10] + (size_t)L * 64 * 512, 512, 0, 512, 64, (bf16*)(wb + WO_RW2T), 0, scr, r, 16, lane); continue; }
        r -= I_LR;
        if (r < I_LR) { cvt_item(a->in[12] + (size_t)L * 64 * 512, 512, 0, 512, 64, (bf16*)(wb + WO_RA2T), 0, scr, r, 16, lane); continue; }
        r -= I_LR;
        cvt_item(a->in[13] + (size_t)L * 160 * 512, 512, 0, 512, 160, (bf16*)(wb + WO_RG2T), 0, scr, r, 16, lane, 160);
    }
}
template <bool NORM>
__device__ __forceinline__ void row_pass(const float* src, float* dst, bf16* dstb, const float* g, const float* bta, int lane) {
    const GAS f32x4* xr = (const GAS f32x4*)src + lane;
    f32x4 v[4]; float s = 0.f;
#pragma unroll
    for (int j = 0; j < 4; ++j) { v[j] = xr[64 * j]; s += (v[j].x + v[j].y) + (v[j].z + v[j].w); }
    if (NORM) {
        const float mean = wave_sum(s) * (1.f / D); float s2 = 0.f;
#pragma unroll
        for (int j = 0; j < 4; ++j) { v[j] = v[j] - mean; s2 += (v[j].x * v[j].x + v[j].y * v[j].y) + (v[j].z * v[j].z + v[j].w * v[j].w); }
        const float rstd = 1.f / sqrtf(wave_sum(s2) * (1.f / D) + LN_EPS);
#pragma unroll
        for (int j = 0; j < 4; ++j) { const f32x4 gg = ((const GAS f32x4*)g)[lane + 64 * j], bb = ((const GAS f32x4*)bta)[lane + 64 * j]; v[j] = v[j] * rstd * gg + bb; }
    }
    GAS f32x4* o4 = (GAS f32x4*)dst + lane;
    GAS unsigned long long* o8 = (GAS unsigned long long*)dstb + lane;
#pragma unroll
    for (int j = 0; j < 4; ++j) { o4[64 * j] = v[j]; o8[64 * j] = (unsigned long long)pk2(v[j].x, v[j].y) | ((unsigned long long)pk2(v[j].z, v[j].w) << 32); }
}

constexpr int CH = 16;
__device__ __forceinline__ void mix_rwkv(KArgs a, int L, int b, int h, LAS float* sm, int tid, const bf16* hm, bf16* out) {
    constexpr int LDH = LD_RW, C_RW = 0;
    const int lane = tid & 63, wid = tid >> 6;
    LAS float* w2h = sm; LAS float* a2h = sm + 4096; LAS float* g2h = sm + 8192;
    LAS float* tw = sm + 18432; LAS float* al = tw + 1024; LAS float* gl = al + 1024;
    LAS float* sr = gl + 2560; LAS float* skr = sr + 1024; LAS float* sv = skr + 1024; LAS float* sd = sv + 1024; LAS float* sa = sd + 1024; LAS float* sb = sa + 1024;
    LAS float* sk2 = sb + 1024; LAS float* sg = sk2 + 1024; LAS float* sbon = sg + 1024; LAS float* sy = sbon + 1024;
    const float* mu = a->in[8] + L * 1824;
    for (int e = tid; e < 64 * 64; e += NTHREADS) { const int i = e >> 6, j = e & 63; w2h[e] = a->in[10][(size_t)(L * 64 + i) * 512 + h * 64 + j]; a2h[e] = a->in[12][(size_t)(L * 64 + i) * 512 + h * 64 + j]; }
    for (int e = tid; e < 160 * 64; e += NTHREADS) { const int i = e >> 6, j = e & 63; g2h[e] = a->in[13][(size_t)(L * 160 + i) * 512 + h * 64 + j]; }
    const int hj = L * 512 + h * 64 + lane;
    const float w0j = a->in[9][hj], a0j = a->in[11][hj], kkj = a->in[14][hj], kaj = a->in[15][hj], rkj = a->in[16][hj], gngj = a->in[17][hj], gnbj = a->in[18][hj];
    float S[8];
#pragma unroll
    for (int i = 0; i < 8; ++i) S[i] = 0.f;
    const int vrow = tid >> 3, kg = tid & 7;
    __syncthreads();
#pragma unroll 1
    for (int c = 0; c < SEQ / CH; ++c) {
        const int t0 = c * CH;
        for (int e = tid; e < CH * 480; e += NTHREADS) {
            const int tt = e / 480, cc = e % 480, t = t0 + tt;
            int col; if (cc < 64) col = h * 64 + cc; else if (cc < 128) col = 512 + h * 64 + (cc - 64); else if (cc < 192) col = 1024 + h * 64 + (cc - 128); else col = 1536 + (cc - 192);
            const size_t ro = (size_t)(b * SEQ + t) * LDH + C_RW + col;
            const float cur = b2f(hm[ro]), prev = t > 0 ? b2f(hm[ro - LDH]) : 0.f;
            const float xs = cur + (prev - cur) * mu[col];
            if (cc < 64) sr[tt * 64 + cc] = xs; else if (cc < 128) skr[tt * 64 + cc - 64] = xs; else if (cc < 192) sv[tt * 64 + cc - 128] = xs;
            else if (cc < 256) tw[tt * 64 + cc - 192] = tanhf_(xs); else if (cc < 320) al[tt * 64 + cc - 256] = xs; else gl[tt * 160 + cc - 320] = sigmoidf_(xs);
        }
        __syncthreads();
#pragma unroll
        for (int i2 = 0; i2 < 2; ++i2) {
            const int tt = wid + 8 * i2;
            float w = w0j, av = a0j, g = 0.f;
#pragma unroll 4
            for (int i = 0; i < 64; ++i) { w += tw[tt * 64 + i] * w2h[i * 64 + lane]; av += al[tt * 64 + i] * a2h[i * 64 + lane]; }
#pragma unroll 4
            for (int i = 0; i < 160; ++i) g += gl[tt * 160 + i] * g2h[i * 64 + lane];
            const float wl = -softplusf_(-w) - 0.5f, dec = __expf(-__expf(wl)), asig = sigmoidf_(av);
            const float kraw = skr[tt * 64 + lane], kkr = kraw * kkj;
            const float kk = kkr * (1.0f / sqrtf(wave_sum(kkr * kkr) + 1e-6f));
            const float k2 = kraw * (1.f + (asig - 1.f) * kaj);
            const float rk = wave_sum(sr[tt * 64 + lane] * k2 * rkj);
            sd[tt * 64 + lane] = dec; sa[tt * 64 + lane] = -kk; sb[tt * 64 + lane] = kk * asig; sk2[tt * 64 + lane] = k2; sg[tt * 64 + lane] = g; sbon[tt * 64 + lane] = rk * sv[tt * 64 + lane];
        }
        __syncthreads();
#pragma unroll 1
        for (int tt = 0; tt < CH; ++tt) {
            const int o = tt * 64 + kg * 8;
            float x = 0.f;
#pragma unroll
            for (int i = 0; i < 8; ++i) x += S[i] * sa[o + i];
            x += __shfl_xor(x, 1); x += __shfl_xor(x, 2); x += __shfl_xor(x, 4);
            const float vv = sv[tt * 64 + vrow];
            float y = 0.f;
#pragma unroll
            for (int i = 0; i < 8; ++i) { S[i] = S[i] * sd[o + i] + x * sb[o + i] + vv * sk2[o + i]; y += S[i] * sr[o + i]; }
            y += __shfl_xor(y, 1); y += __shfl_xor(y, 2); y += __shfl_xor(y, 4);
            if (kg == 0) sy[tt * 64 + vrow] = y;
        }
        __syncthreads();
#pragma unroll
        for (int i2 = 0; i2 < 2; ++i2) {
            const int tt = wid + 8 * i2;
            const float y = sy[tt * 64 + lane], mean = wave_sum(y) * (1.f / 64.f), dv = y - mean, var = wave_sum(dv * dv) * (1.f / 64.f);
            const float yn = dv * (1.0f / sqrtf(var + 64e-5f)) * gngj + gnbj;
            const float o = (yn + sbon[tt * 64 + lane]) * sg[tt * 64 + lane];
            out[(size_t)(b * SEQ + t0 + tt) * 512 + h * 64 + lane] = (bf16)f2bf(o);
        }
        __syncthreads();
    }
}
__device__ __forceinline__ void mix_gla(KArgs a, int L, int b, int h, LAS float* sm, int tid, const bf16* hm, bf16* out) {
    constexpr int LDH = LD_GLA, C_GLA = 0;
    const int lane = tid & 63, wid = tid >> 6;
    LAS float* gkw = sm; LAS float* sq = sm + 1024; LAS float* sk = sq + 1024; LAS float* sdec = sk + 1024; LAS float* sv = sdec + 1024; LAS float* sgt = sv + 2048; LAS float* so = sgt + 2048; LAS float* gkl = so + 2048;
    for (int e = tid; e < 16 * 64; e += NTHREADS) { const int i = e >> 6, j = e & 63; gkw[e] = a->in[19][(size_t)(L * 16 + i) * 256 + h * 64 + j]; }
    const float gkbj = a->in[20][L * 256 + h * 64 + lane];
    const float ng0 = a->in[21][L * 128 + lane], ng1 = a->in[21][L * 128 + 64 + lane];
    float S[16];
#pragma unroll
    for (int i = 0; i < 16; ++i) S[i] = 0.f;
    const int vc = tid >> 2, kg = tid & 3;
    __syncthreads();
#pragma unroll 1
    for (int c = 0; c < SEQ / CH; ++c) {
        const int t0 = c * CH;
        for (int e = tid; e < CH * 400; e += NTHREADS) {
            const int tt = e / 400, cc = e % 400;
            int col; if (cc < 64) col = h * 64 + cc; else if (cc < 128) col = 256 + h * 64 + (cc - 64); else if (cc < 256) col = 512 + h * 128 + (cc - 128); else if (cc < 272) col = 1024 + (cc - 256); else col = 1040 + h * 128 + (cc - 272);
            const float x = b2f(hm[(size_t)(b * SEQ + t0 + tt) * LDH + C_GLA + col]);
            if (cc < 64) sq[tt * 64 + cc] = x; else if (cc < 128) sk[tt * 64 + cc - 64] = x; else if (cc < 256) sv[tt * 128 + cc - 128] = x; else if (cc < 272) gkl[tt * 16 + cc - 256] = x; else sgt[tt * 128 + cc - 272] = x;
        }
        __syncthreads();
#pragma unroll
        for (int i2 = 0; i2 < 2; ++i2) {
            const int tt = wid + 8 * i2;
            float z = gkbj;
#pragma unroll
            for (int i = 0; i < 16; ++i) z += gkl[tt * 16 + i] * gkw[i * 64 + lane];
            sdec[tt * 64 + lane] = __expf(-softplusf_(-z) * (1.f / 16.f));
        }
        __syncthreads();
#pragma unroll 1
        for (int tt = 0; tt < CH; ++tt) {
            const int o = tt * 64 + kg * 16; const float vv = sv[tt * 128 + vc];
            float y = 0.f;
#pragma unroll
            for (int i = 0; i < 16; ++i) { S[i] = S[i] * sdec[o + i] + sk[o + i] * vv; y += S[i] * sq[o + i]; }
            y += __shfl_xor(y, 1); y += __shfl_xor(y, 2);
            if (kg == 0) so[tt * 128 + vc] = y * 0.125f;
        }
        __syncthreads();
#pragma unroll
        for (int i2 = 0; i2 < 2; ++i2) {
            const int tt = wid + 8 * i2;
            const float o0 = so[tt * 128 + lane], o1 = so[tt * 128 + 64 + lane];
            const float rs = 1.0f / sqrtf(wave_sum(o0 * o0 + o1 * o1) * (1.f / 128.f) + 1e-6f);
            const float g0 = sgt[tt * 128 + lane], g1 = sgt[tt * 128 + 64 + lane];
            bf16* op = out + (size_t)(b * SEQ + t0 + tt) * 512 + h * 128;
            op[lane] = (bf16)f2bf(o0 * rs * ng0 * g0 * sigmoidf_(g0)); op[64 + lane] = (bf16)f2bf(o1 * rs * ng1 * g1 * sigmoidf_(g1));
        }
        __syncthreads();
    }
}
__device__ __forceinline__ void mix_gdn(KArgs a, int L, int b, int h, LAS float* sm, int tid, const bf16* hm, bf16* out) {
    constexpr int LDH = LD_GDN, C_GDN = 0;
    const int lane = tid & 63, wid = tid >> 6;
    LAS float* raw = sm;
    LAS float* sq = sm + 7296; LAS float* sk = sq + 2048; LAS float* sv = sk + 2048; LAS float* sgt = sv + 2048; LAS float* so = sgt + 2048; LAS float* sal = so + 2048; LAS float* sbe = sal + 16;
    const float* cw = a->in[22] + (size_t)L * 4 * 1536;
    const float Ah = __expf(a->in[23][L * 4 + h]), dtb = a->in[24][L * 4 + h];
    const float ng0 = a->in[25][L * 128 + lane], ng1 = a->in[25][L * 128 + 64 + lane];
    float S[32];
#pragma unroll
    for (int i = 0; i < 32; ++i) S[i] = 0.f;
    const int vc = tid >> 2, kg = tid & 3;
#pragma unroll 1
    for (int c = 0; c < SEQ / CH; ++c) {
        const int t0 = c * CH;
        for (int e = tid; e < 19 * 384; e += NTHREADS) {
            const int rr = e / 384, cc = e % 384, t = t0 - 3 + rr;
            const int col = (cc < 128) ? (h * 128 + cc) : (cc < 256 ? 512 + h * 128 + (cc - 128) : 1024 + h * 128 + (cc - 256));
            raw[e] = t >= 0 ? b2f(hm[(size_t)(b * SEQ + t) * LDH + C_GDN + col]) : 0.f;
        }
        for (int e = tid; e < CH * 128; e += NTHREADS) { const int tt = e >> 7, cc = e & 127; sgt[e] = b2f(hm[(size_t)(b * SEQ + t0 + tt) * LDH + C_GDN + 1544 + h * 128 + cc]); }
        if (tid < CH) {
            const size_t ro = (size_t)(b * SEQ + t0 + tid) * LDH + C_GDN;
            const float ai = b2f(hm[ro + 1536 + h]), bi = b2f(hm[ro + 1540 + h]);
            sal[tid] = __expf(-Ah * softplusf_(ai + dtb)); sbe[tid] = sigmoidf_(bi);
        }
        __syncthreads();
        for (int e = tid; e < CH * 384; e += NTHREADS) {
            const int tt = e / 384, cc = e % 384;
            const int ch = (cc < 128) ? (h * 128 + cc) : (cc < 256 ? 512 + h * 128 + (cc - 128) : 1024 + h * 128 + (cc - 256));
            float s = 0.f;
#pragma unroll
            for (int i = 0; i < 4; ++i) s += cw[i * 1536 + ch] * raw[(tt + i) * 384 + cc];
            s = s * sigmoidf_(s);
            if (cc < 128) sq[tt * 128 + cc] = s; else if (cc < 256) sk[tt * 128 + cc - 128] = s; else sv[tt * 128 + cc - 256] = s;
        }
        __syncthreads();
#pragma unroll
        for (int i2 = 0; i2 < 2; ++i2) {
            const int tt = wid + 8 * i2;
            const float q0 = sq[tt * 128 + lane], q1 = sq[tt * 128 + 64 + lane], k0 = sk[tt * 128 + lane], k1 = sk[tt * 128 + 64 + lane];
            const float rq = (1.0f / sqrtf(wave_sum(q0 * q0 + q1 * q1) + 1e-6f)) * 0.08838834764831845f, rk = 1.0f / sqrtf(wave_sum(k0 * k0 + k1 * k1) + 1e-6f);
            sq[tt * 128 + lane] = q0 * rq; sq[tt * 128 + 64 + lane] = q1 * rq; sk[tt * 128 + lane] = k0 * rk; sk[tt * 128 + 64 + lane] = k1 * rk;
        }
        __syncthreads();
#pragma unroll 1
        for (int tt = 0; tt < CH; ++tt) {
            const int o = tt * 128 + kg * 32; const float al = sal[tt], be = sbe[tt];
            float p = 0.f;
#pragma unroll
            for (int i = 0; i < 32; ++i) { S[i] *= al; p += S[i] * sk[o + i]; }
            p += __shfl_xor(p, 1); p += __shfl_xor(p, 2);
            const float vn = be * (sv[tt * 128 + vc] - p);
            float y = 0.f;
#pragma unroll
            for (int i = 0; i < 32; ++i) { S[i] += sk[o + i] * vn; y += S[i] * sq[o + i]; }
            y += __shfl_xor(y, 1); y += __shfl_xor(y, 2);
            if (kg == 0) so[tt * 128 + vc] = y;
        }
        __syncthreads();
#pragma unroll
        for (int i2 = 0; i2 < 2; ++i2) {
            const int tt = wid + 8 * i2;
            const float o0 = so[tt * 128 + lane], o1 = so[tt * 128 + 64 + lane];
            const float rs = 1.0f / sqrtf(wave_sum(o0 * o0 + o1 * o1) * (1.f / 128.f) + 1e-6f);
            const float g0 = sgt[tt * 128 + lane], g1 = sgt[tt * 128 + 64 + lane];
            bf16* op = out + (size_t)(b * SEQ + t0 + tt) * 512 + h * 128;
            op[lane] = (bf16)f2bf(o0 * rs * ng0 * g0 * sigmoidf_(g0)); op[64 + lane] = (bf16)f2bf(o1 * rs * ng1 * g1 * sigmoidf_(g1));
        }
        __syncthreads();
    }
}

typedef short bf16x8 __attribute__((ext_vector_type(8)));
typedef unsigned u32x2 __attribute__((ext_vector_type(2)));
__device__ __forceinline__ f32x4 mfma16(bf16x8 a, bf16x8 b, f32x4 c) { return __builtin_amdgcn_mfma_f32_16x16x32_bf16(a, b, c, 0, 0, 0); }
template <int K> __device__ __forceinline__ f32x4 mm16(f32x4 acc, const LAS bf16* Ap, int pa, const LAS bf16* Bp, int pb, int lane) {
    const LAS bf16* a = Ap + (lane & 15) * pa + 8 * (lane >> 4); const LAS bf16* b = Bp + (lane & 15) * pb + 8 * (lane >> 4);
#pragma unroll
    for (int kk = 0; kk < K; kk += 32) acc = mfma16(*(const LAS bf16x8*)(a + kk), *(const LAS bf16x8*)(b + kk), acc);
    return acc;
}
__device__ __forceinline__ u32x2 pack4(f32x4 v) { u32x2 w; w.x = pk2(v[0], v[1]); w.y = pk2(v[2], v[3]); return w; }
__device__ __forceinline__ f32x4 unpack4(u32x2 w) { f32x4 v; v[0] = __uint_as_float(w.x << 16); v[1] = __uint_as_float(w.x & 0xffff0000u); v[2] = __uint_as_float(w.y << 16); v[3] = __uint_as_float(w.y & 0xffff0000u); return v; }
__device__ __forceinline__ void storeT(LAS bf16* Out, int po, int m0, int n0, f32x4 acc, int lane) { *(LAS u32x2*)(Out + (n0 + (lane & 15)) * po + m0 + 4 * (lane >> 4)) = pack4(acc); }
__device__ __forceinline__ void storeR(LAS bf16* Out, int po, int m0, int n0, f32x4 acc, int lane) {
#pragma unroll
    for (int r = 0; r < 4; ++r) Out[(m0 + 4 * (lane >> 4) + r) * po + n0 + (lane & 15)] = (bf16)f2bf(acc[r]);
}
__device__ __forceinline__ int kperm(int d) { return (d & ~31) | (((d >> 2) & 3) << 3) | (((d >> 4) & 1) << 2) | (d & 3); }
__device__ __forceinline__ bf16x8 frag_of(f32x4 lo, f32x4 hi) {
    u32x2 a = pack4(lo), b = pack4(hi); v4u w; w.x = a.x; w.y = a.y; w.z = b.x; w.w = b.y; return __builtin_bit_cast(bf16x8, w);
}

constexpr size_t GLA_QP = 162 * MiB, GLA_NN = 80 * MiB, GLA_E = 145 * MiB, GLA_DEC = 161 * MiB;
constexpr int P64 = 72;
__device__ __forceinline__ void m1_gla(KArgs a, int L, int item, LAS unsigned char* lds, int tid) {
    const int lane = tid & 63, wave = tid >> 6, h = item & 3, tok0 = (item >> 2) * 64;
    unsigned char* R = a->ws + WS_R;
    const bf16* hg = (const bf16*)R; bf16* QP = (bf16*)(R + GLA_QP) + (size_t)item * 4096; bf16* NN = (bf16*)(R + GLA_NN) + (size_t)item * 8192;
    bf16* E = (bf16*)(R + GLA_E); float* DEC = (float*)(R + GLA_DEC) + item * 64; bf16* Y = (bf16*)(a->ws + WS_O) + (size_t)M * 512;
    LAS float* LA = (LAS float*)lds;
    LAS bf16* QS = (LAS bf16*)(lds + 16384); LAS bf16* KS = QS + 64 * P64; LAS bf16* KHT = KS + 64 * P64; LAS bf16* VT = KHT + 64 * P64; LAS bf16* ATT = VT + 128 * P64;
    LAS float* GKL = (LAS float*)(lds + 16384 + (64 * 4 + 128) * P64 * 2);
    for (int e = tid; e < 1024; e += NTHREADS) GKL[e] = b2f(hg[(size_t)(tok0 + (e >> 4)) * LD_GLA + 1024 + (e & 15)]);
    __syncthreads();
    {
        const int t = tid >> 3, d0 = (tid & 7) * 8; float z[8];
#pragma unroll
        for (int j = 0; j < 8; ++j) z[j] = a->in[20][L * 256 + h * 64 + d0 + j];
        for (int i = 0; i < 16; ++i) { const float g = GKL[t * 16 + i]; const float* w = a->in[19] + (size_t)(L * 16 + i) * 256 + h * 64 + d0;
#pragma unroll
            for (int j = 0; j < 8; ++j) z[j] += g * w[j]; }
#pragma unroll
        for (int j = 0; j < 8; ++j) LA[t * 64 + d0 + j] = -softplusf_(-z[j]) * (1.f / 16.f);
    }
    __syncthreads();
    if (tid < 64) { float run = 0.f; for (int t = 0; t < 64; ++t) { run += LA[t * 64 + tid]; LA[t * 64 + tid] = run; } }
    __syncthreads();
    for (int e = tid; e < 4096; e += NTHREADS) {
        const int t = e >> 6, d = e & 63; const float bb = LA[e], be = LA[63 * 64 + d];
        const size_t ro = (size_t)(tok0 + t) * LD_GLA + h * 64 + d;
        const float q = b2f(hg[ro]) * 0.125f * __expf(bb), k = b2f(hg[ro + 256]);
        const bf16 qb = (bf16)f2bf(q);
        QS[t * P64 + d] = qb; QP[t * 64 + kperm(d)] = qb;
        KS[t * P64 + d] = (bf16)f2bf(k * __expf(-bb)); KHT[d * P64 + t] = (bf16)f2bf(k * __expf(be - bb));
        if (t == 63) DEC[d] = __expf(be);
    }
    for (int e = tid; e < 8192; e += NTHREADS) {
        const int t = e >> 7, j = e & 127; const size_t ro = (size_t)(tok0 + t) * LD_GLA + h * 128 + j;
        VT[j * P64 + t] = hg[ro + 512];
        const float gt = b2f(hg[ro + 1040]);
        E[(size_t)(tok0 + t) * 512 + h * 128 + j] = (bf16)f2bf(a->in[21][L * 128 + j] * gt * sigmoidf_(gt));
    }
    __syncthreads();
#pragma unroll
    for (int i = 0; i < 2; ++i) {
        const int idx = wave * 2 + i, T = idx >> 2, S = idx & 3;
        f32x4 acc = {0.f, 0.f, 0.f, 0.f};
        if (S <= T) acc = mm16<64>(acc, QS + 16 * T * P64, P64, KS + 16 * S * P64, P64, lane);
#pragma unroll
        for (int r = 0; r < 4; ++r) if (16 * S + (lane & 15) > 16 * T + 4 * (lane >> 4) + r) acc[r] = 0.f;
        storeR(ATT, P64, 16 * T, 16 * S, acc, lane);
    }
    __syncthreads();
#pragma unroll
    for (int i = 0; i < 4; ++i) {
        const int idx = wave * 4 + i, Jt = idx >> 2, T = idx & 3;
        f32x4 acc = {0.f, 0.f, 0.f, 0.f};
        acc = mm16<64>(acc, VT + 16 * Jt * P64, P64, ATT + 16 * T * P64, P64, lane);
        *(u32x2*)(Y + (size_t)(tok0 + 16 * T + (lane & 15)) * 512 + h * 128 + 16 * Jt + 4 * (lane >> 4)) = pack4(acc);
    }
#pragma unroll
    for (int i = 0; i < 4; ++i) {
        const int idx = wave * 4 + i, J = idx >> 2, I = idx & 3;
        f32x4 acc = {0.f, 0.f, 0.f, 0.f};
        acc = mm16<64>(acc, KHT + 16 * I * P64, P64, VT + 16 * J * P64, P64, lane);
        *(u32x2*)(NN + (size_t)((J * 4 + I) * 64 + lane) * 4) = pack4(acc);
    }
    __syncthreads();
}
__device__ __forceinline__ void m2_gla(KArgs a, int b, int h, int tid) {
    const int lane = tid & 63, J = tid >> 6, g = lane >> 4, n = lane & 15;
    unsigned char* R = a->ws + WS_R;
    const bf16* QPb = (const bf16*)(R + GLA_QP); const bf16* NNb = (const bf16*)(R + GLA_NN); const float* DECb = (const float*)(R + GLA_DEC); bf16* Y = (bf16*)(a->ws + WS_O) + (size_t)M * 512;
    f32x4 H[4];
#pragma unroll
    for (int I = 0; I < 4; ++I) H[I] = (f32x4){0.f, 0.f, 0.f, 0.f};
    bf16x8 bq[4][2], bqn[4][2]; u32x2 yi[4], yin[4], nn[4], nnn[4]; f32x4 dc[4], dcn[4];
#define GLA_LOAD(c, BQ, YI, NNv, DC) do { const int item_ = ((b * 64 + (c)) * 4 + h); const bf16* qp_ = QPb + (size_t)item_ * 4096; \
        _Pragma("unroll") for (int T = 0; T < 4; ++T) { _Pragma("unroll") for (int s = 0; s < 2; ++s) BQ[T][s] = *(const bf16x8*)(qp_ + (16 * T + n) * 64 + 32 * s + 8 * g); \
            YI[T] = *(const u32x2*)(Y + (size_t)((b * 64 + (c)) * 64 + 16 * T + n) * 512 + h * 128 + 16 * J + 4 * g); } \
        _Pragma("unroll") for (int I = 0; I < 4; ++I) { NNv[I] = *(const u32x2*)(NNb + (size_t)item_ * 8192 + (size_t)((J * 4 + I) * 64 + lane) * 4); DC[I] = *(const f32x4*)(DECb + item_ * 64 + 16 * I + 4 * g); } } while (0)
    GLA_LOAD(0, bq, yi, nn, dc);
#pragma unroll 1
    for (int c = 0; c < 64; ++c) {
        if (c + 1 < 64) GLA_LOAD(c + 1, bqn, yin, nnn, dcn);
        const bf16x8 a0 = frag_of(H[0], H[1]), a1 = frag_of(H[2], H[3]);
#pragma unroll
        for (int T = 0; T < 4; ++T) {
            f32x4 acc = unpack4(yi[T]);
            acc = mfma16(a0, bq[T][0], acc); acc = mfma16(a1, bq[T][1], acc);
            *(u32x2*)(Y + (size_t)((b * 64 + c) * 64 + 16 * T + n) * 512 + h * 128 + 16 * J + 4 * g) = pack4(acc);
        }
#pragma unroll
        for (int I = 0; I < 4; ++I) H[I] = H[I] * dc[I] + unpack4(nn[I]);
#pragma unroll
        for (int T = 0; T < 4; ++T) { bq[T][0] = bqn[T][0]; bq[T][1] = bqn[T][1]; yi[T] = yin[T]; nn[T] = nnn[T]; dc[T] = dcn[T]; }
    }
#undef GLA_LOAD
}
__device__ __forceinline__ void m3_rms(bf16* Y, const bf16* E, int gw, int NGW, int lane) {
    for (int m = gw; m < M; m += NGW) {
        const v4u yw = *(const v4u*)(Y + (size_t)m * 512 + lane * 8), ew = *(const v4u*)(E + (size_t)m * 512 + lane * 8);
        float y[8], e[8];
        y[0] = __uint_as_float(yw.x << 16); y[1] = __uint_as_float(yw.x & 0xffff0000u); y[2] = __uint_as_float(yw.y << 16); y[3] = __uint_as_float(yw.y & 0xffff0000u);
        y[4] = __uint_as_float(yw.z << 16); y[5] = __uint_as_float(yw.z & 0xffff0000u); y[6] = __uint_as_float(yw.w << 16); y[7] = __uint_as_float(yw.w & 0xffff0000u);
        e[0] = __uint_as_float(ew.x << 16); e[1] = __uint_as_float(ew.x & 0xffff0000u); e[2] = __uint_as_float(ew.y << 16); e[3] = __uint_as_float(ew.y & 0xffff0000u);
        e[4] = __uint_as_float(ew.z << 16); e[5] = __uint_as_float(ew.z & 0xffff0000u); e[6] = __uint_as_float(ew.w << 16); e[7] = __uint_as_float(ew.w & 0xffff0000u);
        float ss = 0.f;
#pragma unroll
        for (int i = 0; i < 8; ++i) ss += y[i] * y[i];
        ss += __shfl_xor(ss, 1); ss += __shfl_xor(ss, 2); ss += __shfl_xor(ss, 4); ss += __shfl_xor(ss, 8);
        const float rs = 1.0f / sqrtf(ss * (1.f / 128.f) + 1e-6f);
        v4u o; o.x = pk2(y[0] * rs * e[0], y[1] * rs * e[1]); o.y = pk2(y[2] * rs * e[2], y[3] * rs * e[3]); o.z = pk2(y[4] * rs * e[4], y[5] * rs * e[5]); o.w = pk2(y[6] * rs * e[6], y[7] * rs * e[7]);
        *(v4u*)(Y + (size_t)m * 512 + lane * 8) = o;
    }
}
constexpr size_t GDN_QP = 136 * MiB, GDN_MM = 72 * MiB, GDN_NN = 104 * MiB, GDN_E = 152 * MiB;
constexpr int P128 = 136;
__device__ __forceinline__ void m1_gdn(KArgs a, int L, int item, LAS unsigned char* lds, int tid) {
    const int lane = tid & 63, wave = tid >> 6, g = lane >> 4, n = lane & 15, h = item & 3, bc = item >> 2, c = bc & 63, tok0 = bc * 64;
    unsigned char* R = a->ws + WS_R;
    const bf16* hg = (const bf16*)R; bf16* QPg = (bf16*)(R + GDN_QP) + (size_t)item * 8192; bf16* MMg = (bf16*)(R + GDN_MM) + (size_t)item * 16384; bf16* NNg = (bf16*)(R + GDN_NN) + (size_t)item * 16384;
    bf16* E = (bf16*)(R + GDN_E); bf16* Y = (bf16*)(a->ws + WS_O) + (size_t)2 * M * 512;
    LAS bf16* KN = (LAS bf16*)lds; LAS bf16* QN = (LAS bf16*)(lds + 17408); LAS bf16* KNT = (LAS bf16*)(lds + 34816); LAS bf16* VT = (LAS bf16*)(lds + 53248); LAS bf16* KHT = (LAS bf16*)(lds + 71680);
    LAS bf16* S = (LAS bf16*)(lds + 90112); LAS bf16* ST = (LAS bf16*)(lds + 99328); LAS bf16* ATT = (LAS bf16*)(lds + 108544); LAS bf16* S2 = (LAS bf16*)(lds + 117760); LAS bf16* S2T = (LAS bf16*)(lds + 126976);
    LAS bf16* P = (LAS bf16*)(lds + 136192); LAS float* GC = (LAS float*)(lds + 145408); LAS float* BETA = GC + 64;
    LAS bf16* RAW = S;
    LAS bf16* WT = KN; LAS bf16* UT = S2;
    for (int ch = tid; ch < 67 * 48; ch += NTHREADS) {
        const int rr = ch / 48, cc = (ch % 48) * 8;
        const int sc = cc < 128 ? h * 128 + cc : (cc < 256 ? 512 + h * 128 + (cc - 128) : 1024 + h * 128 + (cc - 256));
        v4u val = {0u, 0u, 0u, 0u};
        if (c * 64 - 3 + rr >= 0) val = *(const v4u*)(hg + (size_t)(tok0 - 3 + rr) * LD_GDN + sc);
        *(LAS v4u*)(RAW + rr * 384 + cc) = val;
    }
    if (tid < 64) {
        const size_t ro = (size_t)(tok0 + tid) * LD_GDN;
        const float ai = b2f(hg[ro + 1536 + h]), bi = b2f(hg[ro + 1540 + h]);
        float v = -__expf(a->in[23][L * 4 + h]) * softplusf_(ai + a->in[24][L * 4 + h]);
#pragma unroll
        for (int off = 1; off < 64; off <<= 1) { const float u = __shfl_up(v, off); if (lane >= off) v += u; }
        GC[tid] = v; BETA[tid] = sigmoidf_(bi);
    }
    __syncthreads();
    {
        const float gend = GC[63]; const float* cw = a->in[22] + (size_t)L * 4 * 1536;
        float cwq[2][4], cwk[2][4], cwv[2][4];
#pragma unroll
        for (int u = 0; u < 2; ++u)
#pragma unroll
            for (int i = 0; i < 4; ++i) { const int d = lane + 64 * u; cwq[u][i] = cw[i * 1536 + h * 128 + d]; cwk[u][i] = cw[i * 1536 + 512 + h * 128 + d]; cwv[u][i] = cw[i * 1536 + 1024 + h * 128 + d]; }
        const float ng0 = a->in[25][L * 128 + lane], ng1 = a->in[25][L * 128 + 64 + lane];
#pragma unroll 1
        for (int tt = 0; tt < 8; ++tt) {
            const int t = wave * 8 + tt; const float gct = GC[t];
            float q[2], k[2], v[2];
#pragma unroll
            for (int u = 0; u < 2; ++u) { const int d = lane + 64 * u; float sq = 0.f, sk = 0.f, sv = 0.f;
#pragma unroll
                for (int i = 0; i < 4; ++i) { const LAS bf16* rp = RAW + (t + i) * 384 + d; sq += cwq[u][i] * b2f(rp[0]); sk += cwk[u][i] * b2f(rp[128]); sv += cwv[u][i] * b2f(rp[256]); }
                q[u] = sq * sigmoidf_(sq); k[u] = sk * sigmoidf_(sk); v[u] = sv * sigmoidf_(sv); }
            const float rq = (1.0f / sqrtf(wave_sum(q[0] * q[0] + q[1] * q[1]) + 1e-6f)) * 0.08838834764831845f, rk = 1.0f / sqrtf(wave_sum(k[0] * k[0] + k[1] * k[1]) + 1e-6f);
            const float eg = __expf(gct), eh = __expf(gend - gct);
#pragma unroll
            for (int u = 0; u < 2; ++u) { const int d = lane + 64 * u; const float kn = k[u] * rk, qn = q[u] * rq; const bf16 kb = (bf16)f2bf(kn);
                KN[t * P128 + d] = kb; KNT[d * P64 + t] = kb; QN[t * P128 + d] = (bf16)f2bf(qn); KHT[d * P64 + t] = (bf16)f2bf(kn * eh); VT[d * P64 + t] = (bf16)f2bf(v[u]);
                QPg[t * 128 + kperm(d)] = (bf16)f2bf(qn * eg);
                const float gt = b2f(hg[(size_t)(tok0 + t) * LD_GDN + 1544 + h * 128 + d]);
                E[(size_t)(tok0 + t) * 512 + h * 128 + d] = (bf16)f2bf((u ? ng1 : ng0) * gt * sigmoidf_(gt)); }
        }
    }
    __syncthreads();
#pragma unroll
    for (int i = 0; i < 4; ++i) {
        const int idx = wave * 4 + i, kind = idx >> 4, T = (idx >> 2) & 3, Sx = idx & 3;
        f32x4 acc = {0.f, 0.f, 0.f, 0.f};
        if (Sx <= T) acc = mm16<128>(acc, (kind ? QN : KN) + 16 * T * P128, P128, KN + 16 * Sx * P128, P128, lane);
        const int s = 16 * Sx + n; const float gs = GC[s];
#pragma unroll
        for (int r = 0; r < 4; ++r) { const int t = 16 * T + 4 * g + r; const float dec = __expf(fminf(GC[t] - gs, 0.f));
            acc[r] = kind ? (s <= t ? acc[r] * dec : 0.f) : (s < t ? -BETA[t] * acc[r] * dec : 0.f); }
        if (kind) storeR(ATT, P64, 16 * T, 16 * Sx, acc, lane);
        else { storeR(S, P64, 16 * T, 16 * Sx, acc, lane); storeT(ST, P64, 16 * T, 16 * Sx, acc, lane); }
    }
    __syncthreads();
    for (int e = tid; e < 4096; e += NTHREADS) { const int t = e >> 6, s = e & 63; P[t * P64 + s] = (bf16)f2bf((t == s ? 1.f : 0.f) + b2f(S[t * P64 + s])); }
    __syncthreads();
    {
        LAS bf16* cur = S; LAS bf16* curT = ST; LAS bf16* nxt = S2; LAS bf16* nxtT = S2T;
#pragma unroll 1
        for (int k = 0; k < 5; ++k) {
#pragma unroll
            for (int i = 0; i < 2; ++i) { const int idx = wave * 2 + i, T = idx >> 2, Sx = idx & 3; f32x4 acc = {0.f, 0.f, 0.f, 0.f};
                acc = mm16<64>(acc, cur + 16 * T * P64, P64, curT + 16 * Sx * P64, P64, lane);
                storeR(nxt, P64, 16 * T, 16 * Sx, acc, lane); storeT(nxtT, P64, 16 * T, 16 * Sx, acc, lane); }
            __syncthreads();
            f32x4 pacc[2];
#pragma unroll
            for (int i = 0; i < 2; ++i) { const int idx = wave * 2 + i, T = idx >> 2, Sx = idx & 3;
#pragma unroll
                for (int r = 0; r < 4; ++r) pacc[i][r] = b2f(P[(16 * T + 4 * g + r) * P64 + 16 * Sx + n]);
                pacc[i] = mm16<64>(pacc[i], P + 16 * T * P64, P64, nxtT + 16 * Sx * P64, P64, lane); }
            __syncthreads();
#pragma unroll
            for (int i = 0; i < 2; ++i) { const int idx = wave * 2 + i, T = idx >> 2, Sx = idx & 3; storeR(P, P64, 16 * T, 16 * Sx, pacc[i], lane); }
            __syncthreads();
            LAS bf16* t0 = cur; cur = nxt; nxt = t0; LAS bf16* t1 = curT; curT = nxtT; nxtT = t1;
        }
    }
    for (int e = tid; e < 4096; e += NTHREADS) { const int t = e >> 6, s = e & 63; const float p = b2f(P[t * P64 + s]) * BETA[s]; S[t * P64 + s] = (bf16)f2bf(p * __expf(GC[s])); ST[t * P64 + s] = (bf16)f2bf(p); }
    __syncthreads();
#pragma unroll
    for (int i = 0; i < 8; ++i) {
        const int idx = wave * 8 + i, kind = idx >> 5, T = (idx >> 3) & 3, Dt = idx & 7;
        f32x4 acc = {0.f, 0.f, 0.f, 0.f};
        acc = mm16<64>(acc, (kind ? ST : S) + 16 * T * P64, P64, (kind ? VT : KNT) + 16 * Dt * P64, P64, lane);
        storeT(kind ? UT : WT, P64, 16 * T, 16 * Dt, acc, lane);
    }
    __syncthreads();
    const float egend = __expf(GC[63]);
#pragma unroll
    for (int i = 0; i < 8; ++i) {
        const int idx = wave * 8 + i, kind = idx >> 5, Dt = (idx >> 2) & 7, T = idx & 3;
        f32x4 acc = {0.f, 0.f, 0.f, 0.f};
        acc = mm16<64>(acc, (kind ? UT : WT) + 16 * Dt * P64, P64, ATT + 16 * T * P64, P64, lane);
        const int t = 16 * T + n;
        if (kind) *(u32x2*)(Y + (size_t)(tok0 + t) * 512 + h * 128 + 16 * Dt + 4 * g) = pack4(acc);
        else { bf16* qp = QPg + t * 128 + (Dt >> 1) * 32 + 8 * g + 4 * (Dt & 1); const f32x4 q0 = unpack4(*(const u32x2*)qp); *(u32x2*)qp = pack4(q0 - acc); }
    }
#pragma unroll
    for (int i = 0; i < 16; ++i) {
        const int idx = wave * 16 + i, kind = idx >> 6, A8 = (idx >> 3) & 7, B8 = idx & 7;
        f32x4 acc = {0.f, 0.f, 0.f, 0.f};
        if (kind == 0) {
            acc = mm16<64>(acc, WT + 16 * A8 * P64, P64, KHT + 16 * B8 * P64, P64, lane);
            const int ip = 16 * B8 + n;
#pragma unroll
            for (int r = 0; r < 4; ++r) acc[r] = ((16 * A8 + 4 * g + r) == ip ? egend : 0.f) - acc[r];
            *(u32x2*)(MMg + ip * 128 + (A8 >> 1) * 32 + 8 * g + 4 * (A8 & 1)) = pack4(acc);
        } else {
            acc = mm16<64>(acc, KHT + 16 * A8 * P64, P64, UT + 16 * B8 * P64, P64, lane);
            *(u32x2*)(NNg + (size_t)((B8 * 8 + A8) * 64 + lane) * 4) = pack4(acc);
        }
    }
    __syncthreads();
}
__device__ __forceinline__ void m2_gdn(KArgs a, int b, int h, LAS unsigned char* lds, int tid) {
    const int lane = tid & 63, J = tid >> 6, g = lane >> 4, n = lane & 15;
    unsigned char* R = a->ws + WS_R;
    const bf16* QPb = (const bf16*)(R + GDN_QP); const bf16* MMb = (const bf16*)(R + GDN_MM); const bf16* NNb = (const bf16*)(R + GDN_NN); bf16* Y = (bf16*)(a->ws + WS_O) + (size_t)2 * M * 512;
    constexpr int SLOT = 52224;
    f32x4 H[8];
#pragma unroll
    for (int I = 0; I < 8; ++I) H[I] = (f32x4){0.f, 0.f, 0.f, 0.f};
    v4u pre[6]; u32x2 nn[8], nnn[8], yi[4], yin[4];
#define GDN_GLOAD(c, PRE, NNv, YI) do { const int item_ = (b * 64 + (c)) * 4 + h; \
        _Pragma("unroll") for (int u = 0; u < 6; ++u) { const int ch = tid + 512 * u; PRE[u] = ch < 2048 ? *(const v4u*)(MMb + (size_t)item_ * 16384 + ch * 8) : *(const v4u*)(QPb + (size_t)item_ * 8192 + (ch - 2048) * 8); } \
        _Pragma("unroll") for (int I = 0; I < 8; ++I) NNv[I] = *(const u32x2*)(NNb + (size_t)item_ * 16384 + (size_t)((J * 8 + I) * 64 + lane) * 4); \
        _Pragma("unroll") for (int T = 0; T < 4; ++T) YI[T] = *(const u32x2*)(Y + (size_t)((b * 64 + (c)) * 64 + 16 * T + n) * 512 + h * 128 + 16 * J + 4 * g); } while (0)
#define GDN_LWRITE(slot, PRE) do { LAS unsigned char* base_ = lds + (slot) * SLOT; \
        _Pragma("unroll") for (int u = 0; u < 6; ++u) { const int ch = tid + 512 * u; const int cq = ch < 2048 ? ch : ch - 2048; \
            *(LAS v4u*)(base_ + (ch < 2048 ? 0 : 34816) + (cq >> 4) * (P128 * 2) + (cq & 15) * 16) = PRE[u]; } } while (0)
    GDN_GLOAD(0, pre, nn, yi);
    GDN_LWRITE(0, pre);
    __syncthreads();
#pragma unroll 1
    for (int c = 0; c < 64; ++c) {
        if (c + 1 < 64) GDN_GLOAD(c + 1, pre, nnn, yin);
        const LAS bf16* MMs = (const LAS bf16*)(lds + (c & 1) * SLOT); const LAS bf16* QPs = (const LAS bf16*)(lds + (c & 1) * SLOT + 34816);
        bf16x8 bH[4];
#pragma unroll
        for (int s = 0; s < 4; ++s) bH[s] = frag_of(H[2 * s], H[2 * s + 1]);
#pragma unroll
        for (int T = 0; T < 4; ++T) {
            f32x4 acc = unpack4(yi[T]);
#pragma unroll
            for (int s = 0; s < 4; ++s) acc = mfma16(bH[s], *(const LAS bf16x8*)(QPs + (16 * T + n) * P128 + 32 * s + 8 * g), acc);
            *(u32x2*)(Y + (size_t)((b * 64 + c) * 64 + 16 * T + n) * 512 + h * 128 + 16 * J + 4 * g) = pack4(acc);
        }
#pragma unroll
        for (int I = 0; I < 8; ++I) {
            f32x4 acc = unpack4(nn[I]);
#pragma unroll
            for (int s = 0; s < 4; ++s) acc = mfma16(*(const LAS bf16x8*)(MMs + (16 * I + n) * P128 + 32 * s + 8 * g), bH[s], acc);
            H[I] = acc;
        }
        if (c + 1 < 64) GDN_LWRITE((c + 1) & 1, pre);
        __syncthreads();
#pragma unroll
        for (int I = 0; I < 8; ++I) nn[I] = nnn[I];
#pragma unroll
        for (int T = 0; T < 4; ++T) yi[T] = yin[T];
    }
#undef GDN_GLOAD
#undef GDN_LWRITE
}
#ifndef RW_REP
#define RW_REP 0
#endif
constexpr size_t RW_RP = 64 * MiB, RW_MM = 80 * MiB, RW_NN = 96 * MiB, RW_E1 = 112 * MiB, RW_E2 = 128 * MiB, RW_DC = 144 * MiB;
constexpr int P160 = 168;
template <int K> __device__ __forceinline__ f32x4 mm16g(f32x4 acc, const LAS bf16* Ap, int pa, const bf16* Bg, int pbg, int lane) {
    const LAS bf16* a = Ap + (lane & 15) * pa + 8 * (lane >> 4); const bf16* b = Bg + (size_t)(lane & 15) * pbg + 8 * (lane >> 4);
#pragma unroll
    for (int kk = 0; kk < K; kk += 32) acc = mfma16(*(const LAS bf16x8*)(a + kk), *(const bf16x8*)(b + kk), acc);
    return acc;
}
__device__ __forceinline__ void tri_inv(LAS bf16* S, LAS bf16* ST, LAS bf16* S2, LAS bf16* S2T, LAS bf16* P, int wave, int lane, int tid) {
    const int g = lane >> 4, n = lane & 15;
    for (int e = tid; e < 4096; e += NTHREADS) { const int t = e >> 6, s = e & 63; P[t * P64 + s] = (bf16)f2bf((t == s ? 1.f : 0.f) + b2f(S[t * P64 + s])); }
    __syncthreads();
    LAS bf16* cur = S; LAS bf16* curT = ST; LAS bf16* nxt = S2; LAS bf16* nxtT = S2T;
#pragma unroll 1
    for (int k = 0; k < 5; ++k) {
#pragma unroll
        for (int i = 0; i < 2; ++i) { const int idx = wave * 2 + i, T = idx >> 2, Sx = idx & 3; f32x4 acc = {0.f, 0.f, 0.f, 0.f};
            acc = mm16<64>(acc, cur + 16 * T * P64, P64, curT + 16 * Sx * P64, P64, lane);
            storeR(nxt, P64, 16 * T, 16 * Sx, acc, lane); storeT(nxtT, P64, 16 * T, 16 * Sx, acc, lane); }
        __syncthreads();
        f32x4 pacc[2];
#pragma unroll
        for (int i = 0; i < 2; ++i) { const int idx = wave * 2 + i, T = idx >> 2, Sx = idx & 3;
#pragma unroll
            for (int r = 0; r < 4; ++r) pacc[i][r] = b2f(P[(16 * T + 4 * g + r) * P64 + 16 * Sx + n]);
            pacc[i] = mm16<64>(pacc[i], P + 16 * T * P64, P64, nxtT + 16 * Sx * P64, P64, lane); }
        __syncthreads();
#pragma unroll
        for (int i = 0; i < 2; ++i) { const int idx = wave * 2 + i, T = idx >> 2, Sx = idx & 3; storeR(P, P64, 16 * T, 16 * Sx, pacc[i], lane); }
        __syncthreads();
        LAS bf16* t0 = cur; cur = nxt; nxt = t0; LAS bf16* t1 = curT; curT = nxtT; nxtT = t1;
    }
}
__device__ __forceinline__ void m1_rw(KArgs a, int L, int item, LAS unsigned char* lds, int tid, int wv, const bf16x8 (&fw)[2], const bf16x8 (&fg)[5], float bias01) {
    const int lane = tid & 63, wave = tid >> 6, g = lane >> 4, n = lane & 15, h = item & 7, bc = item >> 3, c = bc & 63, tok0 = bc * 64;
    unsigned char* R = a->ws + WS_R; unsigned char* wb = a->ws + WS_W;
    const bf16* hr = (const bf16*)R; bf16* RPg = (bf16*)(R + RW_RP) + (size_t)item * 4096; bf16* MMg = (bf16*)(R + RW_MM) + (size_t)item * 4096; bf16* NNg = (bf16*)(R + RW_NN) + (size_t)item * 4096;
    bf16* E1 = (bf16*)(R + RW_E1); bf16* E2 = (bf16*)(R + RW_E2); bf16* Y = (bf16*)(a->ws + WS_O); float* DCg = (float*)(R + RW_DC) + (size_t)item * 64;
    const float* mu = a->in[8] + L * 1824;
    LAS bf16* ATr = (LAS bf16*)lds; LAS bf16* BTr = ATr + 64 * P64; LAS bf16* KTr = BTr + 64 * P64; LAS bf16* RTr = KTr + 64 * P64;
    LAS bf16* ATt = RTr + 64 * P64; LAS bf16* VTt = ATt + 64 * P64; LAS bf16* BHt = VTt + 64 * P64; LAS bf16* KHt = BHt + 64 * P64;
    LAS bf16* S = KHt + 64 * P64; LAS bf16* ST = S + 64 * P64; LAS bf16* S2 = ST + 64 * P64; LAS bf16* S2T = S2 + 64 * P64; LAS bf16* P = S2T + 64 * P64;
    LAS bf16* AAK = P + 64 * P64; LAS bf16* ARB = AAK + 64 * P64; LAS bf16* ARK = ARB + 64 * P64;
    LAS bf16* WT = ATr; LAS bf16* UT = BTr; LAS bf16* XT = KTr;
    LAS bf16* TW = S; LAS bf16* AL = ST; LAS bf16* GL = S2;
    constexpr int PL = 65;
    LAS float* LW = (LAS float*)(lds + 73728 + 39936); LAS float* ASIG = LW + 64 * PL;
    LAS bf16* RAW = (LAS bf16*)(lds + 73728);
    v4u rawv[4];
#pragma unroll
    for (int q_ = 0; q_ < 4; ++q_) {
        const int ch = tid + NTHREADS * q_; rawv[q_] = (v4u){0u, 0u, 0u, 0u};
        if (ch < 65 * 24) { const int rr = ch / 24, cc = (ch % 24) * 8; const int sc = (cc >> 6) * 512 + h * 64 + (cc & 63);
            if (c * 64 + rr > 0) rawv[q_] = *(const v4u*)(hr + (size_t)(tok0 - 1 + rr) * LD_RW + sc); }
    }
#pragma unroll 1
    for (int qb = 0; qb < 6; qb += 3) {
        v4u cwv[3], pwv[3];
#pragma unroll
        for (int q_ = 0; q_ < 3; ++q_) {
            const int ch = tid + NTHREADS * (qb + q_); cwv[q_] = (v4u){0u, 0u, 0u, 0u}; pwv[q_] = (v4u){0u, 0u, 0u, 0u};
            if (ch < 64 * 36) { const int t = ch / 36, cc = (ch % 36) * 8; const size_t ro = (size_t)(tok0 + t) * LD_RW + 1536 + cc;
                cwv[q_] = *(const v4u*)(hr + ro); if (c * 64 + t > 0) pwv[q_] = *(const v4u*)(hr + ro - LD_RW); }
        }
#pragma unroll
        for (int q_ = 0; q_ < 3; ++q_) {
            const int ch = tid + NTHREADS * (qb + q_);
            if (ch < 64 * 36) {
                const int t = ch / 36, cc = (ch % 36) * 8;
                const f32x4 m0 = *(const f32x4*)(mu + 1536 + cc), m1 = *(const f32x4*)(mu + 1536 + cc + 4);
                const float mv[8] = {m0[0], m0[1], m0[2], m0[3], m1[0], m1[1], m1[2], m1[3]};
                const unsigned cu[4] = {cwv[q_].x, cwv[q_].y, cwv[q_].z, cwv[q_].w}, pu[4] = {pwv[q_].x, pwv[q_].y, pwv[q_].z, pwv[q_].w};
#pragma unroll
                for (int e = 0; e < 8; ++e) {
                    const float cur = (e & 1) ? __uint_as_float(cu[e >> 1] & 0xffff0000u) : __uint_as_float(cu[e >> 1] << 16), prv = (e & 1) ? __uint_as_float(pu[e >> 1] & 0xffff0000u) : __uint_as_float(pu[e >> 1] << 16);
                    const int col = cc + e; const float xs = cur + (prv - cur) * mv[e];
                    if (col < 64) TW[t * P64 + col] = (bf16)f2bf(tanhf_(xs)); else if (col < 128) AL[t * P64 + col - 64] = (bf16)f2bf(xs); else GL[t * P160 + col - 128] = (bf16)f2bf(sigmoidf_(xs));
                }
            }
        }
    }
    __syncthreads();
    {
        const int kind = wv >> 2, j = 16 * (wv & 3) + n;
#pragma unroll
        for (int T = 0; T < 4; ++T) {
            const LAS bf16* ap_ = (kind ? AL : TW) + (16 * T + n) * P64 + 8 * g;
            f32x4 acc = {0.f, 0.f, 0.f, 0.f};
            acc = mfma16(*(const LAS bf16x8*)ap_, fw[0], acc); acc = mfma16(*(const LAS bf16x8*)(ap_ + 32), fw[1], acc);
#pragma unroll
            for (int r = 0; r < 4; ++r) { const int t = 16 * T + 4 * g + r; const float w = acc[r] + bias01;
                if (kind == 0) LW[t * PL + j] = -__expf(-softplusf_(-w) - 0.5f); else ASIG[t * PL + j] = sigmoidf_(w); }
        }
        const int jg = 16 * (wv >> 1) + n;
#pragma unroll
        for (int i = 0; i < 2; ++i) {
            const int T = 2 * (wv & 1) + i; const LAS bf16* ap_ = GL + (16 * T + n) * P160 + 8 * g;
            f32x4 acc = {0.f, 0.f, 0.f, 0.f};
#pragma unroll
            for (int s_ = 0; s_ < 5; ++s_) acc = mfma16(*(const LAS bf16x8*)(ap_ + 32 * s_), fg[s_], acc);
#pragma unroll
            for (int r = 0; r < 4; ++r) E1[(size_t)(tok0 + 16 * T + 4 * g + r) * 512 + h * 64 + jg] = (bf16)f2bf(acc[r]);
        }
    }
    __syncthreads();
#pragma unroll
    for (int q_ = 0; q_ < 4; ++q_) { const int ch = tid + NTHREADS * q_; if (ch < 65 * 24) *(LAS v4u*)(RAW + (ch / 24) * 192 + (ch % 24) * 8) = rawv[q_]; }
    {
        float cv[8];
#pragma unroll
        for (int cc = 0; cc < 8; ++cc) cv[cc] = LW[lane * PL + wave * 8 + cc];
#pragma unroll
        for (int off = 1; off < 64; off <<= 1) {
#pragma unroll
            for (int cc = 0; cc < 8; ++cc) { const float u = __shfl_up(cv[cc], off); if (lane >= off) cv[cc] += u; }
        }
#pragma unroll
        for (int cc = 0; cc < 8; ++cc) LW[lane * PL + wave * 8 + cc] = cv[cc];
    }
    __syncthreads();
    for (int rep_ = 0; rep_ < ((RW_REP & 2) ? 3 : 1); ++rep_) {
    {
        const int hj = L * 512 + h * 64 + lane;
        const float kkj = a->in[14][hj], kaj = a->in[15][hj], rkj = a->in[16][hj], gngj = a->in[17][hj], gnbj = a->in[18][hj];
        const float mur = mu[h * 64 + lane], muk = mu[512 + h * 64 + lane], muv = mu[1024 + h * 64 + lane];
        const float cend = LW[63 * PL + lane];
        if (wave == 0) DCg[lane] = __expf(cend);
#pragma unroll 2
        for (int tt = 0; tt < 8; ++tt) {
            const int t = wave * 8 + tt; const LAS bf16* rp = RAW + t * 192 + lane;
            const float rc = b2f(rp[192]), kc = b2f(rp[192 + 64]), vc = b2f(rp[192 + 128]), rpv = b2f(rp[0]), kpv = b2f(rp[64]), vpv = b2f(rp[128]);
            const float r = rc + (rpv - rc) * mur, kr = kc + (kpv - kc) * muk, v = vc + (vpv - vc) * muv;
            const float C = LW[t * PL + lane], Cm = t > 0 ? LW[(t - 1) * PL + lane] : 0.f, asig = ASIG[t * PL + lane];
            const float kkr = kr * kkj, kk = kkr * (1.0f / sqrtf(wave_sum(kkr * kkr) + 1e-6f));
            const float k2 = kr * (1.f + (asig - 1.f) * kaj), av = -kk, bv = kk * asig;
            const float bon = wave_sum(r * k2 * rkj) * v;
            const float eC = __expf(C), eCm = __expf(Cm), eN = __expf(-C), eE = __expf(cend - C);
            const bf16 ab = (bf16)f2bf(av * eCm), rb = (bf16)f2bf(r * eC);
            ATr[t * P64 + lane] = ab; ATt[lane * P64 + t] = ab; BTr[t * P64 + lane] = (bf16)f2bf(bv * eN); KTr[t * P64 + lane] = (bf16)f2bf(k2 * eN); RTr[t * P64 + lane] = rb;
            VTt[lane * P64 + t] = (bf16)f2bf(v); BHt[lane * P64 + t] = (bf16)f2bf(bv * eE); KHt[lane * P64 + t] = (bf16)f2bf(k2 * eE);
            RPg[t * 64 + kperm(lane)] = rb;
            if (rep_ == 0) { const size_t eo = (size_t)(tok0 + t) * 512 + h * 64 + lane; const float gg = b2f(E1[eo]);
            E1[eo] = (bf16)f2bf(gngj * gg); E2[eo] = (bf16)f2bf((gnbj + bon) * gg); }
        }
    }
    }
    __syncthreads();
    for (int rep_ = 0; rep_ < ((RW_REP & 4) ? 3 : 1); ++rep_) {
#pragma unroll
    for (int i = 0; i < 8; ++i) {
        const int idx = wave * 8 + i, kind = idx >> 4, T = (idx >> 2) & 3, Sx = idx & 3;
        f32x4 acc = {0.f, 0.f, 0.f, 0.f};
        if (Sx <= T) acc = mm16<64>(acc, ((kind & 2) ? RTr : ATr) + 16 * T * P64, P64, ((kind & 1) ? KTr : BTr) + 16 * Sx * P64, P64, lane);
        const int s = 16 * Sx + n;
#pragma unroll
        for (int r = 0; r < 4; ++r) { const int t = 16 * T + 4 * g + r; if ((kind & 2) ? (s > t) : (s >= t)) acc[r] = 0.f; }
        if (kind == 0) { storeR(S, P64, 16 * T, 16 * Sx, acc, lane); storeT(ST, P64, 16 * T, 16 * Sx, acc, lane); }
        else storeR(kind == 1 ? AAK : (kind == 2 ? ARB : ARK), P64, 16 * T, 16 * Sx, acc, lane);
    }
    }
    __syncthreads();
    for (int rep_ = 0; rep_ < ((RW_REP & 8) ? 3 : 1); ++rep_) {
    if (rep_ > 0) {
#pragma unroll
    for (int i = 0; i < 8; ++i) {
        const int idx = wave * 8 + i, kind = idx >> 4, T = (idx >> 2) & 3, Sx = idx & 3;
        f32x4 acc = {0.f, 0.f, 0.f, 0.f};
        if (Sx <= T) acc = mm16<64>(acc, ((kind & 2) ? RTr : ATr) + 16 * T * P64, P64, ((kind & 1) ? KTr : BTr) + 16 * Sx * P64, P64, lane);
        const int s = 16 * Sx + n;
#pragma unroll
        for (int r = 0; r < 4; ++r) { const int t = 16 * T + 4 * g + r; if ((kind & 2) ? (s > t) : (s >= t)) acc[r] = 0.f; }
        if (kind == 0) { storeR(S, P64, 16 * T, 16 * Sx, acc, lane); storeT(ST, P64, 16 * T, 16 * Sx, acc, lane); }
        else storeR(kind == 1 ? AAK : (kind == 2 ? ARB : ARK), P64, 16 * T, 16 * Sx, acc, lane);
    }
        }
    tri_inv(S, ST, S2, S2T, P, wave, lane, tid);
    }
    for (int rep_ = 0; rep_ < ((RW_REP & 16) ? 3 : 1); ++rep_) {
#pragma unroll
    for (int i = 0; i < 4; ++i) {
        const int idx = wave * 4 + i, kind = idx >> 4, T = (idx >> 2) & 3, Dt = idx & 3;
        f32x4 acc = {0.f, 0.f, 0.f, 0.f};
        acc = mm16<64>(acc, (kind ? P : AAK) + 16 * T * P64, P64, (kind ? ATt : VTt) + 16 * Dt * P64, P64, lane);
        storeT(kind ? WT : XT, P64, 16 * T, 16 * Dt, acc, lane);
    }
    __syncthreads();
#pragma unroll
    for (int i = 0; i < 2; ++i) {
        const int idx = wave * 2 + i, T = idx >> 2, Dt = idx & 3;
        f32x4 acc = {0.f, 0.f, 0.f, 0.f};
        acc = mm16<64>(acc, P + 16 * T * P64, P64, XT + 16 * Dt * P64, P64, lane);
        storeT(UT, P64, 16 * T, 16 * Dt, acc, lane);
    }
    __syncthreads();
    }
    for (int rep_ = 0; rep_ < ((RW_REP & 32) ? 3 : 1); ++rep_) {
#pragma unroll
    for (int i = 0; i < 8; ++i) {
        const int idx = wave * 8 + i, kind = idx >> 4, A4 = (idx >> 2) & 3, B4 = idx & 3;
        f32x4 acc = {0.f, 0.f, 0.f, 0.f};
        if (kind == 0) {
            acc = mm16<64>(acc, WT + 16 * A4 * P64, P64, ARB + 16 * B4 * P64, P64, lane);
            bf16* rp = RPg + (16 * B4 + n) * 64 + (A4 >> 1) * 32 + 8 * g + 4 * (A4 & 1); const f32x4 r0 = unpack4(*(const u32x2*)rp); if (rep_ == 0) *(u32x2*)rp = pack4(r0 + acc);
        } else if (kind == 1) {
            acc = mm16<64>(acc, UT + 16 * A4 * P64, P64, ARB + 16 * B4 * P64, P64, lane);
            acc = mm16<64>(acc, VTt + 16 * A4 * P64, P64, ARK + 16 * B4 * P64, P64, lane);
            *(u32x2*)(Y + (size_t)(tok0 + 16 * B4 + n) * 512 + h * 64 + 16 * A4 + 4 * g) = pack4(acc);
        } else if (kind == 2) {
            acc = mm16<64>(acc, WT + 16 * A4 * P64, P64, BHt + 16 * B4 * P64, P64, lane);
            const int ip = 16 * B4 + n; const float dc = DCg[ip];
#pragma unroll
            for (int r = 0; r < 4; ++r) if (16 * A4 + 4 * g + r == ip) acc[r] += dc;
            *(u32x2*)(MMg + ip * 64 + (A4 >> 1) * 32 + 8 * g + 4 * (A4 & 1)) = pack4(acc);
        } else {
            acc = mm16<64>(acc, BHt + 16 * A4 * P64, P64, UT + 16 * B4 * P64, P64, lane);
            acc = mm16<64>(acc, KHt + 16 * A4 * P64, P64, VTt + 16 * B4 * P64, P64, lane);
            *(u32x2*)(NNg + (size_t)((B4 * 4 + A4) * 64 + lane) * 4) = pack4(acc);
        }
    }
    }
    __syncthreads();
}
__device__ __forceinline__ void m2_rw(KArgs a, int b, int h, int tid) {
    const int lane = tid & 63, J = tid >> 6, g = lane >> 4, n = lane & 15;
    if (J >= 4) return;
    unsigned char* R = a->ws + WS_R;
    const bf16* RPb = (const bf16*)(R + RW_RP); const bf16* MMb = (const bf16*)(R + RW_MM); const bf16* NNb = (const bf16*)(R + RW_NN); bf16* Y = (bf16*)(a->ws + WS_O);
    f32x4 H[4];
#pragma unroll
    for (int I = 0; I < 4; ++I) H[I] = (f32x4){0.f, 0.f, 0.f, 0.f};
    bf16x8 bq[4][2], bqn[4][2];
#define RW_LOAD(c, BQ) do { const bf16* rp_ = RPb + (size_t)((b * 64 + (c)) * 8 + h) * 4096 + n * 64 + 8 * g; \
        _Pragma("unroll") for (int T = 0; T < 4; ++T) { _Pragma("unroll") for (int s = 0; s < 2; ++s) BQ[T][s] = *(const bf16x8*)(rp_ + T * 1024 + 32 * s); } } while (0)
    RW_LOAD(0, bq);
#pragma unroll 1
    for (int c = 0; c < 64; ++c) {
        const int item = (b * 64 + c) * 8 + h;
        bf16x8 am[4][2]; u32x2 yi[4], nn[4];
        { const bf16* mp_ = MMb + (size_t)item * 4096 + n * 64 + 8 * g; bf16* yp_ = Y + (size_t)((b * 64 + c) * 64 + n) * 512 + h * 64 + 16 * J + 4 * g; const bf16* np_ = NNb + (size_t)item * 4096 + (size_t)(J * 4 * 64 + lane) * 4;
#pragma unroll
          for (int T = 0; T < 4; ++T) { am[T][0] = *(const bf16x8*)(mp_ + T * 1024); am[T][1] = *(const bf16x8*)(mp_ + T * 1024 + 32); yi[T] = *(const u32x2*)(yp_ + (size_t)T * 16 * 512); nn[T] = *(const u32x2*)(np_ + T * 256); } }
        if (c + 1 < 64) RW_LOAD(c + 1, bqn);
        const bf16x8 h0 = frag_of(H[0], H[1]), h1 = frag_of(H[2], H[3]);
#pragma unroll
        for (int T = 0; T < 4; ++T) {
            f32x4 acc = {0.f, 0.f, 0.f, 0.f};
            acc = mfma16(h0, bq[T][0], acc); acc = mfma16(h1, bq[T][1], acc);
            *(u32x2*)(Y + (size_t)((b * 64 + c) * 64 + 16 * T + n) * 512 + h * 64 + 16 * J + 4 * g) = pack4(acc + unpack4(yi[T]));
        }
#pragma unroll
        for (int I = 0; I < 4; ++I) { f32x4 acc = {0.f, 0.f, 0.f, 0.f}; acc = mfma16(am[I][0], h0, acc); acc = mfma16(am[I][1], h1, acc); H[I] = acc + unpack4(nn[I]); }
#pragma unroll
        for (int T = 0; T < 4; ++T) { bq[T][0] = bqn[T][0]; bq[T][1] = bqn[T][1]; }
    }
#undef RW_LOAD
}
__device__ __forceinline__ void m3_rw(bf16* Y, const bf16* E1, const bf16* E2, int gw, int NGW, int lane) {
    for (int m = gw; m < M; m += NGW) {
        const v4u yw = *(const v4u*)(Y + (size_t)m * 512 + lane * 8), e1w = *(const v4u*)(E1 + (size_t)m * 512 + lane * 8), e2w = *(const v4u*)(E2 + (size_t)m * 512 + lane * 8);
        const unsigned yu[4] = {yw.x, yw.y, yw.z, yw.w}, e1u[4] = {e1w.x, e1w.y, e1w.z, e1w.w}, e2u[4] = {e2w.x, e2w.y, e2w.z, e2w.w};
        float y[8], e1[8], e2[8];
#pragma unroll
        for (int i = 0; i < 4; ++i) { y[2 * i] = __uint_as_float(yu[i] << 16); y[2 * i + 1] = __uint_as_float(yu[i] & 0xffff0000u); e1[2 * i] = __uint_as_float(e1u[i] << 16); e1[2 * i + 1] = __uint_as_float(e1u[i] & 0xffff0000u);
            e2[2 * i] = __uint_as_float(e2u[i] << 16); e2[2 * i + 1] = __uint_as_float(e2u[i] & 0xffff0000u); }
        float sm = 0.f;
#pragma unroll
        for (int i = 0; i < 8; ++i) sm += y[i];
        sm += __shfl_xor(sm, 1); sm += __shfl_xor(sm, 2); sm += __shfl_xor(sm, 4);
        const float mean = sm * (1.f / 64.f); float sq = 0.f;
#pragma unroll
        for (int i = 0; i < 8; ++i) { y[i] -= mean; sq += y[i] * y[i]; }
        sq += __shfl_xor(sq, 1); sq += __shfl_xor(sq, 2); sq += __shfl_xor(sq, 4);
        const float rs = 1.0f / sqrtf(sq * (1.f / 64.f) + 64e-5f);
        v4u o; o.x = pk2(y[0] * rs * e1[0] + e2[0], y[1] * rs * e1[1] + e2[1]); o.y = pk2(y[2] * rs * e1[2] + e2[2], y[3] * rs * e1[3] + e2[3]);
        o.z = pk2(y[4] * rs * e1[4] + e2[4], y[5] * rs * e1[5] + e2[5]); o.w = pk2(y[6] * rs * e1[6] + e2[6], y[7] * rs * e1[7] + e2[7]);
        *(v4u*)(Y + (size_t)m * 512 + lane * 8) = o;
    }
}
constexpr size_t RW_HS = RW_NN, GLA_HS = GLA_NN, GDN_HS = GDN_MM;
__device__ __forceinline__ void scan_rw(KArgs a, int b, int h, int tid) {
    const int lane = tid & 63, J = tid >> 6, g = lane >> 4, n = lane & 15;
    if (J >= 4) return;
    unsigned char* R = a->ws + WS_R;
    const bf16* MMb = (const bf16*)(R + RW_MM); const bf16* NNb = (const bf16*)(R + RW_NN); bf16* HSb = (bf16*)(R + RW_HS);
    f32x4 H[4];
#pragma unroll
    for (int I = 0; I < 4; ++I) H[I] = (f32x4){0.f, 0.f, 0.f, 0.f};
    bf16x8 am[4][4][2]; u32x2 nn[4][4];
#define SRW_LOAD(c, u) do { const int item_ = (b * 64 + (c)) * 8 + h; const bf16* mp_ = MMb + (size_t)item_ * 4096 + n * 64 + 8 * g; const bf16* np_ = NNb + (size_t)item_ * 4096 + (size_t)(J * 4 * 64 + lane) * 4; \
        _Pragma("unroll") for (int T = 0; T < 4; ++T) { am[u][T][0] = *(const bf16x8*)(mp_ + T * 1024); am[u][T][1] = *(const bf16x8*)(mp_ + T * 1024 + 32); nn[u][T] = *(const u32x2*)(np_ + T * 256); } } while (0)
    SRW_LOAD(0, 0); SRW_LOAD(1, 1); SRW_LOAD(2, 2);
#pragma unroll 1
    for (int c4 = 0; c4 < 64; c4 += 4) {
#pragma unroll
        for (int u = 0; u < 4; ++u) {
            const int c = c4 + u;
            SRW_LOAD(c + 3 < 64 ? c + 3 : 63, (u + 3) & 3);
            const bf16x8 h0 = frag_of(H[0], H[1]), h1 = frag_of(H[2], H[3]);
            bf16* hs = HSb + (size_t)((b * 64 + c) * 8 + h) * 4096 + (16 * J + n) * 64 + 8 * g;
#pragma unroll
            for (int I = 0; I < 4; ++I) { f32x4 acc = unpack4(nn[u][I]); acc = mfma16(am[u][I][0], h0, acc); acc = mfma16(am[u][I][1], h1, acc); H[I] = acc; }
            *(bf16x8*)hs = h0; *(bf16x8*)(hs + 32) = h1;
        }
    }
#undef SRW_LOAD
}
__device__ __forceinline__ void scan_gla(KArgs a, int b, int h, int tid) {
    const int lane = tid & 63, J = tid >> 6, g = lane >> 4, n = lane & 15;
    unsigned char* R = a->ws + WS_R;
    const bf16* NNb = (const bf16*)(R + GLA_NN); const float* DECb = (const float*)(R + GLA_DEC); bf16* HSb = (bf16*)(R + GLA_HS);
    f32x4 H[4];
#pragma unroll
    for (int I = 0; I < 4; ++I) H[I] = (f32x4){0.f, 0.f, 0.f, 0.f};
    f32x4 dc[4][4]; u32x2 nn[4][4];
#define SGL_LOAD(c, u) do { const int item_ = (b * 64 + (c)) * 4 + h; \
        _Pragma("unroll") for (int I = 0; I < 4; ++I) { nn[u][I] = *(const u32x2*)(NNb + (size_t)item_ * 8192 + (size_t)((J * 4 + I) * 64 + lane) * 4); dc[u][I] = *(const f32x4*)(DECb + item_ * 64 + 16 * I + 4 * g); } } while (0)
    SGL_LOAD(0, 0); SGL_LOAD(1, 1); SGL_LOAD(2, 2);
#pragma unroll 1
    for (int c4 = 0; c4 < 64; c4 += 4) {
#pragma unroll
        for (int u = 0; u < 4; ++u) {
            const int c = c4 + u;
            SGL_LOAD(c + 3 < 64 ? c + 3 : 63, (u + 3) & 3);
            bf16* hs = HSb + (size_t)((b * 64 + c) * 4 + h) * 8192 + (16 * J + n) * 64 + 8 * g;
            const bf16x8 h0 = frag_of(H[0], H[1]), h1 = frag_of(H[2], H[3]);
#pragma unroll
            for (int I = 0; I < 4; ++I) H[I] = H[I] * dc[u][I] + unpack4(nn[u][I]);
            *(bf16x8*)hs = h0; *(bf16x8*)(hs + 32) = h1;
        }
    }
#undef SGL_LOAD
}
__device__ __forceinline__ void scan_gdn(KArgs a, int b, int h, LAS unsigned char* lds, int tid) {
    const int lane = tid & 63, J = tid >> 6, g = lane >> 4, n = lane & 15;
    unsigned char* R = a->ws + WS_R;
    const bf16* MMb = (const bf16*)(R + GDN_MM); const bf16* NNb = (const bf16*)(R + GDN_NN); bf16* HSb = (bf16*)(R + GDN_HS);
    constexpr int SLOT = 128 * P128 * 2;
    f32x4 H[8];
#pragma unroll
    for (int I = 0; I < 8; ++I) H[I] = (f32x4){0.f, 0.f, 0.f, 0.f};
    v4u pre[2][4]; u32x2 nn[4][8];
#define SGD_MLOAD(c, v) do { const bf16* mp_ = MMb + (size_t)((b * 64 + (c)) * 4 + h) * 16384; _Pragma("unroll") for (int q_ = 0; q_ < 4; ++q_) pre[v][q_] = *(const v4u*)(mp_ + (size_t)(tid + 512 * q_) * 8); } while (0)
#define SGD_MWRITE(slot, v) do { LAS unsigned char* base_ = lds + (slot) * SLOT; _Pragma("unroll") for (int q_ = 0; q_ < 4; ++q_) { const int ch = tid + 512 * q_; *(LAS v4u*)(base_ + (ch >> 4) * (P128 * 2) + (ch & 15) * 16) = pre[v][q_]; } } while (0)
#define SGD_NLOAD(c, u) do { const bf16* np_ = NNb + (size_t)((b * 64 + (c)) * 4 + h) * 16384 + (size_t)(J * 8 * 64 + lane) * 4; _Pragma("unroll") for (int I = 0; I < 8; ++I) nn[u][I] = *(const u32x2*)(np_ + I * 256); } while (0)
    SGD_MLOAD(0, 0); SGD_MLOAD(1, 1); SGD_NLOAD(0, 0); SGD_NLOAD(1, 1); SGD_NLOAD(2, 2);
    SGD_MWRITE(0, 0);
    __syncthreads();
#pragma unroll 1
    for (int c4 = 0; c4 < 64; c4 += 4) {
#pragma unroll
        for (int u = 0; u < 4; ++u) {
            const int c = c4 + u;
            SGD_MLOAD(c + 2 < 64 ? c + 2 : 63, u & 1);
            SGD_NLOAD(c + 3 < 64 ? c + 3 : 63, (u + 3) & 3);
            const LAS bf16* MMs = (const LAS bf16*)(lds + (c & 1) * SLOT);
            bf16x8 bH[4];
#pragma unroll
            for (int s = 0; s < 4; ++s) bH[s] = frag_of(H[2 * s], H[2 * s + 1]);
            bf16* hs = HSb + (size_t)((b * 64 + c) * 4 + h) * 16384 + (16 * J + n) * 128 + 8 * g;
#pragma unroll
            for (int s = 0; s < 4; ++s) *(bf16x8*)(hs + 32 * s) = bH[s];
#pragma unroll
            for (int I = 0; I < 8; ++I) {
                f32x4 acc = unpack4(nn[u][I]);
#pragma unroll
                for (int s = 0; s < 4; ++s) acc = mfma16(*(const LAS bf16x8*)(MMs + (16 * I + n) * P128 + 32 * s + 8 * g), bH[s], acc);
                H[I] = acc;
            }
            SGD_MWRITE((c + 1) & 1, (u + 1) & 1);
            __syncthreads();
        }
    }
#undef SGD_MLOAD
#undef SGD_MWRITE
#undef SGD_NLOAD
}
template <int KIND> __device__ __forceinline__ void yout(KArgs a, int gw, int NGW, int lane) {
    constexpr int NH = KIND == 0 ? 8 : 4, CH_ = KIND == 0 ? 64 : 128, NJ = CH_ / 16, KK = KIND == 2 ? 128 : 64, NS = KK / 32;
    const int g = lane >> 4, n = lane & 15;
    unsigned char* R = a->ws + WS_R;
    const bf16* HSb = (const bf16*)(R + (KIND == 0 ? RW_HS : (KIND == 1 ? GLA_HS : GDN_HS)));
    const bf16* QPb = (const bf16*)(R + (KIND == 0 ? RW_RP : (KIND == 1 ? GLA_QP : GDN_QP)));
    const bf16* E1 = (const bf16*)(R + (KIND == 0 ? RW_E1 : (KIND == 1 ? GLA_E : GDN_E))); const bf16* E2 = (const bf16*)(R + RW_E2);
    bf16* Y = (bf16*)(a->ws + WS_O) + (size_t)KIND * M * 512;
    const int njobs = (M / 64) * NH * 4;
    for (int job = gw; job < njobs; job += NGW) {
        const int item = job >> 2, T = job & 3, h = item % NH, bc = item / NH;
        const bf16* qp = QPb + (size_t)item * (64 * KK) + (16 * T + n) * KK + 8 * g;
        const bf16* hs = HSb + (size_t)item * (CH_ * KK) + n * KK + 8 * g;
        const size_t yo = (size_t)(bc * 64 + 16 * T + n) * 512 + h * CH_ + 4 * g;
        bf16x8 bq[NS];
#pragma unroll
        for (int s = 0; s < NS; ++s) bq[s] = *(const bf16x8*)(qp + 32 * s);
        f32x4 acc[NJ];
#pragma unroll
        for (int jt = 0; jt < NJ; ++jt) {
            acc[jt] = unpack4(*(const u32x2*)(Y + yo + 16 * jt));
#pragma unroll
            for (int s = 0; s < NS; ++s) acc[jt] = mfma16(*(const bf16x8*)(hs + (size_t)jt * 16 * KK + 32 * s), bq[s], acc[jt]);
        }
        float s1 = 0.f;
        if (KIND == 0) {
#pragma unroll
            for (int jt = 0; jt < NJ; ++jt) s1 += (acc[jt][0] + acc[jt][1]) + (acc[jt][2] + acc[jt][3]);
            s1 += __shfl_xor(s1, 16); s1 += __shfl_xor(s1, 32);
            s1 *= (1.f / CH_);
        }
        float s2 = 0.f;
#pragma unroll
        for (int jt = 0; jt < NJ; ++jt) { acc[jt] = acc[jt] - s1; s2 += (acc[jt][0] * acc[jt][0] + acc[jt][1] * acc[jt][1]) + (acc[jt][2] * acc[jt][2] + acc[jt][3] * acc[jt][3]); }
        s2 += __shfl_xor(s2, 16); s2 += __shfl_xor(s2, 32);
        const float rs = 1.0f / sqrtf(s2 * (1.f / CH_) + (KIND == 0 ? 64e-5f : 1e-6f));
#pragma unroll
        for (int jt = 0; jt < NJ; ++jt) {
            f32x4 o = acc[jt] * rs * unpack4(*(const u32x2*)(E1 + yo + 16 * jt));
            if (KIND == 0) o = o + unpack4(*(const u32x2*)(E2 + yo + 16 * jt));
            *(u32x2*)(Y + yo + 16 * jt) = pack4(o);
        }
    }
}
constexpr int PH_PER_LAYER = 21, N_PHASES = 1 + DEPTH * PH_PER_LAYER;
#ifndef MK_SINGLE
#define MK_SINGLE 0
#endif
#ifndef CHUNK_GLA
#define CHUNK_GLA 1
#endif
#ifndef CHUNK_GDN
#define CHUNK_GDN 1
#endif
#ifndef CHUNK_RW
#define CHUNK_RW 1
#endif
#define XB_TMO      128
#define XB_XCNT(j)  (256  + 64 * (j))
#define XB_XSUB(j)  (1280 + 64 * (j))
#define XB_XGEN(j)  (2304 + 64 * (j))
#define XB_TOP      3328
#define XB_TOPGEN   3392
#define XB_SPIN_CAP (1u << 22)
__device__ __forceinline__ unsigned xb_ld(unsigned* p)              { return __hip_atomic_load(p, __ATOMIC_RELAXED, __HIP_MEMORY_SCOPE_AGENT); }
__device__ __forceinline__ unsigned xb_add(unsigned* p, unsigned v) { return __hip_atomic_fetch_add(p, v, __ATOMIC_RELAXED, __HIP_MEMORY_SCOPE_AGENT); }
__device__ __forceinline__ unsigned xb_xcc_id() { return (unsigned)__builtin_amdgcn_s_getreg((3 << 11) | 20) & 0xFu; }
#define XB_SPIN(cond, bar) do { unsigned _sp = 0; while (cond) { __builtin_amdgcn_s_sleep(1); \
    if ((++_sp & 255u) == 0u) { if (xb_ld(&(bar)[XB_TMO])) break; if (_sp > XB_SPIN_CAP) { atomicAdd(&(bar)[XB_TMO], 1u); break; } } } } while (0)
struct XcdBarrier { unsigned* bar; unsigned x; volatile LAS unsigned* st; };
__device__ __forceinline__ XcdBarrier xcd_barrier_post(unsigned* bar, volatile LAS unsigned* st) {
    XcdBarrier b; b.bar = bar; b.x = xb_xcc_id(); b.st = st;
    if (threadIdx.x == 0) (void)xb_add(&bar[XB_XCNT(b.x)], 1u);
    return b;
}
__device__ __forceinline__ void xcd_barrier_complete(unsigned* bar, unsigned x, unsigned& nloc, unsigned& nx) {
    const unsigned G = gridDim.x * gridDim.y * gridDim.z;
    unsigned sum, cnt, mine, sp = 0u;
    for (;;) {
        sum = 0u; cnt = 0u; mine = 0u;
#pragma unroll
        for (unsigned j = 0; j < 16; ++j) { const unsigned c = xb_ld(&bar[XB_XCNT(j)]); sum += c; cnt += (c > 0u) ? 1u : 0u; mine = (j == x) ? c : mine; }
        if (sum == G) break;
        __builtin_amdgcn_s_sleep(1);
        if ((++sp & 255u) == 0u) { if (xb_ld(&bar[XB_TMO])) break; if (sp > XB_SPIN_CAP) { atomicAdd(&bar[XB_TMO], 1u); break; } }
    }
    nloc = mine > 0u ? mine : 1u; nx = cnt > 0u ? cnt : 1u;
}
__device__ __forceinline__ void xcd_barrier(const XcdBarrier& b) {
    asm volatile("s_waitcnt vmcnt(0)" ::: "memory");
    __syncthreads();
    if (threadIdx.x == 0) {
        unsigned* bar = b.bar;
        __builtin_amdgcn_s_waitcnt(0);
        unsigned nloc = b.st[0], nx = b.st[1];
        if (nloc == 0u) { xcd_barrier_complete(bar, b.x, nloc, nx); b.st[0] = nloc; b.st[1] = nx; }
        const unsigned old = xb_add(&bar[XB_XSUB(b.x)], 1u);
        const unsigned gen = old / nloc;
        if (old + 1u == (gen + 1u) * nloc) {
            __builtin_amdgcn_fence(__ATOMIC_RELEASE, "agent");
            asm volatile("s_waitcnt vmcnt(0)" ::: "memory");
            const unsigned og = xb_add(&bar[XB_TOP], 1u);
            const unsigned tg = og / nx;
            if (og + 1u == (tg + 1u) * nx) xb_add(&bar[XB_TOPGEN], 1u);
            else XB_SPIN(xb_ld(&bar[XB_TOPGEN]) == tg, bar);
            __builtin_amdgcn_fence(__ATOMIC_ACQUIRE, "agent");
            xb_add(&bar[XB_XGEN(b.x)], 1u);
            asm volatile("s_waitcnt vmcnt(0)" ::: "memory");
        } else {
            XB_SPIN(xb_ld(&bar[XB_XGEN(b.x)]) == gen, bar);
            __builtin_amdgcn_fence(__ATOMIC_ACQUIRE, "agent");
            asm volatile("s_waitcnt vmcnt(0)" ::: "memory");
        }
    }
    __syncthreads();
}
template <int PH> __device__ __forceinline__ void run_phase(LAS unsigned char* lds) {
    constexpr int L = PH > 0 ? (PH - 1) / PH_PER_LAYER : 0, q = PH > 0 ? (PH - 1) % PH_PER_LAYER + 1 : 0, s = q >= 16 ? 1 : 0;
    const int tid = threadIdx.x, lane = tid & 63, wave = __builtin_amdgcn_readfirstlane(tid >> 6);
    const int G = gridDim.x, bid = blockIdx.x;
    KArgs ap = (KArgs)__builtin_amdgcn_kernarg_segment_ptr();
    unsigned char* ws = ap->ws; float* X = ap->out;
    const int gw = bid * NWAVES + wave, NGW = G * NWAVES;
    unsigned char* wb = ws + WS_W;
    bf16* XB = (bf16*)(ws + WS_XB);
    (void)lane; (void)gw; (void)NGW; (void)wb; (void)XB; (void)X; (void)s;
    if constexpr (q == 0) {
        convert_weights(ap, 0, lds, wave, lane, gw, NGW);
        for (int m = gw; m < M; m += NGW) row_pass<false>(ap->in[0] + (size_t)m * D, X + (size_t)m * D, XB + (size_t)m * D, nullptr, nullptr, lane);
    } else if constexpr (q == 1 || q == 16) {
        pg8::Gemm g{XB, (const bf16*)(wb + (s ? WO_W13_1 : WO_W13_0)), M, 5632, D}; pg8::StaticOrder S; S.init(M, 5632, G, bid);
        pg8::EpiSwiGLU E{(bf16*)(ws + WS_R), FF};
        pg8::gemm_phase<pg8::EpiSwiGLU, pg8::StaticOrder, true, true>(lds, g, S, E, tid);
    } else if constexpr (q == 2 || q == 17) {
        pg8::Gemm g{(const bf16*)(ws + WS_R), (const bf16*)(wb + (s ? WO_W2_1 : WO_W2_0)), M, D, FF}; pg8::StaticOrder S; S.init(M, D, G, bid);
        pg8::EpiResid E{X, ALPHA, 0.5f};
        pg8::gemm_phase<pg8::EpiResid, pg8::StaticOrder, true, true>(lds, g, S, E, tid);
    } else if constexpr (q == 3 || q == 15 || q == 18 || q == 21) {
        constexpr int li = q == 3 ? 0 : (q == 15 ? 1 : (q == 18 ? 2 : 3));
        const float* lng = ap->in[2] + (size_t)(L * 4 + li) * D; const float* lnb = ap->in[3] + (size_t)(L * 4 + li) * D;
        for (int m = gw; m < M; m += NGW) row_pass<true>(X + (size_t)m * D, X + (size_t)m * D, XB + (size_t)m * D, lng, lnb, lane);
        if constexpr (q == 18) {
            const float* ps = ap->in[1] + (size_t)L * M * PLE; bf16* pd = (bf16*)(ws + WS_R);
            for (size_t e = (size_t)(bid * NTHREADS + tid) * 4; e < (size_t)M * PLE; e += (size_t)G * NTHREADS * 4) {
                const f32x4 v = *(const GAS f32x4*)(ps + e);
                *(GAS unsigned long long*)(pd + e) = (unsigned long long)pk2(v.x, v.y) | ((unsigned long long)pk2(v.z, v.w) << 32);
            }
        }
        if constexpr (q == 21 && L + 1 < DEPTH) convert_weights(ap, L + 1, lds, wave, lane, gw, NGW);
    } else if constexpr (q == 4) {
        pg8::Gemm g{XB, (const bf16*)(wb + WO_WRW), M, LD_RW, D}; pg8::StaticOrder S; S.init(M, LD_RW, G, bid);
        pg8::EpiStore<0> E{(bf16*)(ws + WS_R), LD_RW};
        pg8::gemm_phase<pg8::EpiStore<0>, pg8::StaticOrder, true, true>(lds, g, S, E, tid);
    } else if constexpr (q == 5) {
        {
            const int hh = bid & 7, n_ = lane & 15, g_ = lane >> 4; const int kind = wave >> 2;
            const bf16* b01 = (const bf16*)(wb + (kind ? WO_RA2T : WO_RW2T)) + (size_t)(hh * 64 + 16 * (wave & 3) + n_) * 64 + 8 * g_;
            const bf16* bg_ = (const bf16*)(wb + WO_RG2T) + (size_t)(hh * 64 + 16 * (wave >> 1) + n_) * 160 + 8 * g_;
            bf16x8 fw[2], fg[5];
            fw[0] = *(const bf16x8*)b01; fw[1] = *(const bf16x8*)(b01 + 32);
#pragma unroll
            for (int s_ = 0; s_ < 5; ++s_) fg[s_] = *(const bf16x8*)(bg_ + 32 * s_);
            const float bias01 = ap->in[kind ? 11 : 9][L * 512 + hh * 64 + 16 * (wave & 3) + n_];
            for (int it = bid; it < 2048; it += G) m1_rw(ap, L, it, lds, tid, wave, fw, fg, bias01);
        }
    } else if constexpr (q == 6 || q == 8 || q == 11) {
        constexpr int NSC = q == 6 ? 32 : 16;
        if (bid < NSC) {
            if constexpr (q == 6) scan_rw(ap, bid >> 3, bid & 7, tid);
            else if constexpr (q == 8) scan_gla(ap, bid >> 2, bid & 3, tid);
            else scan_gdn(ap, bid >> 2, bid & 3, lds, tid);
        } else if constexpr (q == 11) {
            pg8::Gemm g{XB, (const bf16*)(wb + WO_WG), M, 2048, D}; pg8::StaticOrder S; S.init(M, 2048, G - NSC, bid - NSC);
            pg8::EpiStore<2> E{(bf16*)(ws + WS_R), 1024, (size_t)32 * MiB / 2};
            pg8::gemm_phase<pg8::EpiStore<2>, pg8::StaticOrder, true, true>(lds, g, S, E, tid);
        } else {
            constexpr int ld = q == 6 ? LD_GLA : LD_GDN; constexpr size_t wo = q == 6 ? WO_WGLA : WO_WGDN;
            pg8::Gemm g{XB, (const bf16*)(wb + wo), M, ld, D}; pg8::StaticOrder S; S.init(M, ld, G - NSC, bid - NSC);
            pg8::EpiStore<0> E{(bf16*)(ws + WS_R), ld};
            pg8::gemm_phase<pg8::EpiStore<0>, pg8::StaticOrder, true, true>(lds, g, S, E, tid);
        }
    } else if constexpr (q == 7) {
        yout<0>(ap, gw, NGW, lane);
        for (int it = bid; it < 1024; it += G) m1_gla(ap, L, it, lds, tid);
    } else if constexpr (q == 9) {
        yout<1>(ap, gw, NGW, lane);
    } else if constexpr (q == 10) {
        for (int it = bid; it < 1024; it += G) m1_gdn(ap, L, it, lds, tid);
    } else if constexpr (q == 12) {
        yout<2>(ap, gw, NGW, lane);
        pg8::Gemm g{XB, (const bf16*)(wb + WO_WG) + (size_t)2048 * 1024, M, 1024, D}; pg8::StaticOrder S; S.init(M, 1024, G, bid);
        pg8::EpiStore<2> E{(bf16*)(ws + WS_R + 104 * MiB), 1024};
        pg8::gemm_phase<pg8::EpiStore<2>, pg8::StaticOrder, true, true>(lds, g, S, E, tid);
    } else if constexpr (q == 13) {
        pg8::Gemm g{(const bf16*)(ws + WS_O), (const bf16*)(wb + WO_WBR), 3 * M, 3 * 1024, 512}; pg8::BranchOrder S; S.init(G, bid);
        pg8::EpiBranch E{(const bf16*)(ws + WS_R), (size_t)32 * MiB / 2, (size_t)104 * MiB / 2, XB};
        pg8::gemm_phase<pg8::EpiBranch, pg8::BranchOrder, true, true>(lds, g, S, E, tid);
    } else if constexpr (q == 14) {
        pg8::Gemm g{XB, (const bf16*)(wb + WO_WO), M, D, D}; pg8::StaticOrder S; S.init(M, D, G, bid);
        pg8::EpiResid E{X, ALPHA, 1.0f};
        pg8::gemm_phase<pg8::EpiResid, pg8::StaticOrder, true, true>(lds, g, S, E, tid);
    } else if constexpr (q == 19) {
        int kple = PLE; asm volatile("" : "+s"(kple));
        pg8::Gemm g{(const bf16*)(ws + WS_R), (const bf16*)(wb + WO_WPP), M, D, kple}; pg8::StaticOrder S; S.init(M, D, G, bid);
        pg8::EpiStore<0> E{(bf16*)(ws + WS_R_PP), D};
        pg8::gemm_phase<pg8::EpiStore<0>, pg8::StaticOrder, true, true>(lds, g, S, E, tid);
    } else if constexpr (q == 20) {
        pg8::Gemm g{XB, (const bf16*)(wb + WO_WPG), M, D, D}; pg8::StaticOrder S; S.init(M, D, G, bid);
        pg8::EpiPle E{X, (const bf16*)(ws + WS_R_PP), ALPHA};
        pg8::gemm_phase<pg8::EpiPle, pg8::StaticOrder, true, true>(lds, g, S, E, tid);
    }
}
__global__ void __launch_bounds__(NTHREADS, 2) mk_fwd(Args args) {
    extern __shared__ __attribute__((aligned(16))) unsigned char lds_raw[];
    LAS unsigned char* lds = (LAS unsigned char*)lds_raw;
#if MK_SINGLE
    cg::grid_group grid = cg::this_grid();
    volatile LAS unsigned* xst = (volatile LAS unsigned*)(lds + 147456);
    if (threadIdx.x == 0) { xst[0] = 0u; xst[1] = 0u; }
    __syncthreads();
    const XcdBarrier xb = xcd_barrier_post((unsigned*)args.ws, xst);
#ifdef MK_TIME
#define STAMP(k) if (blockIdx.x == 0 && threadIdx.x == 0) ((unsigned long long*)(args.ws + 32768))[(k)] = __builtin_amdgcn_s_memrealtime();
#else
#define STAMP(k)
#endif
    STAMP(0)
#define PHASE(k) if (args.ph_lo <= (k) && (k) < args.ph_hi) { run_phase<(k)>(lds); if ((k) + 1 < args.ph_hi) { if ((k) == 0) grid.sync(); else xcd_barrier(xb); } STAMP((k) + 1) }
#else
#define PHASE(k) if (args.ph_lo <= (k) && (k) < args.ph_hi) { run_phase<(k)>(lds); }
#endif
    PHASE(0)
    PHASE(1)
    PHASE(2)
    PHASE(3)
    PHASE(4)
    PHASE(5)
    PHASE(6)
    PHASE(7)
    PHASE(8)
    PHASE(9)
    PHASE(10)
    PHASE(11)
    PHASE(12)
    PHASE(13)
    PHASE(14)
    PHASE(15)
    PHASE(16)
    PHASE(17)
    PHASE(18)
    PHASE(19)
    PHASE(20)
    PHASE(21)
    PHASE(22)
    PHASE(23)
    PHASE(24)
    PHASE(25)
    PHASE(26)
    PHASE(27)
    PHASE(28)
    PHASE(29)
    PHASE(30)
    PHASE(31)
    PHASE(32)
    PHASE(33)
    PHASE(34)
    PHASE(35)
    PHASE(36)
    PHASE(37)
    PHASE(38)
    PHASE(39)
    PHASE(40)
    PHASE(41)
    PHASE(42)
#undef PHASE
    static_assert(N_PHASES == 43, "phase slots");
#if MK_SINGLE && defined(MK_TIME)
    if (blockIdx.x == 0 && threadIdx.x == 0) { const unsigned long long* ts = (const unsigned long long*)(args.ws + 32768); asm volatile("s_waitcnt vmcnt(0)" ::: "memory");
        const float us_ = 0.01f * (float)(ts[MK_TIME_B] - ts[MK_TIME_A]); const float st_ = exp2f(floorf(log2f(fmaxf(us_, 1.f)))) * 0.25f; args.out[0] += roundf(us_ / st_) * st_; }
#endif
}

#ifdef MK_DEBUG
__global__ void __launch_bounds__(NTHREADS, 2) dbg_naive(Args args, int which, int L) {
    extern __shared__ __attribute__((aligned(16))) unsigned char lds_raw[];
    KArgs ap = (KArgs)__builtin_amdgcn_kernarg_segment_ptr();
    const int tid = threadIdx.x, bid = blockIdx.x;
    bf16* dst = (bf16*)(args.ws + WS_DBG);
    if (which == 0) mix_rwkv(ap, L, 0, bid, (LAS float*)lds_raw, tid, (const bf16*)(args.ws + WS_R), dst);
    else if (which == 1) mix_gla(ap, L, 0, bid, (LAS float*)lds_raw, tid, (const bf16*)(args.ws + WS_R), dst);
    else mix_gdn(ap, L, 0, bid, (LAS float*)lds_raw, tid, (const bf16*)(args.ws + WS_R), dst);
}
__global__ void dbg_cmp(Args args, int which) {
    const bf16* o = (const bf16*)(args.ws + WS_O) + (size_t)which * M * 512; const bf16* r = (const bf16*)(args.ws + WS_DBG);
    float mx = 0.f;
    for (size_t e = (size_t)blockIdx.x * blockDim.x + threadIdx.x; e < (size_t)SEQ * 512; e += (size_t)gridDim.x * blockDim.x) {
#ifdef MK_DEBUG_TMAX
        if ((int)(e / 512) >= MK_DEBUG_TMAX) continue;
#endif
        mx = fmaxf(mx, fabsf(b2f(o[e]) - b2f(r[e])));
    }
    atomicMax((unsigned*)args.ws + 1 + which, __float_as_uint(mx));
}
__global__ void dbg_inject(Args args) {
    if (threadIdx.x == 0 && blockIdx.x == 0) { const float* d = (const float*)args.ws; args.out[0] += 1.0e4f * d[1 + MK_DEBUG]; }
}
#endif

extern "C" void kernel_launch(void* const* d_in, const int* in_sizes, int n_in, void* d_out, int out_size, void* d_ws, size_t ws_size, hipStream_t stream) {
    static int grid = 0;
    if (grid == 0) {
        if (n_in != 30 || out_size != M * D || ws_size < WS_END) { fprintf(stderr, "kernel_launch: unexpected problem: n_in %d out %d ws %zu\n", n_in, out_size, ws_size); grid = -1; return; }
        int dev = 0, cus = 0, per_cu = 0;
        (void)hipGetDevice(&dev); (void)hipDeviceGetAttribute(&cus, hipDeviceAttributeMultiprocessorCount, dev);
        (void)hipFuncSetAttribute((const void*)mk_fwd, hipFuncAttributeMaxDynamicSharedMemorySize, LDS_BYTES);
#ifdef MK_DEBUG
        (void)hipFuncSetAttribute((const void*)dbg_naive, hipFuncAttributeMaxDynamicSharedMemorySize, LDS_BYTES);
#endif
        (void)hipOccupancyMaxActiveBlocksPerMultiprocessor(&per_cu, (const void*)mk_fwd, NTHREADS, LDS_BYTES);
        (void)hipGetLastError();
        if (per_cu < 1) { fprintf(stderr, "kernel_launch: occupancy query says %d\n", per_cu); per_cu = 1; }
        grid = cus;
        if (grid > 256) grid = 256;
    }
    if (grid < 0) return;
    Args a{};
    for (int i = 0; i < 30; ++i) a.in[i] = (const float*)d_in[i];
    a.out = (float*)d_out; a.ws = (unsigned char*)d_ws;
#if MK_SINGLE
    (void)hipMemsetAsync(d_ws, 0, 65536, stream);
    a.ph_lo = 0; a.ph_hi = N_PHASES;
    void* kargs[] = {&a};
    hipError_t e = hipLaunchCooperativeKernel((const void*)mk_fwd, dim3(grid), dim3(NTHREADS), kargs, LDS_BYTES, stream);
    if (e != hipSuccess) fprintf(stderr, "cooperative launch failed: %s (grid %d)\n", hipGetErrorString(e), grid);
#else
#ifdef MK_DEBUG
    (void)hipMemsetAsync(d_ws, 0, 4096, stream);
#endif
    for (int ph = 0; ph < N_PHASES; ++ph) {
        a.ph_lo = ph; a.ph_hi = ph + 1;
        hipLaunchKernelGGL(mk_fwd, dim3(grid), dim3(NTHREADS), LDS_BYTES, stream, a);
#ifdef MK_DEBUG
        { const int L_ = ph > 0 ? (ph - 1) / PH_PER_LAYER : 0, q_ = ph > 0 ? (ph - 1) % PH_PER_LAYER + 1 : 0;
          const int which = q_ == 7 ? 0 : (q_ == 11 ? 1 : (q_ == 15 ? 2 : -1));
          if (which == MK_DEBUG) { hipLaunchKernelGGL(dbg_naive, dim3(which == 0 ? 8 : 4), dim3(NTHREADS), LDS_BYTES, stream, a, which, L_); hipLaunchKernelGGL(dbg_cmp, dim3(256), dim3(256), 0, stream, a, which); } }
#endif
    }
#ifdef MK_DEBUG
    hipLaunchKernelGGL(dbg_inject, dim3(1), dim3(64), 0, stream, a);
#endif
#endif
}
```
